# Optimizing an MI355X kernel written in HIP

```python
import math
import jax
import jax.numpy as jnp
from jax import lax
import numpy as np

D_MODEL = 4096
BATCH = 2
SEQ = 4096
DEPTH = 1
DEC_BATCH = 128
DEC_SEQ = 1
PAST_LEN = 8192
PAGE_SIZE = 128

HEAD_DIM = 64
N_ATTN_HEADS = 32
N_KV_HEADS = 4
GQA_GROUP = N_ATTN_HEADS // N_KV_HEADS
WINDOW = 128
ATTN_BLOCK = 128
N_BUCKETS = 32
MAX_DISTANCE = 128
N_RET_HEADS = 8
RET_KDIM = 128
RET_VDIM = 256
RET_CHUNK = 128
ROPE_BASE = 10000.0
D_FF = 11008
CONV_W = 3
PLE_DIM = 256
EPS = 1e-6

ATTN_WIDTH = N_ATTN_HEADS * HEAD_DIM
KV_WIDTH = N_KV_HEADS * HEAD_DIM
RET_QK_WIDTH = N_RET_HEADS * RET_KDIM
RET_V_WIDTH = N_RET_HEADS * RET_VDIM
MIX_WIDTH = ATTN_WIDTH + RET_V_WIDTH
IN_SIZES = (ATTN_WIDTH, KV_WIDTH, KV_WIDTH, RET_QK_WIDTH, RET_QK_WIDTH, RET_V_WIDTH, RET_V_WIDTH)
IN_WIDTH = sum(IN_SIZES)
IN_SPLITS = tuple(int(s) for s in np.cumsum(IN_SIZES)[:-1])

kernel_name = 'hybrid_swa_retention_convffn_step'


def rmsnorm(x, g):
    xf = x.astype(jnp.float32)
    y = xf * lax.rsqrt(jnp.mean(xf * xf, axis=-1, keepdims=True) + EPS)
    return (y * g.astype(jnp.float32)).astype(x.dtype)


def t5_bucket(dist):
    n = jnp.maximum(dist, 0)
    max_exact = N_BUCKETS // 2
    nf = jnp.maximum(n, 1).astype(jnp.float32)
    large = max_exact + (jnp.log(nf / max_exact) / math.log(MAX_DISTANCE / max_exact)
                         * (N_BUCKETS - max_exact)).astype(jnp.int32)
    return jnp.where(n < max_exact, n, jnp.minimum(large, N_BUCKETS - 1))


def window_attention(q, k, v, q_pos, k_pos, rel_bias, sinks):
    n_blk, nq = q_pos.shape
    nk = k_pos.shape[1]
    dist = q_pos[:, :, None] - k_pos[:, None, :]
    valid = (dist >= 0) & (dist <= WINDOW) & (k_pos[:, None, :] >= 0)
    bias = jnp.moveaxis(rel_bias.astype(jnp.float32)[t5_bucket(dist)], -1, 1)
    bias = bias.reshape(n_blk, N_KV_HEADS, GQA_GROUP, nq, nk)
    s = jnp.einsum('bnqhgd,bnkhd->bnhgqk', q, k,
                   preferred_element_type=jnp.float32) * HEAD_DIM ** -0.5 + bias
    s = jnp.where(valid[:, None, None], s, -jnp.inf)
    sink = sinks.astype(jnp.float32).reshape(1, 1, N_KV_HEADS, GQA_GROUP, 1, 1)
    m = jnp.maximum(jnp.max(s, axis=-1, keepdims=True), sink)
    e = jnp.exp(s - m)
    probs = e / (jnp.sum(e, axis=-1, keepdims=True) + jnp.exp(sink - m))
    return jnp.einsum('bnhgqk,bnkhd->bnqhgd', probs.astype(v.dtype), v)


def attn_prompt(q, k, v, pos, rel_bias, sinks):
    b, t = q.shape[:2]
    nb = t // ATTN_BLOCK
    qb = q.reshape(b, nb, ATTN_BLOCK, N_KV_HEADS, GQA_GROUP, HEAD_DIM)

    def with_prev(a):
        a = a.reshape(b, nb, ATTN_BLOCK, N_KV_HEADS, HEAD_DIM)
        prev = jnp.concatenate([jnp.zeros_like(a[:, :1]), a[:, :-1]], axis=1)
        return jnp.concatenate([prev, a], axis=2)

    q_pos = pos.reshape(nb, ATTN_BLOCK)
    k_pos = jnp.concatenate([q_pos - ATTN_BLOCK, q_pos], axis=1)
    o = window_attention(qb, with_prev(k), with_prev(v), q_pos, k_pos, rel_bias, sinks)
    return o.reshape(b, t, ATTN_WIDTH)


def attn_sample(q, k, v, win_k, win_v, pos, rel_bias, sinks):
    b, s = q.shape[:2]
    wb = win_k.shape[1]
    kk = jnp.concatenate([win_k.astype(k.dtype), k], axis=1)
    vv = jnp.concatenate([win_v.astype(v.dtype), v], axis=1)
    q_pos = pos[None]
    k_pos = (pos[0] - wb + jnp.arange(wb + s, dtype=jnp.int32))[None]
    o = window_attention(q.reshape(b, 1, s, N_KV_HEADS, GQA_GROUP, HEAD_DIM),
                         kk[:, None], vv[:, None], q_pos, k_pos, rel_bias, sinks)
    return o.reshape(b, s, ATTN_WIDTH), kk[:, -wb:], vv[:, -wb:]


def rotary(x, pos):
    half = x.shape[-1] // 2
    inv = ROPE_BASE ** (-jnp.arange(half, dtype=jnp.float32) / half)
    ang = pos.astype(jnp.float32)[:, None] * inv[None]
    cos = jnp.cos(ang)[None, :, None, :]
    sin = jnp.sin(ang)[None, :, None, :]
    xf = x.astype(jnp.float32)
    x1, x2 = xf[..., :half], xf[..., half:]
    return jnp.concatenate([x1 * cos - x2 * sin, x2 * cos + x1 * sin], axis=-1).astype(x.dtype)


def retention_chunk(s0, q, k, v, log_decay):
    L = q.shape[1]
    idx = jnp.arange(L, dtype=jnp.float32)
    diff = idx[:, None] - idx[None, :]
    dmask = jnp.where(diff[None] >= 0, jnp.exp(diff[None] * log_decay[:, None, None]), 0.0)
    qf, kf, vf = q.astype(jnp.float32), k.astype(jnp.float32), v.astype(jnp.float32)
    scores = jnp.einsum('blhd,bmhd->bhlm', qf, kf) * dmask
    o_intra = jnp.einsum('bhlm,bmhe->blhe', scores, vf)
    q_dec = jnp.exp((idx + 1.0)[:, None] * log_decay[None])
    o_inter = jnp.einsum('blhd,bhde->blhe', qf * q_dec[None, :, :, None], s0)
    k_dec = jnp.exp((L - 1.0 - idx)[:, None] * log_decay[None])
    s1 = (jnp.exp(L * log_decay)[None, :, None, None] * s0
          + jnp.einsum('blhd,blhe->bhde', kf * k_dec[None, :, :, None], vf))
    return s1, o_intra + o_inter


def retention(s0, q, k, v, log_decay):
    b, t = q.shape[:2]
    chunk = RET_CHUNK if t % RET_CHUNK == 0 else t
    nc = t // chunk

    def to_chunks(a):
        return jnp.swapaxes(a.reshape(b, nc, chunk, *a.shape[2:]), 0, 1)

    def step(s, qkv):
        return retention_chunk(s, qkv[0], qkv[1], qkv[2], log_decay)

    s1, o = lax.scan(step, s0, (to_chunks(q), to_chunks(k), to_chunks(v)))
    return s1, jnp.swapaxes(o, 0, 1).reshape(b, t, N_RET_HEADS, RET_VDIM)


def conv_ffn(h, prev, w_up, conv_w, conv_b, w_down):
    u = h @ w_up
    t = u.shape[1]
    up = jnp.concatenate([prev.astype(u.dtype), u], axis=1)
    c = conv_b.astype(u.dtype)
    for j in range(CONV_W):
        c = c + conv_w[j] * up[:, j:j + t]
    g, val = jnp.split(c, 2, axis=-1)
    y = (jax.nn.gelu(g, approximate=False) * val) @ w_down
    return y, up[:, -(CONV_W - 1):]


def decoder_layer(x, p, pos, past, lp, rel_bias, log_decay):
    (g_mix, w_in, g_q, g_k, sinks, w_out, g_ffn, w_up, conv_w, conv_b, w_down,
     g_ple, w_ple_gate, w_ple_proj) = lp
    b, t, _ = x.shape
    h = rmsnorm(x, g_mix)
    aq, ak, av, rq, rk, rv, rg = jnp.split(h @ w_in, IN_SPLITS, axis=-1)
    aq = rmsnorm(aq.reshape(b, t, N_ATTN_HEADS, HEAD_DIM), g_q)
    ak = rmsnorm(ak.reshape(b, t, N_KV_HEADS, HEAD_DIM), g_k)
    av = av.reshape(b, t, N_KV_HEADS, HEAD_DIM)
    rq = rotary(rq.reshape(b, t, N_RET_HEADS, RET_KDIM), pos)
    rk = rotary(rk.reshape(b, t, N_RET_HEADS, RET_KDIM), pos) * RET_KDIM ** -0.5
    rv = rv.reshape(b, t, N_RET_HEADS, RET_VDIM)
    if past is None:
        attn = attn_prompt(aq, ak, av, pos, rel_bias, sinks)
        new_k, new_v = ak[:, -WINDOW:], av[:, -WINDOW:]
        s0 = jnp.zeros((b, N_RET_HEADS, RET_KDIM, RET_VDIM), jnp.float32)
        conv_prev = jnp.zeros((b, CONV_W - 1, 2 * D_FF), x.dtype)
    else:
        win_k, win_v, s_past, conv_prev = past
        attn, new_k, new_v = attn_sample(aq, ak, av, win_k, win_v, pos, rel_bias, sinks)
        s0 = s_past.astype(jnp.float32)
    s1, ro = retention(s0, rq, rk, rv, log_decay)
    ro = ro * lax.rsqrt(jnp.mean(ro * ro, axis=-1, keepdims=True) + EPS)
    ret = (jax.nn.silu(rg.astype(jnp.float32)) * ro.reshape(b, t, RET_V_WIDTH)).astype(x.dtype)
    x = x + jnp.concatenate([attn.astype(x.dtype), ret], axis=-1) @ w_out
    f, conv_new = conv_ffn(rmsnorm(x, g_ffn), conv_prev, w_up, conv_w, conv_b, w_down)
    x = x + f
    gate = jax.nn.sigmoid(rmsnorm(x, g_ple) @ w_ple_gate)
    x = x + gate * (p @ w_ple_proj)
    return x, new_k, new_v, s1, conv_new


def setup_inputs(seed: int = 0) -> dict:
    key = jax.random.key(seed)
    ks = jax.random.split(key, 24)
    f32 = jnp.float32
    win = min(WINDOW, PAST_LEN)

    def nrm(k, shape, scale):
        return jax.random.normal(k, shape, f32) * scale

    return {
        'x_prompt': nrm(ks[0], (BATCH, SEQ, D_MODEL), 1.0),
        'x_sample': nrm(ks[1], (DEC_BATCH, DEC_SEQ, D_MODEL), 1.0),
        'p_prompt': nrm(ks[2], (DEPTH, BATCH, SEQ, PLE_DIM), 1.0),
        'p_sample': nrm(ks[3], (DEPTH, DEC_BATCH, DEC_SEQ, PLE_DIM), 1.0),
        'cache_win_k': nrm(ks[4], (DEPTH, DEC_BATCH, win, N_KV_HEADS, HEAD_DIM), 1.0),
        'cache_win_v': nrm(ks[5], (DEPTH, DEC_BATCH, win, N_KV_HEADS, HEAD_DIM), 1.0),
        'state_ret': nrm(ks[6], (DEPTH, DEC_BATCH, N_RET_HEADS, RET_KDIM, RET_VDIM), 1.0),
        'state_conv': nrm(ks[7], (DEPTH, DEC_BATCH, CONV_W - 1, 2 * D_FF), 1.0),
        'rel_bias': nrm(ks[8], (N_BUCKETS, N_ATTN_HEADS), 0.5),
        'g_mix': 1.0 + nrm(ks[9], (DEPTH, D_MODEL), 0.02),
        'w_in': nrm(ks[10], (DEPTH, D_MODEL, IN_WIDTH), D_MODEL ** -0.5),
        'g_q': 1.0 + nrm(ks[11], (DEPTH, HEAD_DIM), 0.02),
        'g_k': 1.0 + nrm(ks[12], (DEPTH, HEAD_DIM), 0.02),
        'sinks': nrm(ks[13], (DEPTH, N_ATTN_HEADS), 0.5),
        'w_out': nrm(ks[14], (DEPTH, MIX_WIDTH, D_MODEL), MIX_WIDTH ** -0.5),
        'g_ffn': 1.0 + nrm(ks[15], (DEPTH, D_MODEL), 0.02),
        'w_up': nrm(ks[16], (DEPTH, D_MODEL, 2 * D_FF), D_MODEL ** -0.5),
        'conv_w': nrm(ks[17], (DEPTH, CONV_W, 2 * D_FF), CONV_W ** -0.5),
        'conv_b': nrm(ks[18], (DEPTH, 2 * D_FF), 0.01),
        'w_down': nrm(ks[19], (DEPTH, D_FF, D_MODEL), D_FF ** -0.5),
        'g_ple': 1.0 + nrm(ks[20], (DEPTH, D_MODEL), 0.02),
        'w_ple_gate': nrm(ks[21], (DEPTH, D_MODEL, D_MODEL), D_MODEL ** -0.5),
        'w_ple_proj': nrm(ks[22], (DEPTH, PLE_DIM, D_MODEL), PLE_DIM ** -0.5),
    }


def reference(x_prompt, x_sample, p_prompt, p_sample, cache_win_k, cache_win_v, state_ret, state_conv,
              rel_bias, g_mix, w_in, g_q, g_k, sinks, w_out, g_ffn, w_up, conv_w, conv_b, w_down,
              g_ple, w_ple_gate, w_ple_proj):
    log_decay = jnp.log(1.0 - 2.0 ** (-5.0 - jnp.arange(N_RET_HEADS, dtype=jnp.float32)))
    pos_prompt = jnp.arange(x_prompt.shape[1], dtype=jnp.int32)
    pos_sample = PAST_LEN + jnp.arange(x_sample.shape[1], dtype=jnp.int32)
    yp, ys = x_prompt, x_sample
    kp_l, vp_l, rp_l, cp_l, ks_l, vs_l, rs_l, cs_l = [], [], [], [], [], [], [], []
    for l in range(DEPTH):
        lp = (g_mix[l], w_in[l], g_q[l], g_k[l], sinks[l], w_out[l], g_ffn[l], w_up[l], conv_w[l],
              conv_b[l], w_down[l], g_ple[l], w_ple_gate[l], w_ple_proj[l])
        yp, kp, vp, rp, cp = decoder_layer(yp, p_prompt[l], pos_prompt, None, lp, rel_bias, log_decay)
        past = (cache_win_k[l], cache_win_v[l], state_ret[l], state_conv[l])
        ys, ksn, vsn, rsn, csn = decoder_layer(ys, p_sample[l], pos_sample, past, lp, rel_bias, log_decay)
        kp_l.append(kp.astype(cache_win_k.dtype))
        vp_l.append(vp.astype(cache_win_v.dtype))
        rp_l.append(rp.astype(state_ret.dtype))
        cp_l.append(cp.astype(state_conv.dtype))
        ks_l.append(ksn.astype(cache_win_k.dtype))
        vs_l.append(vsn.astype(cache_win_v.dtype))
        rs_l.append(rsn.astype(state_ret.dtype))
        cs_l.append(csn.astype(state_conv.dtype))
    return (yp, ys, jnp.stack(kp_l), jnp.stack(vp_l), jnp.stack(rp_l), jnp.stack(cp_l),
            jnp.stack(ks_l), jnp.stack(vs_l), jnp.stack(rs_l), jnp.stack(cs_l))
```

```cpp
#include <hip/hip_runtime.h>
#include <cstdio>
#include <cstdint>
#include <cmath>
namespace pg8 {
#define PG8_LAS __attribute__((address_space(3)))
typedef unsigned short bf16_t;
typedef short bf16x8 __attribute__((ext_vector_type(8)));
typedef float f32x4 __attribute__((ext_vector_type(4)));
typedef unsigned u32x4 __attribute__((ext_vector_type(4)));
constexpr int BM = 256, BK = 64, HALF = 128, HTB = HALF * BK * 2  , STAGE_BYTES = 8 * HTB, NXCD = 8, WGM = 8;

__host__ __device__ __forceinline__ int lds_byte(int r, int c) { const int st = (r >> 4) * 2 + (c >> 5), rr = r & 15, cc = c & 31, ob = rr * 64 + cc * 2; return st * 1024 + (ob ^ (((ob >> 9) & 1) << 5)); }
__host__ __device__ __forceinline__ void stage_rc(int b, int& R, int& C) { const int st = b / 1024, sb = b % 1024, swz = sb ^ (((sb >> 9) & 1) << 5); R = (st >> 1) * 16 + swz / 64; C = (st & 1) * 32 + (swz % 64) / 2; }
__host__ __device__ __forceinline__ int perm32(int rho) { const int n = rho >> 4, i = rho & 15; return 8 * (i >> 2) + 4 * n + (i & 3); }

struct Unit { int pm, pn; };
struct Gemm { const bf16_t* A; const bf16_t* Bt; int M, N, K; };

struct StaticOrder {
    int nM, nN, nwg, G, c;
    __host__ __device__ void init(int M, int N, int G_, int c_) { nM = M / BM; nN = N / BM; nwg = nM * nN; G = G_; c = c_; }
    __host__ __device__ bool next(int i, Unit& u) const {
        const long L = (long)i * G + c; if (L >= nwg) return false;
        int wgid = (int)L; { const int q = nwg / NXCD, r = nwg % NXCD, xcd = wgid % NXCD, off = wgid / NXCD; wgid = (xcd < r ? xcd * (q + 1) : r * (q + 1) + (xcd - r) * q) + off; }
        const int nig = WGM * nN, gid = wgid / nig, fm = gid * WGM, gsz = (nM - fm) < WGM ? (nM - fm) : WGM;
        u.pm = fm + ((wgid % nig) % gsz); u.pn = (wgid % nig) / gsz; return true;
    }
    __device__ __forceinline__ void a_ready(const Unit&) const {}
    __device__ __forceinline__ void done(const Unit&) const {}
};

__device__ __forceinline__ unsigned cvt_pk_bf16(float lo, float hi) { unsigned r; asm volatile("v_cvt_pk_bf16_f32 %0, %1, %2" : "=v"(r) : "v"(lo), "v"(hi)); return r; }
typedef float f32x2 __attribute__((ext_vector_type(2)));
__device__ __forceinline__ f32x2 gelu_pk(f32x2 v) {
    const f32x2 av = __builtin_elementwise_abs(v), d = av * 0.2316418882f + 1.0f;
    f32x2 t; t.x = __builtin_amdgcn_rcpf(d.x); t.y = __builtin_amdgcn_rcpf(d.y);
    f32x2 q = t * 0.5307027145f + (-0.7265760135f); q = q * t + 0.7107068705f; q = q * t + (-0.142248368f); q = q * t + 0.127414796f; q = q * t;
    const f32x2 s = (v * v) * (-0.72134752044f);
    f32x2 e; e.x = __builtin_amdgcn_exp2f(s.x); e.y = __builtin_amdgcn_exp2f(s.y);
    const f32x2 m = v * (q * e), r = v - m;
    f32x2 o; o.x = v.x < 0.f ? m.x : r.x; o.y = v.y < 0.f ? m.y : r.y; return o;
}

template <int ACT  > struct EpiBf16 {
    static constexpr bool PERM = true, AFTER_DRAIN = false; static_assert(ACT == 0 || ACT == 1, "EpiBf16: ACT is 0 (none) or 1 (gelu_pk)");
    bf16_t* O; int ldc; const float* bias; int split_cols; size_t split_stride; float scale0;
    __device__ __forceinline__ void operator()(const f32x4 (&acc)[2][2][4][2], const Unit& u, int wr, int wc, int fr, int fq) const {
        const int row0 = u.pm * BM + wr * 64 + fr; int colt = u.pn * BM; bf16_t* base = O;
        float sc = 1.f; if (split_cols) { const int t = colt / split_cols; base += (size_t)t * split_stride; colt -= t * split_cols; if (t == 0) sc = scale0; }
        const int col0 = colt + wc * 32 + 8 * fq, bcol0 = u.pn * BM + wc * 32 + 8 * fq;
        f32x4 bv[2][2];
#pragma unroll
        for (int bj = 0; bj < 2; ++bj)
#pragma unroll
            for (int n = 0; n < 2; ++n) bv[bj][n] = bias ? *(const f32x4*)(bias + bcol0 + bj * HALF + 4 * n) : (f32x4){0.f, 0.f, 0.f, 0.f};
#pragma unroll
        for (int ai = 0; ai < 2; ++ai)
#pragma unroll
            for (int m = 0; m < 4; ++m) { bf16_t* rowp = base + (size_t)(row0 + ai * HALF + m * 16) * ldc + col0;
#pragma unroll
                for (int bj = 0; bj < 2; ++bj) { f32x4 v0 = acc[ai][bj][m][0] + bv[bj][0], v1 = acc[ai][bj][m][1] + bv[bj][1];
                    if (ACT == 1) { f32x2 a = gelu_pk((f32x2){v0[0], v0[1]}), b = gelu_pk((f32x2){v0[2], v0[3]}), c = gelu_pk((f32x2){v1[0], v1[1]}), d = gelu_pk((f32x2){v1[2], v1[3]});
                        v0 = (f32x4){a.x, a.y, b.x, b.y}; v1 = (f32x4){c.x, c.y, d.x, d.y}; }
                    v0 = v0 * sc; v1 = v1 * sc; u32x4 w; w.x = cvt_pk_bf16(v0[0], v0[1]); w.y = cvt_pk_bf16(v0[2], v0[3]); w.z = cvt_pk_bf16(v1[0], v1[1]); w.w = cvt_pk_bf16(v1[2], v1[3]);
                    *(u32x4*)(rowp + bj * HALF) = w; } }
    }
};

typedef unsigned u32x2 __attribute__((ext_vector_type(2)));
typedef float f32x2b __attribute__((ext_vector_type(2))); typedef __bf16 bf16x2b __attribute__((ext_vector_type(2)));
__device__ __forceinline__ unsigned cvtpk(float lo, float hi) { f32x2b v = {lo, hi}; bf16x2b b = __builtin_convertvector(v, bf16x2b); return __builtin_bit_cast(unsigned, b); }
constexpr int ROWS_REAL = 8320, ROWS_PROMPT = 8192, DMODEL = 4096;
constexpr float RMS_EPS = 1e-6f;

template <bool SCALE> struct EpiBf16S {
    static constexpr bool PERM = true, AFTER_DRAIN = false;
    bf16_t* O; int ldc; const float* ss;
    __device__ __forceinline__ void operator()(const f32x4 (&acc)[2][2][4][2], const Unit& u, int wr, int wc, int fr, int fq) const {
        const int row0 = u.pm * BM + wr * 64 + fr, col0 = u.pn * BM + wc * 32 + 8 * fq;
#pragma unroll
        for (int ai = 0; ai < 2; ++ai)
#pragma unroll
            for (int m = 0; m < 4; ++m) { const int row = row0 + ai * HALF + m * 16; bf16_t* rowp = O + (size_t)row * ldc + col0;
                float sc = 1.f; if (SCALE) sc = 1.0f / sqrtf(ss[row] * (1.0f / DMODEL) + RMS_EPS);
#pragma unroll
                for (int bj = 0; bj < 2; ++bj) { const f32x4 v0 = acc[ai][bj][m][0] * sc, v1 = acc[ai][bj][m][1] * sc;
                    u32x4 w; w.x = cvtpk(v0[0], v0[1]); w.y = cvtpk(v0[2], v0[3]); w.z = cvtpk(v1[0], v1[1]); w.w = cvtpk(v1[2], v1[3]);
                    *(u32x4*)(rowp + bj * HALF) = w; } }
    }
};
struct EpiResid {
    static constexpr bool PERM = false, AFTER_DRAIN = false;
    const float* base_p; const float* base_s; float* outf; bf16_t* outb; float* ss;
    __device__ __forceinline__ void operator()(const f32x4 (&acc)[2][2][4][2], const Unit& u, int wr, int wc, int fr, int fq) const {
        const int row0 = u.pm * BM + wr * 64 + fr, col0 = u.pn * BM + wc * 32 + 4 * fq;
#pragma unroll
        for (int ai = 0; ai < 2; ++ai)
#pragma unroll
            for (int m = 0; m < 4; ++m) { const int row = row0 + ai * HALF + m * 16;
                if (u.pm * BM + ai * HALF < ROWS_REAL) {
                    const float* bp = (row < ROWS_PROMPT) ? base_p + (size_t)row * DMODEL : base_s + (size_t)(row - ROWS_PROMPT) * DMODEL;
                    float s = 0.f;
#pragma unroll
                    for (int bj = 0; bj < 2; ++bj)
#pragma unroll
                        for (int n = 0; n < 2; ++n) { const int c = col0 + bj * HALF + n * 16; const f32x4 o = *(const f32x4*)(bp + c) + acc[ai][bj][m][n];
                            *(f32x4*)(outf + (size_t)row * DMODEL + c) = o; s += (o[0] * o[0] + o[1] * o[1]) + (o[2] * o[2] + o[3] * o[3]);
                            u32x2 w; w.x = cvtpk(o[0], o[1]); w.y = cvtpk(o[2], o[3]); *(u32x2*)(outb + (size_t)row * DMODEL + c) = w; }
                    s += __shfl_xor(s, 16); s += __shfl_xor(s, 32);
                    if (fq == 0) atomicAdd(ss + row, s);
                } else {
#pragma unroll
                    for (int bj = 0; bj < 2; ++bj)
#pragma unroll
                        for (int n = 0; n < 2; ++n) { const int c = col0 + bj * HALF + n * 16; u32x2 w; w.x = 0u; w.y = 0u; *(u32x2*)(outb + (size_t)row * DMODEL + c) = w; }
                }
                asm volatile("" ::: "memory"); }
    }
};
struct EpiPle {
    static constexpr bool PERM = false, AFTER_DRAIN = false;
    float* y; const bf16_t* ple; const float* ss;
    __device__ __forceinline__ void operator()(const f32x4 (&acc)[2][2][4][2], const Unit& u, int wr, int wc, int fr, int fq) const {
        const int row0 = u.pm * BM + wr * 64 + fr, col0 = u.pn * BM + wc * 32 + 4 * fq;
#pragma unroll
        for (int ai = 0; ai < 2; ++ai)
#pragma unroll
            for (int m = 0; m < 4; ++m) { const int row = row0 + ai * HALF + m * 16;
                if (u.pm * BM + ai * HALF < ROWS_REAL) {
                    const float sc = 1.0f / sqrtf(ss[row] * (1.0f / DMODEL) + RMS_EPS);
#pragma unroll
                    for (int bj = 0; bj < 2; ++bj)
#pragma unroll
                        for (int n = 0; n < 2; ++n) { const int c = col0 + bj * HALF + n * 16; const size_t off = (size_t)row * DMODEL + c;
                            const f32x4 x2 = *(const f32x4*)(y + off); const u32x2 pw = *(const u32x2*)(ple + off);
                            const f32x4 pl = {__uint_as_float(pw.x << 16), __uint_as_float(pw.x & 0xffff0000u), __uint_as_float(pw.y << 16), __uint_as_float(pw.y & 0xffff0000u)};
                            const f32x4 z = acc[ai][bj][m][n] * sc; f32x4 o;
#pragma unroll
                            for (int k = 0; k < 4; ++k) { const float g = __builtin_amdgcn_rcpf(1.0f + __builtin_amdgcn_exp2f(-1.4426950408889634f * z[k])); o[k] = x2[k] + g * pl[k]; }
                            *(f32x4*)(y + off) = o; }
                }
                asm volatile("" ::: "memory"); }
    }
};

template <class Epi, class Sched, bool ALIGN_EPI = false, bool SP2 = false>
__device__ __forceinline__ void gemm_phase(PG8_LAS unsigned char* lds, const Gemm g, const Sched& S, const Epi& E) {
    const int tid = threadIdx.x, wid = __builtin_amdgcn_readfirstlane(tid >> 6), lane = tid & 63, wr = wid >> 2, wc = wid & 3, fr = lane & 15, fq = lane >> 4;
    const int K = g.K, nt = K / BK;
    unsigned voffA[2], voffB[2];
#pragma unroll
    for (int i = 0; i < 2; ++i) { int R, C; stage_rc(tid * 16 + i * 8192, R, C); const int Rb = Epi::PERM ? ((R & ~31) + perm32(R & 31)) : R;
        voffA[i] = (unsigned)(R * K + C) * 2u; voffB[i] = (unsigned)(Rb * K + C) * 2u; }
    const size_t kstep = (size_t)(BK * 2);
    const size_t hstep = (size_t)HALF * K * 2;
    const size_t tstep = 2 * hstep;
    const unsigned ldsw = (unsigned)wid * 1024u;
    const int aoff = lds_byte(wr * 64 + fr, fq * 8), boff = lds_byte(wc * 32 + fr, fq * 8);
#define PG8_SA(b, h) (((b) * 2 + (h)) * HTB)
#define PG8_SB(b, h) ((4 + (b) * 2 + (h)) * HTB)
#define PG8_STAGE(bufoff, gbase, voff) do { _Pragma("unroll") for (int _i = 0; _i < 2; ++_i) \
        __builtin_amdgcn_global_load_lds((const unsigned*)((const char*)(gbase) + (voff)[_i]), (PG8_LAS unsigned*)(lds + (bufoff) + ldsw + _i * 8192), 16, 0, 0); } while (0)
#define PG8_LDA(dst, b, h) do { _Pragma("unroll") for (int m = 0; m < 4; ++m) _Pragma("unroll") for (int k = 0; k < 2; ++k) dst[m][k] = *(const PG8_LAS bf16x8*)(lds + PG8_SA(b, h) + aoff + m * 2048 + k * 1024); } while (0)
#define PG8_LDB(dst, b, h) do { _Pragma("unroll") for (int n = 0; n < 2; ++n) _Pragma("unroll") for (int k = 0; k < 2; ++k) dst[n][k] = *(const PG8_LAS bf16x8*)(lds + PG8_SB(b, h) + boff + n * 2048 + k * 1024); } while (0)
#define PG8_MMA(ai, bj, At, Bt) do { __builtin_amdgcn_s_setprio(1); _Pragma("unroll") for (int m = 0; m < 4; ++m) _Pragma("unroll") for (int n = 0; n < 2; ++n) _Pragma("unroll") for (int k = 0; k < 2; ++k) \
        acc[ai][bj][m][n] = __builtin_amdgcn_mfma_f32_16x16x32_bf16(Bt[n][k], At[m][k], acc[ai][bj][m][n], 0, 0, 0); __builtin_amdgcn_s_setprio(0); } while (0)
#define PG8_WAIT_V(n) asm volatile("s_waitcnt vmcnt(" #n ")" ::: "memory")
#define PG8_WAIT_L(n) asm volatile("s_waitcnt lgkmcnt(" #n ")" ::: "memory")
#define PG8_BAR __builtin_amdgcn_s_barrier()
#define PG8_SCHED __builtin_amdgcn_sched_barrier(0)
    Unit cur, nxt; int ui = 0;
    if (!S.next(0, cur)) return;
    f32x4 acc[2][2][4][2];
#pragma unroll
    for (int a = 0; a < 2; ++a)
#pragma unroll
        for (int b = 0; b < 2; ++b)
#pragma unroll
            for (int m = 0; m < 4; ++m)
#pragma unroll
                for (int n = 0; n < 2; ++n) acc[a][b][m][n] = (f32x4){0.f, 0.f, 0.f, 0.f};
    bf16x8 At[4][2], B0[2][2], B1[2][2];
    const char* cA = (const char*)g.A + (size_t)cur.pm * tstep; const char* cB = (const char*)g.Bt + (size_t)cur.pn * tstep;
    S.a_ready(cur);
    if constexpr (SP2) {
        PG8_STAGE(PG8_SB(0, 0), cB, voffB); PG8_STAGE(PG8_SB(0, 1), cB + hstep, voffB); PG8_STAGE(PG8_SA(0, 0), cA, voffA); PG8_STAGE(PG8_SA(0, 1), cA + hstep, voffA);
        if (wr == 1) PG8_BAR;
        PG8_WAIT_V(2); PG8_BAR;
        PG8_STAGE(PG8_SB(1, 0), cB + kstep, voffB); PG8_STAGE(PG8_SA(1, 0), cA + kstep, voffA); PG8_STAGE(PG8_SB(1, 1), cB + hstep + kstep, voffB);
        PG8_WAIT_V(6); PG8_BAR;
    } else {
        PG8_STAGE(PG8_SB(0, 0), cB, voffB); PG8_STAGE(PG8_SA(0, 0), cA, voffA); PG8_STAGE(PG8_SB(0, 1), cB + hstep, voffB); PG8_STAGE(PG8_SA(0, 1), cA + hstep, voffA);
        if (wr == 1) PG8_BAR;
        PG8_WAIT_V(4); PG8_BAR;
        PG8_STAGE(PG8_SB(1, 0), cB + kstep, voffB); PG8_STAGE(PG8_SA(1, 0), cA + kstep, voffA); PG8_STAGE(PG8_SB(1, 1), cB + hstep + kstep, voffB);
        PG8_WAIT_V(6); PG8_BAR;
    }
    for (;;) {
        const bool has_next = S.next(ui + 1, nxt);
        const char* nA = has_next ? (const char*)g.A + (size_t)nxt.pm * tstep : cA; const char* nB = has_next ? (const char*)g.Bt + (size_t)nxt.pn * tstep : cB;
        for (int t = 0; t < nt; t += 2) {
            const bool last = (t == nt - 2);
            const char* a1 = cA + (size_t)(t + 1) * kstep;
            const char* a2 = last ? nA : cA + (size_t)(t + 2) * kstep; const char* b2 = last ? nB : cB + (size_t)(t + 2) * kstep;
            const char* a3 = a2 + kstep; const char* b3 = b2 + kstep;
            if (last && has_next) S.a_ready(nxt);
            if constexpr (SP2) {
            PG8_LDB(B0, 0, 0); PG8_LDB(B1, 0, 1); PG8_SCHED; PG8_LDA(At, 0, 0); PG8_STAGE(PG8_SA(1, 1), a1 + hstep, voffA);
            PG8_WAIT_V(8); PG8_WAIT_L(0); PG8_BAR; PG8_MMA(0, 0, At, B0); PG8_MMA(0, 1, At, B1); PG8_BAR; PG8_SCHED;
            PG8_LDA(At, 0, 1); PG8_STAGE(PG8_SB(0, 0), b2, voffB); PG8_STAGE(PG8_SB(0, 1), b2 + hstep, voffB); PG8_STAGE(PG8_SA(0, 0), a2, voffA);
            PG8_WAIT_V(8); PG8_WAIT_L(0); PG8_BAR; PG8_MMA(1, 0, At, B0); PG8_MMA(1, 1, At, B1); PG8_BAR; PG8_SCHED;
            PG8_LDB(B0, 1, 0); PG8_LDB(B1, 1, 1); PG8_SCHED; PG8_LDA(At, 1, 0); PG8_STAGE(PG8_SA(0, 1), a2 + hstep, voffA);
            PG8_WAIT_V(8); PG8_WAIT_L(0); PG8_BAR; PG8_MMA(0, 0, At, B0); PG8_MMA(0, 1, At, B1); PG8_BAR; PG8_SCHED;
            PG8_LDA(At, 1, 1); PG8_STAGE(PG8_SB(1, 0), b3, voffB); PG8_STAGE(PG8_SB(1, 1), b3 + hstep, voffB); PG8_STAGE(PG8_SA(1, 0), a3, voffA);
            PG8_WAIT_V(8); PG8_WAIT_L(0); PG8_BAR; PG8_MMA(1, 0, At, B0); PG8_MMA(1, 1, At, B1); PG8_BAR; PG8_SCHED;
            } else {
            PG8_LDB(B0, 0, 0); PG8_SCHED; PG8_LDA(At, 0, 0); PG8_STAGE(PG8_SA(1, 1), a1 + hstep, voffA);
            PG8_WAIT_L(8); PG8_BAR; PG8_WAIT_L(0); PG8_MMA(0, 0, At, B0); PG8_BAR; PG8_SCHED;
            PG8_LDB(B1, 0, 1); PG8_STAGE(PG8_SB(0, 0), b2, voffB);
            PG8_BAR; PG8_WAIT_L(0); PG8_MMA(0, 1, At, B1); PG8_BAR;
            PG8_LDA(At, 0, 1); PG8_STAGE(PG8_SA(0, 0), a2, voffA);
            PG8_BAR; PG8_WAIT_L(0); PG8_MMA(1, 0, At, B0); PG8_BAR; PG8_SCHED;
            PG8_STAGE(PG8_SB(0, 1), b2 + hstep, voffB);
            PG8_WAIT_V(6); PG8_BAR; PG8_MMA(1, 1, At, B1); PG8_BAR;
            PG8_LDB(B0, 1, 0); PG8_SCHED; PG8_LDA(At, 1, 0); PG8_STAGE(PG8_SA(0, 1), a2 + hstep, voffA);
            PG8_WAIT_L(8); PG8_BAR; PG8_WAIT_L(0); PG8_MMA(0, 0, At, B0); PG8_BAR; PG8_SCHED;
            PG8_LDB(B1, 1, 1); PG8_STAGE(PG8_SB(1, 0), b3, voffB);
            PG8_BAR; PG8_WAIT_L(0); PG8_MMA(0, 1, At, B1); PG8_BAR;
            PG8_LDA(At, 1, 1); PG8_STAGE(PG8_SA(1, 0), a3, voffA);
            PG8_BAR; PG8_WAIT_L(0); PG8_MMA(1, 0, At, B0); PG8_BAR; PG8_SCHED;
            PG8_STAGE(PG8_SB(1, 1), b3 + hstep, voffB);
            PG8_WAIT_V(6); PG8_BAR; PG8_MMA(1, 1, At, B1); PG8_BAR;
            }
        }
        if constexpr (ALIGN_EPI) { if (wr == 0) PG8_BAR; }
        if constexpr (!Epi::AFTER_DRAIN) { E(acc, cur, wr, wc, fr, fq); S.done(cur); }
        if (!has_next) break;
#pragma unroll
        for (int a = 0; a < 2; ++a)
#pragma unroll
            for (int b = 0; b < 2; ++b)
#pragma unroll
                for (int m = 0; m < 4; ++m)
#pragma unroll
                    for (int n = 0; n < 2; ++n) acc[a][b][m][n] = (f32x4){0.f, 0.f, 0.f, 0.f};
        cur = nxt; cA = nA; cB = nB; ++ui;
        if constexpr (ALIGN_EPI) { if (wr == 1) PG8_BAR; }
    }
    PG8_WAIT_V(0);
    if constexpr (!ALIGN_EPI) { if (wr == 0) PG8_BAR; }
    PG8_BAR;
    if constexpr (Epi::AFTER_DRAIN) { E.fused(acc, cur, wr, wc, fr, fq, lds, wid, lane); S.done(cur); }
#undef PG8_SA
#undef PG8_SB
#undef PG8_STAGE
#undef PG8_LDA
#undef PG8_LDB
#undef PG8_MMA
#undef PG8_WAIT_V
#undef PG8_WAIT_L
#undef PG8_BAR
#undef PG8_SCHED
}
}
#define GAS __attribute__((address_space(1)))
#define LAS __attribute__((address_space(3)))
typedef unsigned short bf16;
typedef unsigned v4u __attribute__((ext_vector_type(4)));
typedef float f32x4 __attribute__((ext_vector_type(4)));
typedef short bf16x8 __attribute__((ext_vector_type(8)));
typedef GAS unsigned gu32;
typedef GAS unsigned long long gu64;
#define RLX_AGENT __ATOMIC_RELAXED, __HIP_MEMORY_SCOPE_AGENT
#define LDS_WAIT() asm volatile("s_waitcnt lgkmcnt(0)" ::: "memory")
#define VM_WAIT() asm volatile("s_waitcnt vmcnt(0)" ::: "memory")
__device__ __forceinline__ unsigned long long rt() { return __builtin_amdgcn_s_memrealtime(); }
__device__ __forceinline__ unsigned f2bf(float f) { unsigned u = __builtin_bit_cast(unsigned, f); return (u + 0x7fffu + ((u >> 16) & 1u)) >> 16; }
__device__ __forceinline__ unsigned pk2(float lo, float hi) { return f2bf(lo) | (f2bf(hi) << 16); }
#define XB_TMO      128
#define XB_XCNT(j)  (256  + 64 * (j))
#define XB_XSUB(j)  (1280 + 64 * (j))
#define XB_XGEN(j)  (2304 + 64 * (j))
#define XB_TOP      3328
#define XB_TOPGEN   3392
#define XCD_BAR_WORDS 3456
#define XB_SPIN_CAP (1u << 18)

__device__ __forceinline__ unsigned xb_ld(unsigned* p)              { return __hip_atomic_load(p, __ATOMIC_RELAXED, __HIP_MEMORY_SCOPE_AGENT); }
__device__ __forceinline__ unsigned xb_add(unsigned* p, unsigned v) { return __hip_atomic_fetch_add(p, v, __ATOMIC_RELAXED, __HIP_MEMORY_SCOPE_AGENT); }
__device__ __forceinline__ unsigned xb_xcc_id() { return (unsigned)__builtin_amdgcn_s_getreg((3 << 11) | 20) & 0xFu; }
#define XB_SPIN(cond, bar) do { unsigned _sp = 0; while (cond) { __builtin_amdgcn_s_sleep(1); \
    if ((++_sp & 255u) == 0u) { if (xb_ld(&(bar)[XB_TMO])) break; if (_sp > XB_SPIN_CAP) { atomicAdd(&(bar)[XB_TMO], 1u); break; } } } } while (0)

struct XcdBarrier {
    unsigned* bar; unsigned x;
    volatile LAS unsigned* st;
};

__device__ __forceinline__ XcdBarrier xcd_barrier_post(unsigned* bar, volatile LAS unsigned* st) {
    XcdBarrier b; b.bar = bar; b.x = xb_xcc_id(); b.st = st;
    if (threadIdx.x == 0) (void)xb_add(&bar[XB_XCNT(b.x)], 1u);
    return b;
}
__device__ __forceinline__ void xcd_barrier_complete(unsigned* bar, unsigned x, unsigned& nloc, unsigned& nx) {
    const unsigned G = gridDim.x * gridDim.y * gridDim.z;
    unsigned sum, cnt, mine, sp = 0u;
    for (;;) {
        sum = 0u; cnt = 0u; mine = 0u;
#pragma unroll
        for (unsigned j = 0; j < 16; ++j) { const unsigned c = xb_ld(&bar[XB_XCNT(j)]); sum += c; cnt += (c > 0u) ? 1u : 0u; mine = (j == x) ? c : mine; }
        if (sum == G) break;
        __builtin_amdgcn_s_sleep(1);
        if ((++sp & 255u) == 0u) { if (xb_ld(&bar[XB_TMO])) break; if (sp > XB_SPIN_CAP) { atomicAdd(&bar[XB_TMO], 1u); break; } }
    }
    nloc = mine > 0u ? mine : 1u; nx = cnt > 0u ? cnt : 1u;
}

__device__ __forceinline__ void xcd_barrier(const XcdBarrier& b) {
    asm volatile("s_waitcnt vmcnt(0)" ::: "memory");
    __syncthreads();
    if (threadIdx.x == 0) {
        unsigned* bar = b.bar;
        __builtin_amdgcn_s_waitcnt(0);
        unsigned nloc = b.st[0], nx = b.st[1];
        if (nloc == 0u) { xcd_barrier_complete(bar, b.x, nloc, nx); b.st[0] = nloc; b.st[1] = nx; }
        const unsigned old = xb_add(&bar[XB_XSUB(b.x)], 1u);
        const unsigned gen = old / nloc;
        if (old + 1u == (gen + 1u) * nloc) {
            __builtin_amdgcn_fence(__ATOMIC_RELEASE, "agent");
            asm volatile("s_waitcnt vmcnt(0)" ::: "memory");
            const unsigned og = xb_add(&bar[XB_TOP], 1u);
            const unsigned tg = og / nx;
            if (og + 1u == (tg + 1u) * nx) xb_add(&bar[XB_TOPGEN], 1u);
            else XB_SPIN(xb_ld(&bar[XB_TOPGEN]) == tg, bar);
            __builtin_amdgcn_fence(__ATOMIC_ACQUIRE, "agent");
            xb_add(&bar[XB_XGEN(b.x)], 1u);
            asm volatile("s_waitcnt vmcnt(0)" ::: "memory");
        } else {
            XB_SPIN(xb_ld(&bar[XB_XGEN(b.x)]) == gen, bar);
            __builtin_amdgcn_fence(__ATOMIC_ACQUIRE, "agent");
            asm volatile("s_waitcnt vmcnt(0)" ::: "memory");
        }
    }
    __syncthreads();
}

#ifndef MK_N_LAUNCHES
#define MK_N_LAUNCHES 1
#endif
constexpr int N_LAUNCHES = MK_N_LAUNCHES;
constexpr int N_PHASES = 11;
constexpr int NWAVES = 8, NTHR = 512;
constexpr int DM = 4096, SEQ = 4096, NBATCH = 2, MPROMPT = 8192, MSAMPLE = 128, MREAL = 8320, MPAD = 8448;
constexpr int NIN = 8704, DFF = 11008, NUP = 22016, PLED = 256;
constexpr int C_AQ = 0, C_AK = 2048, C_AV = 2304, C_RQ = 2560, C_RK = 3584, C_RV = 4608, C_RG = 6656;
constexpr int NCHUNK = 32;
constexpr int PAST = 8192;
constexpr float EPS = 1e-6f;
enum { I_XP = 0, I_XS, I_PP, I_PS, I_CK, I_CV, I_SR, I_SC, I_RB, I_GMIX, I_WIN, I_GQ, I_GK, I_SINK, I_WOUT, I_GFFN, I_WUP, I_CW, I_CB, I_WDOWN, I_GPLE, I_WGATE, I_WPROJ, N_INPUTS };
constexpr size_t O_YP = 0, O_YS = 33554432, O_WKP = 34078720, O_WVP = 34144256, O_RP = 34209792, O_CP = 34734080, O_WKS = 34822144, O_WVS = 39016448, O_RS = 43210752, O_CS = 76765184, O_END = 82401280;
constexpr size_t MiB = 1u << 20;
constexpr size_t WS_CTL = 0, CTL_ZERO_BYTES = 1 * MiB;
constexpr size_t WS_ROT = 1 * MiB, WS_WIN = 4 * MiB, WS_WOUT = 72 * MiB, WS_WUP = 104 * MiB, WS_WDOWN = 276 * MiB, WS_WGATE = 362 * MiB, WS_WPROJ = 394 * MiB;
constexpr size_t WS_A = 396 * MiB, WS_X1 = 462 * MiB, WS_PB = 594 * MiB, WS_PLE = 599 * MiB, WS_ACT = 665 * MiB, WS_U = 843 * MiB;
constexpr size_t WS_PROJ = 843 * MiB, WS_MIX = 984 * MiB, WS_KVT = 1050 * MiB, WS_ST = 1114 * MiB, WS_END = 1198 * MiB;
static_assert(WS_WIN + (size_t)NIN * DM * 2 <= WS_WOUT && WS_WUP + (size_t)NUP * DM * 2 <= WS_WDOWN && WS_WDOWN + (size_t)DM * DFF * 2 <= WS_WGATE, "ws map (weights)");
static_assert(WS_A + (size_t)MPAD * DM * 2 <= WS_X1 && WS_X1 + (size_t)MPAD * DM * 4 <= WS_PB && WS_PB + (size_t)MPAD * PLED * 2 <= WS_PLE && WS_PLE + (size_t)MPAD * DM * 2 <= WS_ACT, "ws map (act)");
static_assert(WS_ACT + (size_t)MPAD * DFF * 2 <= WS_U && WS_U + (size_t)MPAD * NUP * 2 <= WS_END, "ws map (u)");
static_assert(WS_PROJ + (size_t)MPAD * NIN * 2 <= WS_MIX && WS_MIX + (size_t)MPAD * DM * 2 <= WS_KVT && WS_KVT + (size_t)16 * NCHUNK * 32768 * 4 <= WS_ST && WS_ST + (size_t)16 * NCHUNK * 32768 * 2 <= WS_END, "ws map (overlay)");
static_assert(WS_ROT + (size_t)4097 * 64 * 8 <= WS_WIN, "ws map (rot)");
constexpr int CW_TMO = 0, CW_CODE = 1, CW_BAR = 4096, CW_SS1 = 65536, CW_SS2 = 65536 + 16384;
static_assert((CW_SS2 + MPAD) * 4 <= (int)CTL_ZERO_BYTES, "ctl");
constexpr int RING_OFF = 0, RING_BYTES = 131072, LDSCTL_OFF = RING_BYTES, MISC_OFF = LDSCTL_OFF + 320, LDS_BYTES = 147456;

#define DEVI __device__ __forceinline__
typedef unsigned u32x2 __attribute__((ext_vector_type(2)));
typedef float f2v __attribute__((ext_vector_type(2)));

DEVI float bflo(unsigned w) { return __uint_as_float(w << 16); }
DEVI float bfhi(unsigned w) { return __uint_as_float(w & 0xffff0000u); }
DEVI float bf1(unsigned short b) { return __uint_as_float((unsigned)b << 16); }
DEVI void unpack8(const v4u r, float (&f)[8]) { f[0] = bflo(r.x); f[1] = bfhi(r.x); f[2] = bflo(r.y); f[3] = bfhi(r.y); f[4] = bflo(r.z); f[5] = bfhi(r.z); f[6] = bflo(r.w); f[7] = bfhi(r.w); }
DEVI unsigned cvtpk(float lo, float hi) { return pg8::cvtpk(lo, hi); }
DEVI v4u pack8(const float (&f)[8]) { v4u w; w.x = cvtpk(f[0], f[1]); w.y = cvtpk(f[2], f[3]); w.z = cvtpk(f[4], f[5]); w.w = cvtpk(f[6], f[7]); return w; }
DEVI float wave_sum(float v) {
#pragma unroll
    for (int o = 1; o < 64; o <<= 1) v += __shfl_xor(v, o);
    return v;
}
DEVI float wave_max(float v) {
#pragma unroll
    for (int o = 1; o < 64; o <<= 1) v = fmaxf(v, __shfl_xor(v, o));
    return v;
}
#define MFMA16(a, b, c) __builtin_amdgcn_mfma_f32_16x16x32_bf16((a), (b), (c), 0, 0, 0)

struct Args { const float* in[N_INPUTS]; float* out; unsigned char* ws; int ph_lo, ph_hi; };
#define P_Win_t ((bf16*)(args.ws + WS_WIN))
#define P_Wout_t ((bf16*)(args.ws + WS_WOUT))
#define P_Wup_t ((bf16*)(args.ws + WS_WUP))
#define P_Wdown_t ((bf16*)(args.ws + WS_WDOWN))
#define P_Wgate_t ((bf16*)(args.ws + WS_WGATE))
#define P_Wproj_t ((bf16*)(args.ws + WS_WPROJ))
#define P_A ((bf16*)(args.ws + WS_A))
#define P_PB ((bf16*)(args.ws + WS_PB))
#define P_PLEB ((bf16*)(args.ws + WS_PLE))
#define P_ACT ((bf16*)(args.ws + WS_ACT))
#define P_U ((bf16*)(args.ws + WS_U))
#define P_PROJ ((bf16*)(args.ws + WS_PROJ))
#define P_MIX ((bf16*)(args.ws + WS_MIX))
#define P_ST ((bf16*)(args.ws + WS_ST))
#define P_X1 ((float*)(args.ws + WS_X1))
#define P_KVT ((float*)(args.ws + WS_KVT))
#define P_ROT ((f2v*)(args.ws + WS_ROT))
#define P_SS1 ((float*)(args.ws + WS_CTL) + CW_SS1)
#define P_SS2 ((float*)(args.ws + WS_CTL) + CW_SS2)
struct Frame {
    LAS unsigned char* lds;
    volatile LAS unsigned* MISC;
    gu32* ctl;
    int tid, lane, wave, G;
};

DEVI void p0_transpose_item(const float* W, int K, int N, bf16* WT, const float* kscale, LAS float* scr, int item, int lane) {
    const int nblk = N / 32, kb = item / nblk, nb = item % nblk, k0 = 64 * kb, n0 = 32 * nb;
#pragma unroll 8
    for (int i = 0; i < 32; ++i) { const int kk = 2 * i + (lane >> 5); float w = W[(size_t)(k0 + kk) * N + n0 + (lane & 31)]; if (kscale) w *= kscale[k0 + kk]; scr[kk * 33 + (lane & 31)] = w; }
    LDS_WAIT(); asm volatile("" ::: "memory");
    const int c = lane & 7;
#pragma unroll
    for (int j = 0; j < 4; ++j) { const int n = (lane >> 3) + 8 * j; const LAS float* s = scr + (8 * c) * 33 + n;
        v4u o; o.x = cvtpk(s[0 * 33], s[1 * 33]); o.y = cvtpk(s[2 * 33], s[3 * 33]); o.z = cvtpk(s[4 * 33], s[5 * 33]); o.w = cvtpk(s[6 * 33], s[7 * 33]);
        *(GAS v4u*)(WT + (size_t)(n0 + n) * K + k0 + 8 * c) = o; }
    LDS_WAIT(); asm volatile("" ::: "memory");
}
DEVI void rms_row_to_bf16(const float* xrow, const float* g, bf16* orow, int lane) {
    const GAS f32x4* xr = (const GAS f32x4*)xrow + lane; const GAS f32x4* gr = (const GAS f32x4*)g + lane;
    f32x4 v[16]; float s = 0.f;
#pragma unroll
    for (int j = 0; j < 16; ++j) { v[j] = xr[64 * j]; s += (v[j].x * v[j].x + v[j].y * v[j].y) + (v[j].z * v[j].z + v[j].w * v[j].w); }
    const float rstd = 1.0f / sqrtf(wave_sum(s) * (1.0f / DM) + EPS);
    GAS u32x2* o8 = (GAS u32x2*)orow + lane;
#pragma unroll
    for (int j = 0; j < 16; ++j) { const f32x4 gv = gr[64 * j]; u32x2 w; w.x = cvtpk(v[j].x * rstd * gv.x, v[j].y * rstd * gv.y); w.y = cvtpk(v[j].z * rstd * gv.z, v[j].w * rstd * gv.w); o8[64 * j] = w; }
}
DEVI void p0_prologue(Frame& F, const Args& args) {
    LAS float* scr = (LAS float*)(F.lds + RING_OFF + F.wave * 16384);
    const int gw = blockIdx.x * NWAVES + F.wave, NGW = F.G * NWAVES;
    const int gt = blockIdx.x * NTHR + F.tid, NGT = F.G * NTHR;
    for (int idx = gt; idx < 4097 * 64; idx += NGT) { const int pi = idx >> 6, i = idx & 63; const float pos = (pi == 4096) ? (float)PAST : (float)pi;
        const float inv = powf(10000.0f, -(float)i * (1.0f / 64.0f)); const float ang = pos * inv; float sn, cs; sincosf(ang, &sn, &cs); P_ROT[idx] = (f2v){cs, sn}; }
    for (int idx = gt; idx < MPAD * 32; idx += NGT) { const int row = idx >> 5, ch = idx & 31; v4u o = {0u, 0u, 0u, 0u};
        if (row < MREAL) { const float* src = (row < MPROMPT) ? args.in[I_PP] + (size_t)row * PLED : args.in[I_PS] + (size_t)(row - MPROMPT) * PLED;
            const f32x4 a = *(const GAS f32x4*)(src + ch * 8), b = *(const GAS f32x4*)(src + ch * 8 + 4); o.x = cvtpk(a.x, a.y); o.y = cvtpk(a.z, a.w); o.z = cvtpk(b.x, b.y); o.w = cvtpk(b.z, b.w); }
        *(GAS v4u*)(P_PB + (size_t)row * PLED + ch * 8) = o; }
    for (int idx = gt; idx < (MPAD - MREAL) * (DM / 8); idx += NGT) { const v4u z = {0u, 0u, 0u, 0u}; const size_t off = (size_t)MREAL * DM + (size_t)idx * 8;
        *(GAS v4u*)(P_A + off) = z; *(GAS v4u*)(P_MIX + off) = z; }
    for (int m = gw; m < MREAL; m += NGW) { const float* xr = (m < MPROMPT) ? args.in[I_XP] + (size_t)m * DM : args.in[I_XS] + (size_t)(m - MPROMPT) * DM; rms_row_to_bf16(xr, args.in[I_GMIX], P_A + (size_t)m * DM, F.lane); }
    constexpr int IT_IN = (DM / 64) * (NIN / 32), IT_OUT = (DM / 64) * (DM / 32), IT_UP = (DM / 64) * (NUP / 32), IT_DOWN = (DFF / 64) * (DM / 32), IT_GATE = IT_OUT, IT_PROJ = (PLED / 64) * (DM / 32);
    constexpr int NITEMS = IT_IN + IT_OUT + IT_UP + IT_DOWN + IT_GATE + IT_PROJ;
    for (int it = gw; it < NITEMS; it += NGW) {
        int r = it;
        if (r < IT_IN) { p0_transpose_item(args.in[I_WIN], DM, NIN, P_Win_t, nullptr, scr, r, F.lane); continue; } r -= IT_IN;
        if (r < IT_OUT) { p0_transpose_item(args.in[I_WOUT], DM, DM, P_Wout_t, nullptr, scr, r, F.lane); continue; } r -= IT_OUT;
        if (r < IT_UP) { p0_transpose_item(args.in[I_WUP], DM, NUP, P_Wup_t, args.in[I_GFFN], scr, r, F.lane); continue; } r -= IT_UP;
        if (r < IT_DOWN) { p0_transpose_item(args.in[I_WDOWN], DFF, DM, P_Wdown_t, nullptr, scr, r, F.lane); continue; } r -= IT_DOWN;
        if (r < IT_GATE) { p0_transpose_item(args.in[I_WGATE], DM, DM, P_Wgate_t, args.in[I_GPLE], scr, r, F.lane); continue; } r -= IT_GATE;
        p0_transpose_item(args.in[I_WPROJ], PLED, DM, P_Wproj_t, nullptr, scr, r, F.lane);
    }
}

DEVI int t5_bucket(int n) {
    if (n < 16) return n;
    const float v = logf((float)n * (1.0f / 16.0f)) / 2.0794415416798357f * 16.0f;
    const int l = 16 + (int)v; return l < 31 ? l : 31;
}
DEVI void attn_prompt_unit(Frame& F, const Args& args, int unit) {
    const int qb = unit & 31, kvh = (unit >> 5) & 3, b = unit >> 7;
    LAS bf16* Kh = (LAS bf16*)(F.lds);
    LAS bf16* Vt = (LAS bf16*)(F.lds + 36864);
    LAS float* biasT = (LAS float*)(F.lds + 36864 + 33792);
    const int tid = F.tid, lane = F.lane, g = F.wave, fr = lane & 15, fq = lane >> 4;
    const float* gk = args.in[I_GK]; const float* gq = args.in[I_GQ];
    __syncthreads();
    for (int task = tid; task < 2048; task += NTHR) {
        const int key = task >> 3, ch = task & 7, tok = (qb - 1) * 128 + key;
        v4u kr = {0u, 0u, 0u, 0u}, vr = {0u, 0u, 0u, 0u};
        if (tok >= 0) { const bf16* rp = P_PROJ + (size_t)(b * SEQ + tok) * NIN + kvh * 64 + ch * 8; kr = *(const GAS v4u*)(rp + C_AK); vr = *(const GAS v4u*)(rp + C_AV); }
        float kf[8], vf[8]; unpack8(kr, kf); unpack8(vr, vf);
        float ss = 0.f;
#pragma unroll
        for (int i = 0; i < 8; ++i) ss += kf[i] * kf[i];
        ss += __shfl_xor(ss, 1); ss += __shfl_xor(ss, 2); ss += __shfl_xor(ss, 4);
        const float rstd = 1.0f / sqrtf(ss * (1.0f / 64.0f) + EPS);
#pragma unroll
        for (int i = 0; i < 8; ++i) kf[i] = kf[i] * rstd * gk[ch * 8 + i];
        *(LAS v4u*)(Kh + key * 72 + ch * 8) = pack8(kf);
        const unsigned vw[4] = {vr.x, vr.y, vr.z, vr.w};
#pragma unroll
        for (int i = 0; i < 8; ++i) Vt[(ch * 8 + i) * 264 + key] = (bf16)((i & 1) ? (vw[i >> 1] >> 16) : (vw[i >> 1] & 0xffffu));
        if (qb == 31 && key >= 128) {
            float* ok = args.out + O_WKP + ((size_t)(b * 128 + (key - 128)) * 4 + kvh) * 64 + ch * 8; float* ov = args.out + O_WVP + ((size_t)(b * 128 + (key - 128)) * 4 + kvh) * 64 + ch * 8;
            *(GAS f32x4*)ok = (f32x4){kf[0], kf[1], kf[2], kf[3]}; *(GAS f32x4*)(ok + 4) = (f32x4){kf[4], kf[5], kf[6], kf[7]};
            *(GAS f32x4*)ov = (f32x4){vf[0], vf[1], vf[2], vf[3]}; *(GAS f32x4*)(ov + 4) = (f32x4){vf[4], vf[5], vf[6], vf[7]};
        }
    }
    for (int i = tid; i < 8 * 129; i += NTHR) { const int gg = i / 129, dist = i - gg * 129; biasT[gg * 132 + dist] = args.in[I_RB][t5_bucket(dist) * 32 + kvh * 8 + gg]; }
    __syncthreads();
    const int head = kvh * 8 + g; const float sink = args.in[I_SINK][head];
    float gqv[2][8];
#pragma unroll
    for (int s = 0; s < 2; ++s)
#pragma unroll
        for (int i = 0; i < 8; ++i) gqv[s][i] = gq[32 * s + 8 * fq + i] * 0.125f;
    for (int j = 0; j < 8; ++j) {
        const size_t row = (size_t)b * SEQ + qb * 128 + 16 * j + fr;
        const bf16* qp = P_PROJ + row * NIN + C_AQ + head * 64 + 8 * fq;
        float q0[8], q1[8]; { const v4u r0 = *(const GAS v4u*)qp, r1 = *(const GAS v4u*)(qp + 32); unpack8(r0, q0); unpack8(r1, q1); }
        float ss = 0.f;
#pragma unroll
        for (int i = 0; i < 8; ++i) ss += q0[i] * q0[i] + q1[i] * q1[i];
        ss += __shfl_xor(ss, 16); ss += __shfl_xor(ss, 32);
        const float rstd = 1.0f / sqrtf(ss * (1.0f / 64.0f) + EPS);
#pragma unroll
        for (int i = 0; i < 8; ++i) { q0[i] *= rstd * gqv[0][i]; q1[i] *= rstd * gqv[1][i]; }
        bf16x8 qf[2]; qf[0] = __builtin_bit_cast(bf16x8, pack8(q0)); qf[1] = __builtin_bit_cast(bf16x8, pack8(q1));
        const int start = (16 * j < 96) ? 16 * j : 96;
        f32x4 sacc[10];
#pragma unroll
        for (int t = 0; t < 10; ++t) { sacc[t] = (f32x4){0.f, 0.f, 0.f, 0.f};
#pragma unroll
            for (int s = 0; s < 2; ++s) { const bf16x8 kfr = *(const LAS bf16x8*)(Kh + (start + 16 * t + fr) * 72 + 32 * s + 8 * fq); sacc[t] = MFMA16(kfr, qf[s], sacc[t]); } }
        float mx = -INFINITY;
#pragma unroll
        for (int t = 0; t < 10; ++t)
#pragma unroll
            for (int r = 0; r < 4; ++r) { const int key = start + 16 * t + 4 * fq + r, dist = 128 + 16 * j + fr - key; const bool valid = (dist >= 0) && (dist <= 128) && (qb > 0 || key >= 128);
                const int dc = dist < 0 ? 0 : (dist > 128 ? 128 : dist);
                const float sv = valid ? sacc[t][r] + biasT[g * 132 + dc] : -INFINITY; sacc[t][r] = sv; mx = fmaxf(mx, sv); }
        mx = fmaxf(mx, __shfl_xor(mx, 16)); mx = fmaxf(mx, __shfl_xor(mx, 32)); mx = fmaxf(mx, sink);
        float l = 0.f;
#pragma unroll
        for (int t = 0; t < 10; ++t)
#pragma unroll
            for (int r = 0; r < 4; ++r) { const float e = __expf(sacc[t][r] - mx); sacc[t][r] = e; l += e; }
        l += __shfl_xor(l, 16); l += __shfl_xor(l, 32); l += __expf(sink - mx);
        const float rl = 1.0f / l;
        bf16x8 pf[5];
#pragma unroll
        for (int ks = 0; ks < 5; ++ks) { v4u w; w.x = cvtpk(sacc[2 * ks][0] * rl, sacc[2 * ks][1] * rl); w.y = cvtpk(sacc[2 * ks][2] * rl, sacc[2 * ks][3] * rl);
            w.z = cvtpk(sacc[2 * ks + 1][0] * rl, sacc[2 * ks + 1][1] * rl); w.w = cvtpk(sacc[2 * ks + 1][2] * rl, sacc[2 * ks + 1][3] * rl); pf[ks] = __builtin_bit_cast(bf16x8, w); }
        bf16* op = P_MIX + row * DM + head * 64 + 4 * fq;
#pragma unroll
        for (int dt = 0; dt < 4; ++dt) { f32x4 o = (f32x4){0.f, 0.f, 0.f, 0.f};
#pragma unroll
            for (int ks = 0; ks < 5; ++ks) { const LAS bf16* vp = Vt + (16 * dt + fr) * 264 + start + 32 * ks + 4 * fq; const u32x2 a = *(const LAS u32x2*)vp, c = *(const LAS u32x2*)(vp + 16);
                const v4u vv = {a.x, a.y, c.x, c.y}; o = MFMA16(__builtin_bit_cast(bf16x8, vv), pf[ks], o); }
            u32x2 w; w.x = cvtpk(o[0], o[1]); w.y = cvtpk(o[2], o[3]); *(GAS u32x2*)(op + 16 * dt) = w; }
    }
}
DEVI void attn_sample_unit(Frame& F, const Args& args, int unit) {
    const int kvh = unit & 3, b = unit >> 2;
    LAS float* Kc = (LAS float*)(F.lds);
    LAS float* Vc = (LAS float*)(F.lds + 33792);
    LAS float* qs = (LAS float*)(F.lds + 33792 + 33280);
    LAS float* pl = qs + 512;
    LAS float* biasT = pl + 8 * 132;
    const int tid = F.tid, lane = F.lane, g = F.wave;
    const size_t prow = (size_t)(MPROMPT + b) * NIN;
    __syncthreads();
    for (int idx = tid; idx < 128 * 16; idx += NTHR) { const int j = idx >> 4, c4 = idx & 15; const size_t src = ((size_t)(b * 128 + j) * 4 + kvh) * 64 + c4 * 4;
        const f32x4 kv = *(const GAS f32x4*)(args.in[I_CK] + src), vv = *(const GAS f32x4*)(args.in[I_CV] + src);
        Kc[j * 65 + c4 * 4 + 0] = kv.x; Kc[j * 65 + c4 * 4 + 1] = kv.y; Kc[j * 65 + c4 * 4 + 2] = kv.z; Kc[j * 65 + c4 * 4 + 3] = kv.w;
        *(LAS f32x4*)(Vc + j * 64 + c4 * 4) = vv;
        if (j >= 1) { const size_t dst = ((size_t)(b * 128 + (j - 1)) * 4 + kvh) * 64 + c4 * 4; *(GAS f32x4*)(args.out + O_WKS + dst) = kv; *(GAS f32x4*)(args.out + O_WVS + dst) = vv; } }
    {
        const int head = kvh * 8 + g; const float qv = bf1(P_PROJ[prow + C_AQ + head * 64 + lane]);
        const float ss = wave_sum(qv * qv); qs[g * 64 + lane] = qv * (1.0f / sqrtf(ss * (1.0f / 64.0f) + EPS)) * args.in[I_GQ][lane] * 0.125f;
    }
    if (g == 0) { const float kv = bf1(P_PROJ[prow + C_AK + kvh * 64 + lane]); const float ss = wave_sum(kv * kv); const float kn = kv * (1.0f / sqrtf(ss * (1.0f / 64.0f) + EPS)) * args.in[I_GK][lane];
        Kc[128 * 65 + lane] = kn; args.out[O_WKS + ((size_t)(b * 128 + 127) * 4 + kvh) * 64 + lane] = kn; }
    if (g == 1) { const float vv = bf1(P_PROJ[prow + C_AV + kvh * 64 + lane]); Vc[128 * 64 + lane] = vv; args.out[O_WVS + ((size_t)(b * 128 + 127) * 4 + kvh) * 64 + lane] = vv; }
    for (int i = tid; i < 8 * 129; i += NTHR) { const int gg = i / 129, dist = i - gg * 129; biasT[gg * 132 + dist] = args.in[I_RB][t5_bucket(dist) * 32 + kvh * 8 + gg]; }
    __syncthreads();
    {
        const float sink = args.in[I_SINK][kvh * 8 + g];
        float s0 = 0.f, s1 = 0.f, s2 = 0.f;
        for (int d = 0; d < 64; ++d) { const float q = qs[g * 64 + d]; s0 += q * Kc[lane * 65 + d]; s1 += q * Kc[(lane + 64) * 65 + d]; s2 += q * Kc[128 * 65 + d]; }
        s0 += biasT[g * 132 + (128 - lane)]; s1 += biasT[g * 132 + (64 - lane)]; s2 += biasT[g * 132 + 0];
        float mx = wave_max(fmaxf(s0, s1)); mx = fmaxf(mx, fmaxf(s2, sink));
        const float e0 = __expf(s0 - mx), e1 = __expf(s1 - mx), e2 = __expf(s2 - mx);
        const float l = wave_sum(e0 + e1) + e2 + __expf(sink - mx); const float rl = 1.0f / l;
        pl[g * 132 + lane] = e0 * rl; pl[g * 132 + 64 + lane] = e1 * rl; if (lane == 0) pl[g * 132 + 128] = e2 * rl;
    }
    __syncthreads();
    {
        float o = 0.f;
        for (int j = 0; j < 129; ++j) o += pl[g * 132 + j] * Vc[j * 64 + lane];
        P_MIX[(size_t)(MPROMPT + b) * DM + (kvh * 8 + g) * 64 + lane] = (bf16)(cvtpk(o, 0.f) & 0xffffu);
    }
}
template <bool TRANSPOSED> DEVI void ret_stage_k(Frame& F, const Args& args, LAS bf16* Kd, int b, int h, int c, float lg2) {
    for (int task = F.tid; task < 1024; task += NTHR) {
        const int m = task & 127, ch = task >> 7;
        const int t = c * 128 + m; const bf16* rp = P_PROJ + (size_t)(b * SEQ + t) * NIN + C_RK + h * 128 + ch * 8;
        float a[8], bb[8]; { const v4u r0 = *(const GAS v4u*)rp, r1 = *(const GAS v4u*)(rp + 64); unpack8(r0, a); unpack8(r1, bb); }
        const GAS f2v* rt = (const GAS f2v*)P_ROT + (size_t)t * 64 + ch * 8;
        float sc = 0.08838834764831845f; if (TRANSPOSED) sc *= exp2f((float)(127 - m) * lg2);
        float lo[8], hi[8];
#pragma unroll
        for (int i = 0; i < 8; ++i) { const f2v cs = rt[i]; lo[i] = (a[i] * cs.x - bb[i] * cs.y) * sc; hi[i] = (bb[i] * cs.x + a[i] * cs.y) * sc; }
        if (TRANSPOSED) {
#pragma unroll
            for (int i = 0; i < 8; i += 2) { const unsigned wl = cvtpk(lo[i], lo[i + 1]), wh = cvtpk(hi[i], hi[i + 1]);
                Kd[(ch * 8 + i) * 136 + m] = (bf16)(wl & 0xffffu); Kd[(ch * 8 + i + 1) * 136 + m] = (bf16)(wl >> 16);
                Kd[(64 + ch * 8 + i) * 136 + m] = (bf16)(wh & 0xffffu); Kd[(64 + ch * 8 + i + 1) * 136 + m] = (bf16)(wh >> 16); }
        } else { *(LAS v4u*)(Kd + m * 136 + ch * 8) = pack8(lo); *(LAS v4u*)(Kd + m * 136 + 64 + ch * 8) = pack8(hi); }
    }
}
DEVI void ret_stage_vt(Frame& F, const Args& args, LAS bf16* Vt, int b, int h, int c) {
    for (int task = F.tid; task < 4096; task += NTHR) {
        const int m = task & 127, ch = task >> 7;
        const v4u r = *(const GAS v4u*)(P_PROJ + (size_t)(b * SEQ + c * 128 + m) * NIN + C_RV + h * 256 + ch * 8);
        const unsigned w[4] = {r.x, r.y, r.z, r.w};
#pragma unroll
        for (int i = 0; i < 8; ++i) Vt[(ch * 8 + i) * 136 + m] = (bf16)((i & 1) ? (w[i >> 1] >> 16) : (w[i >> 1] & 0xffffu));
    }
}
DEVI float ret_log2_gamma(int h) { return log2f(1.0f - exp2f(-5.0f - (float)h)); }
DEVI void ret_kv_unit(Frame& F, const Args& args, int unit) {
    const int c = unit & 31, h = (unit >> 5) & 7, b = unit >> 8;
    LAS bf16* Kt = (LAS bf16*)(F.lds); LAS bf16* Vt = (LAS bf16*)(F.lds + 34816);
    const int lane = F.lane, w = F.wave, fr = lane & 15, fq = lane >> 4;
    __syncthreads();
    ret_stage_k<true>(F, args, Kt, b, h, c, ret_log2_gamma(h));
    ret_stage_vt(F, args, Vt, b, h, c);
    __syncthreads();
    f32x4 acc[8][2];
#pragma unroll
    for (int dt = 0; dt < 8; ++dt) { acc[dt][0] = (f32x4){0.f, 0.f, 0.f, 0.f}; acc[dt][1] = (f32x4){0.f, 0.f, 0.f, 0.f}; }
#pragma unroll
    for (int ks = 0; ks < 4; ++ks) {
        bf16x8 vf[2];
#pragma unroll
        for (int et = 0; et < 2; ++et) vf[et] = *(const LAS bf16x8*)(Vt + (32 * w + 16 * et + fr) * 136 + 32 * ks + 8 * fq);
#pragma unroll
        for (int dt = 0; dt < 8; ++dt) { const bf16x8 kf = *(const LAS bf16x8*)(Kt + (16 * dt + fr) * 136 + 32 * ks + 8 * fq);
            acc[dt][0] = MFMA16(kf, vf[0], acc[dt][0]); acc[dt][1] = MFMA16(kf, vf[1], acc[dt][1]); }
    }
    float* dst = P_KVT + (size_t)unit * 32768;
#pragma unroll
    for (int dt = 0; dt < 8; ++dt)
#pragma unroll
        for (int et = 0; et < 2; ++et) *(GAS f32x4*)(dst + (size_t)(32 * w + 16 * et + fr) * 128 + 16 * dt + 4 * fq) = acc[dt][et];
}
DEVI void ret_sample_unit(Frame& F, const Args& args, int unit) {
    const int h = unit & 7, b = unit >> 3;
    LAS float* qv = (LAS float*)(F.lds); LAS float* kv = qv + 128; LAS float* vv = kv + 128; LAS float* red = vv + 256; LAS float* red2 = red + 8 * 256;
    const int tid = F.tid, lane = F.lane, w = F.wave;
    const size_t prow = (size_t)(MPROMPT + b) * NIN;
    const float gamma = 1.0f - exp2f(-5.0f - (float)h);
    __syncthreads();
    if (tid < 128) { const int d = tid & 63, isk = tid >> 6; const bf16* rp = P_PROJ + prow + (isk ? C_RK : C_RQ) + h * 128;
        const float a = bf1(rp[d]), bb = bf1(rp[d + 64]); const f2v cs = P_ROT[(size_t)4096 * 64 + d]; const float sc = isk ? 0.08838834764831845f : 1.0f;
        LAS float* dstv = isk ? kv : qv; dstv[d] = (a * cs.x - bb * cs.y) * sc; dstv[d + 64] = (bb * cs.x + a * cs.y) * sc; }
    else if (tid < 384) { vv[tid - 128] = bf1(P_PROJ[prow + C_RV + h * 256 + (tid - 128)]); }
    __syncthreads();
    const float qk = wave_sum(qv[lane] * kv[lane] + qv[lane + 64] * kv[lane + 64]);
    const f32x4 v4 = *(const LAS f32x4*)(vv + 4 * lane);
    f32x4 o4 = {0.f, 0.f, 0.f, 0.f};
    const size_t sbase = (size_t)unit * 32768;
#pragma unroll 4
    for (int i = 0; i < 16; ++i) { const int d = w + 8 * i; const size_t off = sbase + (size_t)d * 256 + 4 * lane;
        const f32x4 s0 = *(const GAS f32x4*)(args.in[I_SR] + off); const float qd = qv[d] * gamma, kd = kv[d];
        o4 += s0 * qd; const f32x4 s1 = s0 * gamma + v4 * kd; *(GAS f32x4*)(args.out + O_RS + off) = s1; }
    *(LAS f32x4*)(red + w * 256 + 4 * lane) = o4;
    __syncthreads();
    float o = 0.f;
    if (tid < 256) {
#pragma unroll
        for (int i = 0; i < 8; ++i) o += red[i * 256 + tid];
        o += qk * vv[tid]; }
    const float ssq = wave_sum(o * o);
    if (lane == 0) red2[w] = ssq;
    __syncthreads();
    if (tid < 256) { const float tot = red2[0] + red2[1] + red2[2] + red2[3]; const float rn = 1.0f / sqrtf(tot * (1.0f / 256.0f) + EPS);
        const float rg = bf1(P_PROJ[prow + C_RG + h * 256 + tid]); const float sg = rg / (1.0f + __expf(-rg));
        P_MIX[(size_t)(MPROMPT + b) * DM + 2048 + h * 256 + tid] = (bf16)(cvtpk(sg * o * rn, 0.f) & 0xffffu); }
}
DEVI void ret_scan(Frame& F, const Args& args) {
    const int gt = blockIdx.x * NTHR + F.tid, NGT = F.G * NTHR;
    for (int g4 = gt; g4 < 16 * 8192; g4 += NGT) {
        const int bh = g4 >> 13, within = g4 & 8191, h = bh & 7;
        const float g128 = exp2f(128.0f * ret_log2_gamma(h));
        f32x4 S = {0.f, 0.f, 0.f, 0.f};
        const GAS f32x4* src = (const GAS f32x4*)P_KVT + (size_t)bh * NCHUNK * 8192 + within; GAS u32x2* dst = (GAS u32x2*)P_ST + (size_t)bh * NCHUNK * 8192 + within;
#pragma unroll 8
        for (int c = 0; c < NCHUNK; ++c) { const f32x4 kv = src[(size_t)c * 8192]; u32x2 w; w.x = cvtpk(S[0], S[1]); w.y = cvtpk(S[2], S[3]); dst[(size_t)c * 8192] = w; S = S * g128 + kv; }
        const int e = within >> 5, d0 = (within & 31) * 4;
#pragma unroll
        for (int i = 0; i < 4; ++i) args.out[O_RP + ((size_t)bh * 128 + d0 + i) * 256 + e] = S[i];
    }
}
DEVI void ret_out_unit(Frame& F, const Args& args, int unit) {
    const int c = unit & 31, h = (unit >> 5) & 7, b = unit >> 8;
    LAS bf16* Km = (LAS bf16*)(F.lds); LAS bf16* Vt = (LAS bf16*)(F.lds + 34816);
    const int lane = F.lane, w = F.wave, fr = lane & 15, fq = lane >> 4;
    const float lg2 = ret_log2_gamma(h);
    __syncthreads();
    ret_stage_k<false>(F, args, Km, b, h, c, lg2);
    ret_stage_vt(F, args, Vt, b, h, c);
    __syncthreads();
    int l = 16 * w + fr; asm volatile("" : "+v"(l));
    const int t = c * 128 + l; const size_t row = (size_t)b * SEQ + t;
    bf16x8 qf[4], qdf[4];
    {
        float qa[4][8]; const bf16* qp = P_PROJ + row * NIN + C_RQ + h * 128 + 8 * fq;
#pragma unroll
        for (int s = 0; s < 4; ++s) { const v4u r = *(const GAS v4u*)(qp + 32 * s); unpack8(r, qa[s]); }
        const float dec = exp2f((float)(l + 1) * lg2);
#pragma unroll
        for (int s = 0; s < 2; ++s) { const GAS f2v* rt = (const GAS f2v*)P_ROT + (size_t)t * 64 + 32 * s + 8 * fq;
            float lo[8], hi[8], lod[8], hid[8];
#pragma unroll
            for (int i = 0; i < 8; ++i) { const f2v cs = rt[i]; lo[i] = qa[s][i] * cs.x - qa[s + 2][i] * cs.y; hi[i] = qa[s + 2][i] * cs.x + qa[s][i] * cs.y; lod[i] = lo[i] * dec; hid[i] = hi[i] * dec; }
            qf[s] = __builtin_bit_cast(bf16x8, pack8(lo)); qf[s + 2] = __builtin_bit_cast(bf16x8, pack8(hi)); qdf[s] = __builtin_bit_cast(bf16x8, pack8(lod)); qdf[s + 2] = __builtin_bit_cast(bf16x8, pack8(hid)); }
    }
    f32x4 sacc[8];
#pragma unroll
    for (int mt = 0; mt < 8; ++mt) { sacc[mt] = (f32x4){0.f, 0.f, 0.f, 0.f};
        if (mt <= w) {
#pragma unroll
            for (int s = 0; s < 4; ++s) { const bf16x8 kf = *(const LAS bf16x8*)(Km + (16 * mt + fr) * 136 + 32 * s + 8 * fq); sacc[mt] = MFMA16(kf, qf[s], sacc[mt]); }
#pragma unroll
            for (int r = 0; r < 4; ++r) { const int diff = l - (16 * mt + 4 * fq + r); sacc[mt][r] = (diff >= 0) ? sacc[mt][r] * exp2f((float)diff * lg2) : 0.f; }
        } }
    bf16x8 pf[4];
#pragma unroll
    for (int ks = 0; ks < 4; ++ks) { v4u pw; pw.x = cvtpk(sacc[2 * ks][0], sacc[2 * ks][1]); pw.y = cvtpk(sacc[2 * ks][2], sacc[2 * ks][3]); pw.z = cvtpk(sacc[2 * ks + 1][0], sacc[2 * ks + 1][1]); pw.w = cvtpk(sacc[2 * ks + 1][2], sacc[2 * ks + 1][3]); pf[ks] = __builtin_bit_cast(bf16x8, pw); }
    f32x4 oacc[16];
    const bf16* stp = P_ST + (size_t)unit * 32768;
#pragma unroll
    for (int et = 0; et < 16; ++et) { f32x4 o = (f32x4){0.f, 0.f, 0.f, 0.f};
#pragma unroll
        for (int ks = 0; ks < 4; ++ks) if (2 * ks <= w) { const LAS bf16* vp = Vt + (16 * et + fr) * 136 + 32 * ks + 4 * fq; const u32x2 a = *(const LAS u32x2*)vp, cc = *(const LAS u32x2*)(vp + 16);
            const v4u vv = {a.x, a.y, cc.x, cc.y}; o = MFMA16(__builtin_bit_cast(bf16x8, vv), pf[ks], o); }
#pragma unroll
        for (int s = 0; s < 4; ++s) { const bf16x8 sf = __builtin_bit_cast(bf16x8, *(const GAS v4u*)(stp + (size_t)(16 * et + fr) * 128 + 32 * s + 8 * fq)); o = MFMA16(sf, qdf[s], o); }
        oacc[et] = o; asm volatile("" ::: "memory"); }
    float ss = 0.f;
#pragma unroll
    for (int et = 0; et < 16; ++et) ss += (oacc[et][0] * oacc[et][0] + oacc[et][1] * oacc[et][1]) + (oacc[et][2] * oacc[et][2] + oacc[et][3] * oacc[et][3]);
    ss += __shfl_xor(ss, 16); ss += __shfl_xor(ss, 32);
    const float rn = 1.0f / sqrtf(ss * (1.0f / 256.0f) + EPS);
    const bf16* gp = P_PROJ + row * NIN + C_RG + h * 256 + 4 * fq; bf16* op = P_MIX + row * DM + 2048 + h * 256 + 4 * fq;
#pragma unroll
    for (int et = 0; et < 16; ++et) { const u32x2 gw = *(const GAS u32x2*)(gp + 16 * et); const float gg[4] = {bflo(gw.x), bfhi(gw.x), bflo(gw.y), bfhi(gw.y)}; float r4[4];
#pragma unroll
        for (int r = 0; r < 4; ++r) r4[r] = gg[r] / (1.0f + __expf(-gg[r])) * oacc[et][r] * rn;
        u32x2 ow; ow.x = cvtpk(r4[0], r4[1]); ow.y = cvtpk(r4[2], r4[3]); *(GAS u32x2*)(op + 16 * et) = ow; }
}
DEVI void conv_gate_pass(Frame& F, const Args& args) {
    const int gt = blockIdx.x * NTHR + F.tid, NGT = F.G * NTHR;
    const float* cw = args.in[I_CW]; const float* cb = args.in[I_CB];
    constexpr int NCG = DFF / 8;
    for (int task = gt; task < (MPROMPT / 32) * NCG; task += NGT) {
        const int seg = task / NCG, cg = task - seg * NCG, r0 = seg * 32, j0 = cg * 8;
        float w0[16], w1[16], w2[16], bs[16];
#pragma unroll
        for (int i = 0; i < 8; ++i) { w0[i] = cw[j0 + i]; w1[i] = cw[NUP + j0 + i]; w2[i] = cw[2 * NUP + j0 + i]; bs[i] = cb[j0 + i];
            w0[8 + i] = cw[DFF + j0 + i]; w1[8 + i] = cw[NUP + DFF + j0 + i]; w2[8 + i] = cw[2 * NUP + DFF + j0 + i]; bs[8 + i] = cb[DFF + j0 + i]; }
        float p2[16], p1[16];
        const bool first = (r0 & (SEQ - 1)) == 0;
        if (first) {
#pragma unroll
            for (int i = 0; i < 16; ++i) { p2[i] = 0.f; p1[i] = 0.f; }
        } else { const bf16* ua = P_U + (size_t)(r0 - 2) * NUP + j0; float t8[8];
            unpack8(*(const GAS v4u*)ua, t8);
#pragma unroll
            for (int i = 0; i < 8; ++i) p2[i] = t8[i];
            unpack8(*(const GAS v4u*)(ua + DFF), t8);
#pragma unroll
            for (int i = 0; i < 8; ++i) p2[8 + i] = t8[i];
            unpack8(*(const GAS v4u*)(ua + NUP), t8);
#pragma unroll
            for (int i = 0; i < 8; ++i) p1[i] = t8[i];
            unpack8(*(const GAS v4u*)(ua + NUP + DFF), t8);
#pragma unroll
            for (int i = 0; i < 8; ++i) p1[8 + i] = t8[i]; }
#pragma unroll 4
        for (int r = 0; r < 32; ++r) { const int row = r0 + r; const bf16* up = P_U + (size_t)row * NUP + j0;
            const v4u rg = *(const GAS v4u*)up, rv = *(const GAS v4u*)(up + DFF); float cur[16]; { float t8[8]; unpack8(rg, t8);
#pragma unroll
                for (int i = 0; i < 8; ++i) cur[i] = t8[i];
                unpack8(rv, t8);
#pragma unroll
                for (int i = 0; i < 8; ++i) cur[8 + i] = t8[i]; }
            float a8[8];
#pragma unroll
            for (int i = 0; i < 8; i += 2) { const float cg0 = bs[i] + w0[i] * p2[i] + w1[i] * p1[i] + w2[i] * cur[i], cg1 = bs[i + 1] + w0[i + 1] * p2[i + 1] + w1[i + 1] * p1[i + 1] + w2[i + 1] * cur[i + 1];
                const float cv0 = bs[8 + i] + w0[8 + i] * p2[8 + i] + w1[8 + i] * p1[8 + i] + w2[8 + i] * cur[8 + i], cv1 = bs[9 + i] + w0[9 + i] * p2[9 + i] + w1[9 + i] * p1[9 + i] + w2[9 + i] * cur[9 + i];
                const pg8::f32x2 ge = pg8::gelu_pk((pg8::f32x2){cg0, cg1}); a8[i] = ge.x * cv0; a8[i + 1] = ge.y * cv1; }
            *(GAS v4u*)(P_ACT + (size_t)row * DFF + j0) = pack8(a8);
            if ((row & (SEQ - 1)) >= SEQ - 2) { float* oc = args.out + O_CP + ((size_t)(row >> 12) * 2 + ((row & (SEQ - 1)) - (SEQ - 2))) * NUP + j0;
#pragma unroll
                for (int i = 0; i < 8; ++i) { oc[i] = cur[i]; oc[DFF + i] = cur[8 + i]; } }
#pragma unroll
            for (int i = 0; i < 16; ++i) { p2[i] = p1[i]; p1[i] = cur[i]; } }
    }
    for (int task = gt; task < 2 * MSAMPLE * NCG; task += NGT) {
        const int rb = task / NCG, cg = task - rb * NCG, j0 = cg * 8;
        if (rb >= MSAMPLE) { const v4u z = {0u, 0u, 0u, 0u}; *(GAS v4u*)(P_ACT + (size_t)(MREAL + rb - MSAMPLE) * DFF + j0) = z; continue; }
        const int row = MPROMPT + rb; const bf16* up = P_U + (size_t)row * NUP + j0;
        float cur[16]; { float t8[8]; unpack8(*(const GAS v4u*)up, t8);
#pragma unroll
            for (int i = 0; i < 8; ++i) cur[i] = t8[i];
            unpack8(*(const GAS v4u*)(up + DFF), t8);
#pragma unroll
            for (int i = 0; i < 8; ++i) cur[8 + i] = t8[i]; }
        const float* sc0 = args.in[I_SC] + (size_t)rb * 2 * NUP + j0; const float* sc1 = sc0 + NUP;
        float* oc0 = args.out + O_CS + (size_t)rb * 2 * NUP + j0; float* oc1 = oc0 + NUP;
        float a8[8];
#pragma unroll
        for (int i = 0; i < 8; i += 2) {
            const float p2g0 = sc0[i], p2g1 = sc0[i + 1], p1g0 = sc1[i], p1g1 = sc1[i + 1], p2v0 = sc0[DFF + i], p2v1 = sc0[DFF + i + 1], p1v0 = sc1[DFF + i], p1v1 = sc1[DFF + i + 1];
            const float cg0 = cb[j0 + i] + cw[j0 + i] * p2g0 + cw[NUP + j0 + i] * p1g0 + cw[2 * NUP + j0 + i] * cur[i];
            const float cg1 = cb[j0 + i + 1] + cw[j0 + i + 1] * p2g1 + cw[NUP + j0 + i + 1] * p1g1 + cw[2 * NUP + j0 + i + 1] * cur[i + 1];
            const float cv0 = cb[DFF + j0 + i] + cw[DFF + j0 + i] * p2v0 + cw[NUP + DFF + j0 + i] * p1v0 + cw[2 * NUP + DFF + j0 + i] * cur[8 + i];
            const float cv1 = cb[DFF + j0 + i + 1] + cw[DFF + j0 + i + 1] * p2v1 + cw[NUP + DFF + j0 + i + 1] * p1v1 + cw[2 * NUP + DFF + j0 + i + 1] * cur[8 + i + 1];
            const pg8::f32x2 ge = pg8::gelu_pk((pg8::f32x2){cg0, cg1}); a8[i] = ge.x * cv0; a8[i + 1] = ge.y * cv1;
            oc0[i] = p1g0; oc0[i + 1] = p1g1; oc0[DFF + i] = p1v0; oc0[DFF + i + 1] = p1v1;
            oc1[i] = cur[i]; oc1[i + 1] = cur[i + 1]; oc1[DFF + i] = cur[8 + i]; oc1[DFF + i + 1] = cur[8 + i + 1]; }
        *(GAS v4u*)(P_ACT + (size_t)row * DFF + j0) = pack8(a8);
    }
}

__global__ void __launch_bounds__(NTHR, 2) mk_fwd(Args args) {
    extern __shared__ __attribute__((aligned(16))) unsigned char lds[];
    Frame F;
    F.lds = (LAS unsigned char*)lds;
    F.MISC = (volatile LAS unsigned*)(F.lds + MISC_OFF);
    F.tid = threadIdx.x; F.lane = F.tid & 63; F.wave = __builtin_amdgcn_readfirstlane(F.tid >> 6); F.G = gridDim.x;
    unsigned char* ws = args.ws;
    F.ctl = (gu32*)(ws + WS_CTL);
    for (int u = F.tid; u < (LDS_BYTES - LDSCTL_OFF) / 4; u += NTHR) ((LAS unsigned*)(F.lds + LDSCTL_OFF))[u] = 0u;
    __syncthreads();
    XcdBarrier bar; bar.bar = (unsigned*)(F.ctl + CW_BAR); bar.x = 0; bar.st = nullptr;
    if (N_LAUNCHES == 1) bar = xcd_barrier_post((unsigned*)(F.ctl + CW_BAR), F.MISC + 8);
#define GRID_BAR() do { if (N_LAUNCHES == 1) xcd_barrier(bar); } while (0)
    const int lo = args.ph_lo, hi = args.ph_hi;
#ifndef PHASE_MASK
#define PHASE_MASK 0x7ff
#endif
#define IN(k) (((PHASE_MASK >> (k)) & 1) && lo <= (k) && (k) < hi)
#define BOTH(k) (IN(k) && IN((k) + 1))
    typedef pg8::StaticOrder SO;
    if (IN(0)) { p0_prologue(F, args); if (BOTH(0)) GRID_BAR(); }
    if (IN(1)) { pg8::Gemm g{P_A, P_Win_t, MPAD, NIN, DM}; SO S; S.init(MPAD, NIN, F.G, (int)blockIdx.x);
        pg8::EpiBf16S<false> E{P_PROJ, NIN, nullptr};
        pg8::gemm_phase<pg8::EpiBf16S<false>, SO, true, true>(F.lds + RING_OFF, g, S, E);
        if (BOTH(1)) GRID_BAR(); }
    if (IN(2)) {
        for (int u = blockIdx.x; u < 256; u += F.G) attn_prompt_unit(F, args, u);
        for (int u = blockIdx.x; u < 512; u += F.G) ret_kv_unit(F, args, u);
        for (int u = blockIdx.x; u < 512; u += F.G) attn_sample_unit(F, args, u);
        for (int u = blockIdx.x; u < 1024; u += F.G) ret_sample_unit(F, args, u);
        __syncthreads();
        if (BOTH(2)) GRID_BAR(); }
    if (IN(3)) { ret_scan(F, args); if (BOTH(3)) GRID_BAR(); }
    if (IN(4)) { for (int u = blockIdx.x; u < 512; u += F.G) ret_out_unit(F, args, u); __syncthreads(); if (BOTH(4)) GRID_BAR(); }
    if (IN(5)) { pg8::Gemm g{P_MIX, P_Wout_t, MPAD, DM, DM}; SO S; S.init(MPAD, DM, F.G, (int)blockIdx.x);
        pg8::EpiResid E{args.in[I_XP], args.in[I_XS], P_X1, P_A, P_SS1};
        pg8::gemm_phase<pg8::EpiResid, SO, true, true>(F.lds + RING_OFF, g, S, E);
        if (BOTH(5)) GRID_BAR(); }
    if (IN(6)) { pg8::Gemm g{P_A, P_Wup_t, MPAD, NUP, DM}; SO S; S.init(MPAD, NUP, F.G, (int)blockIdx.x);
        pg8::EpiBf16S<true> E{P_U, NUP, P_SS1};
        pg8::gemm_phase<pg8::EpiBf16S<true>, SO, true, true>(F.lds + RING_OFF, g, S, E);
        if (BOTH(6)) GRID_BAR(); }
    if (IN(7)) { conv_gate_pass(F, args); if (BOTH(7)) GRID_BAR(); }
    if (IN(8)) { pg8::Gemm g{P_ACT, P_Wdown_t, MPAD, DM, DFF}; SO S; S.init(MPAD, DM, F.G, (int)blockIdx.x);
        pg8::EpiResid E{P_X1, P_X1 + (size_t)MPROMPT * DM, args.out, P_A, P_SS2};
        pg8::gemm_phase<pg8::EpiResid, SO, true, true>(F.lds + RING_OFF, g, S, E);
        __syncthreads(); }
    if (IN(9)) { int kple = PLED; asm volatile("" : "+s"(kple));
        pg8::Gemm g{P_PB, P_Wproj_t, MPAD, DM, kple}; SO S; S.init(MPAD, DM, F.G, (int)blockIdx.x);
        pg8::EpiBf16S<false> E{P_PLEB, DM, nullptr};
        pg8::gemm_phase<pg8::EpiBf16S<false>, SO, true, true>(F.lds + RING_OFF, g, S, E);
        if (BOTH(9)) GRID_BAR(); }
    if (IN(10)) { pg8::Gemm g{P_A, P_Wgate_t, MPAD, DM, DM}; SO S; S.init(MPAD, DM, F.G, (int)blockIdx.x);
        pg8::EpiPle E{args.out, P_PLEB, P_SS2};
        pg8::gemm_phase<pg8::EpiPle, SO, true, true>(F.lds + RING_OFF, g, S, E); }
#undef IN
#undef BOTH
}

extern "C" void kernel_launch(void* const* d_in, const int* in_sizes, int n_in, void* d_out, int out_size, void* d_ws, size_t ws_size, hipStream_t stream) {
    static int grid = 0;
    if (grid == 0) {
        if (n_in != N_INPUTS || (size_t)out_size != O_END || ws_size < WS_END) { fprintf(stderr, "kernel_launch: unexpected shapes: n_in %d out %d ws %zu; nothing launched\n", n_in, out_size, ws_size); grid = -1; return; }
        int dev = 0, cus = 0, per_cu = 0;
        if (hipGetDevice(&dev) != hipSuccess || hipDeviceGetAttribute(&cus, hipDeviceAttributeMultiprocessorCount, dev) != hipSuccess) { grid = -1; return; }
        if (hipFuncSetAttribute((const void*)mk_fwd, hipFuncAttributeMaxDynamicSharedMemorySize, LDS_BYTES) != hipSuccess) { fprintf(stderr, "kernel_launch: hipFuncSetAttribute failed\n"); grid = -1; return; }
        if (hipOccupancyMaxActiveBlocksPerMultiprocessor(&per_cu, (const void*)mk_fwd, NTHR, LDS_BYTES) != hipSuccess || per_cu < 1) { fprintf(stderr, "kernel_launch: occupancy query says %d blocks per CU\n", per_cu); }
        (void)hipGetLastError();
        grid = cus;
    }
    if (grid < 0) return;
    if (hipMemsetAsync((char*)d_ws + WS_CTL, 0, CTL_ZERO_BYTES, stream) != hipSuccess) return;
    Args a{};
    for (int i = 0; i < N_INPUTS; ++i) a.in[i] = (const float*)d_in[i];
    a.out = (float*)d_out; a.ws = (unsigned char*)d_ws;
    if (N_LAUNCHES == 1) { a.ph_lo = 0; a.ph_hi = N_PHASES; hipLaunchKernelGGL(mk_fwd, dim3(grid), dim3(NTHR), LDS_BYTES, stream, a); }
    else { for (int p = 0; p < N_PHASES; ++p) { a.ph_lo = p; a.ph_hi = p + 1; hipLaunchKernelGGL(mk_fwd, dim3(grid), dim3(NTHR), LDS_BYTES, stream, a); } }
}
```

```cpp
#include <hip/hip_runtime.h>
#include <cstdio>
#include <cstdint>
#include <cmath>
namespace pg8 {
#define PG8_LAS __attribute__((address_space(3)))
typedef unsigned short bf16_t;
typedef short bf16x8 __attribute__((ext_vector_type(8)));
typedef float f32x4 __attribute__((ext_vector_type(4)));
typedef unsigned u32x4 __attribute__((ext_vector_type(4)));
constexpr int BM = 256, BK = 64, HALF = 128, HTB = HALF * BK * 2  , STAGE_BYTES = 8 * HTB, NXCD = 8, WGM = 8;

__host__ __device__ __forceinline__ int lds_byte(int r, int c) { const int st = (r >> 4) * 2 + (c >> 5), rr = r & 15, cc = c & 31, ob = rr * 64 + cc * 2; return st * 1024 + (ob ^ (((ob >> 9) & 1) << 5)); }
__host__ __device__ __forceinline__ void stage_rc(int b, int& R, int& C) { const int st = b / 1024, sb = b % 1024, swz = sb ^ (((sb >> 9) & 1) << 5); R = (st >> 1) * 16 + swz / 64; C = (st & 1) * 32 + (swz % 64) / 2; }
__host__ __device__ __forceinline__ int perm32(int rho) { const int n = rho >> 4, i = rho & 15; return 8 * (i >> 2) + 4 * n + (i & 3); }

struct Unit { int pm, pn; };
struct Gemm { const bf16_t* A; const bf16_t* Bt; int M, N, K; long rsA, ksA, rsB, ksB; };
__host__ __device__ __forceinline__ Gemm gemm_rowmajor(const bf16_t* A, const bf16_t* Bt, int M, int N, int K) { return Gemm{A, Bt, M, N, K, (long)K * 2, 128, (long)K * 2, 128}; }
__host__ __device__ __forceinline__ Gemm gemm_tiled(const bf16_t* A, const bf16_t* Bt, int M, int N, int K, int rowsA, int rowsB) { return Gemm{A, Bt, M, N, K, 128, (long)rowsA * 128, 128, (long)rowsB * 128}; }

struct StaticOrder {
    int nM, nN, nwg, G, c;
    __host__ __device__ void init(int M, int N, int G_, int c_) { nM = M / BM; nN = N / BM; nwg = nM * nN; G = G_; c = c_; }
    __host__ __device__ bool next(int i, Unit& u) const {
        const long L = (long)i * G + c; if (L >= nwg) return false;
        int wgid = (int)L; { const int q = nwg / NXCD, r = nwg % NXCD, xcd = wgid % NXCD, off = wgid / NXCD; wgid = (xcd < r ? xcd * (q + 1) : r * (q + 1) + (xcd - r) * q) + off; }
        const int nig = WGM * nN, gid = wgid / nig, fm = gid * WGM, gsz = (nM - fm) < WGM ? (nM - fm) : WGM;
        u.pm = fm + ((wgid % nig) % gsz); u.pn = (wgid % nig) / gsz; return true;
    }
    __device__ __forceinline__ void a_ready(const Unit&) const {}
    __device__ __forceinline__ void done(const Unit&) const {}
};

__device__ __forceinline__ unsigned cvt_pk_bf16(float lo, float hi) { unsigned r; asm volatile("v_cvt_pk_bf16_f32 %0, %1, %2" : "=v"(r) : "v"(lo), "v"(hi)); return r; }
typedef float f32x2 __attribute__((ext_vector_type(2)));
__device__ __forceinline__ f32x2 gelu_pk(f32x2 v) {
    const f32x2 av = __builtin_elementwise_abs(v), d = av * 0.2316418882f + 1.0f;
    f32x2 t; t.x = __builtin_amdgcn_rcpf(d.x); t.y = __builtin_amdgcn_rcpf(d.y);
    f32x2 q = t * 0.5307027145f + (-0.7265760135f); q = q * t + 0.7107068705f; q = q * t + (-0.142248368f); q = q * t + 0.127414796f; q = q * t;
    const f32x2 s = (v * v) * (-0.72134752044f);
    f32x2 e; e.x = __builtin_amdgcn_exp2f(s.x); e.y = __builtin_amdgcn_exp2f(s.y);
    const f32x2 m = v * (q * e), r = v - m;
    f32x2 o; o.x = v.x < 0.f ? m.x : r.x; o.y = v.y < 0.f ? m.y : r.y; return o;
}

template <int ACT  > struct EpiBf16 {
    static constexpr bool PERM = true, AFTER_DRAIN = false; static_assert(ACT == 0 || ACT == 1, "EpiBf16: ACT is 0 (none) or 1 (gelu_pk)");
    bf16_t* O; int ldc; const float* bias; int split_cols; size_t split_stride; float scale0;
    __device__ __forceinline__ void operator()(const f32x4 (&acc)[2][2][4][2], const Unit& u, int wr, int wc, int fr, int fq) const {
        const int row0 = u.pm * BM + wr * 64 + fr; int colt = u.pn * BM; bf16_t* base = O;
        float sc = 1.f; if (split_cols) { const int t = colt / split_cols; base += (size_t)t * split_stride; colt -= t * split_cols; if (t == 0) sc = scale0; }
        const int col0 = colt + wc * 32 + 8 * fq, bcol0 = u.pn * BM + wc * 32 + 8 * fq;
        f32x4 bv[2][2];
#pragma unroll
        for (int bj = 0; bj < 2; ++bj)
#pragma unroll
            for (int n = 0; n < 2; ++n) bv[bj][n] = bias ? *(const f32x4*)(bias + bcol0 + bj * HALF + 4 * n) : (f32x4){0.f, 0.f, 0.f, 0.f};
#pragma unroll
        for (int ai = 0; ai < 2; ++ai)
#pragma unroll
            for (int m = 0; m < 4; ++m) { bf16_t* rowp = base + (size_t)(row0 + ai * HALF + m * 16) * ldc + col0;
#pragma unroll
                for (int bj = 0; bj < 2; ++bj) { f32x4 v0 = acc[ai][bj][m][0] + bv[bj][0], v1 = acc[ai][bj][m][1] + bv[bj][1];
                    if (ACT == 1) { f32x2 a = gelu_pk((f32x2){v0[0], v0[1]}), b = gelu_pk((f32x2){v0[2], v0[3]}), c = gelu_pk((f32x2){v1[0], v1[1]}), d = gelu_pk((f32x2){v1[2], v1[3]});
                        v0 = (f32x4){a.x, a.y, b.x, b.y}; v1 = (f32x4){c.x, c.y, d.x, d.y}; }
                    v0 = v0 * sc; v1 = v1 * sc; u32x4 w; w.x = cvt_pk_bf16(v0[0], v0[1]); w.y = cvt_pk_bf16(v0[2], v0[3]); w.z = cvt_pk_bf16(v1[0], v1[1]); w.w = cvt_pk_bf16(v1[2], v1[3]);
                    *(u32x4*)(rowp + bj * HALF) = w; } }
    }
};

typedef unsigned u32x2 __attribute__((ext_vector_type(2)));
typedef float f32x2b __attribute__((ext_vector_type(2))); typedef __bf16 bf16x2b __attribute__((ext_vector_type(2)));
__device__ __forceinline__ unsigned cvtpk(float lo, float hi) { f32x2b v = {lo, hi}; bf16x2b b = __builtin_convertvector(v, bf16x2b); return __builtin_bit_cast(unsigned, b); }
constexpr int ROWS_REAL = 8320, ROWS_PROMPT = 8192, DMODEL = 4096;
constexpr float RMS_EPS = 1e-6f;

template <bool SCALE> struct EpiBf16S {
    static constexpr bool PERM = true, AFTER_DRAIN = false;
    bf16_t* O; int ldc; const float* ss;
    __device__ __forceinline__ void operator()(const f32x4 (&acc)[2][2][4][2], const Unit& u, int wr, int wc, int fr, int fq) const {
        const int row0 = u.pm * BM + wr * 64 + fr, col0 = u.pn * BM + wc * 32 + 8 * fq;
        float ssr[2][4];
        if (SCALE) {
#pragma unroll
            for (int ai = 0; ai < 2; ++ai)
#pragma unroll
                for (int m = 0; m < 4; ++m) ssr[ai][m] = ss[row0 + ai * HALF + m * 16];
        }
#pragma unroll
        for (int ai = 0; ai < 2; ++ai)
#pragma unroll
            for (int m = 0; m < 4; ++m) { const int row = row0 + ai * HALF + m * 16; bf16_t* rowp = O + (size_t)row * ldc + col0;
                float sc = 1.f; if (SCALE) sc = __builtin_amdgcn_rsqf(ssr[ai][m] * (1.0f / DMODEL) + RMS_EPS);
#pragma unroll
                for (int bj = 0; bj < 2; ++bj) { const f32x4 v0 = acc[ai][bj][m][0] * sc, v1 = acc[ai][bj][m][1] * sc;
                    u32x4 w; w.x = cvtpk(v0[0], v0[1]); w.y = cvtpk(v0[2], v0[3]); w.z = cvtpk(v1[0], v1[1]); w.w = cvtpk(v1[2], v1[3]);
                    *(u32x4*)(rowp + bj * HALF) = w; } }
    }
};
template <bool BASE_BF16, bool OUT_F32> struct EpiResid {
    static constexpr bool PERM = false, AFTER_DRAIN = false;
    const float* base_p; const float* base_s; float* outf; bf16_t* outb; float* ss;
    __device__ __forceinline__ void operator()(const f32x4 (&acc)[2][2][4][2], const Unit& u, int wr, int wc, int fr, int fq) const {
        const int row0 = u.pm * BM + wr * 64 + fr, col0 = u.pn * BM + wc * 32 + 4 * fq;
        f32x4 bf[2][4]; u32x2 bw[2][4];
#pragma unroll
        for (int g = 0; g <= 8; ++g) {
            if (g < 8) { const int ai = g >> 2, m = g & 3, row = row0 + ai * HALF + m * 16;
                {   const float* bp = BASE_BF16 ? nullptr : ((row < ROWS_PROMPT) ? base_p + (size_t)row * DMODEL : base_s + (size_t)(row - ROWS_PROMPT) * DMODEL);
#pragma unroll
                    for (int bj = 0; bj < 2; ++bj)
#pragma unroll
                        for (int n = 0; n < 2; ++n) { const int c = col0 + bj * HALF + n * 16;
                            if (BASE_BF16) bw[g & 1][bj * 2 + n] = *(const u32x2*)(outb + (size_t)row * DMODEL + c); else bf[g & 1][bj * 2 + n] = *(const f32x4*)(bp + c); }
                } }
            if (g > 0) { const int h = g - 1, ai = h >> 2, m = h & 3, row = row0 + ai * HALF + m * 16;
                {   float s = 0.f;
#pragma unroll
                    for (int bj = 0; bj < 2; ++bj)
#pragma unroll
                        for (int n = 0; n < 2; ++n) { const int c = col0 + bj * HALF + n * 16; f32x4 b4;
                            if (BASE_BF16) { const u32x2 w2 = bw[h & 1][bj * 2 + n]; b4 = (f32x4){__uint_as_float(w2.x << 16), __uint_as_float(w2.x & 0xffff0000u), __uint_as_float(w2.y << 16), __uint_as_float(w2.y & 0xffff0000u)}; }
                            else b4 = bf[h & 1][bj * 2 + n];
                            const f32x4 o = b4 + acc[ai][bj][m][n];
                            if (OUT_F32) *(f32x4*)(outf + (size_t)row * DMODEL + c) = o;
                            s += (o[0] * o[0] + o[1] * o[1]) + (o[2] * o[2] + o[3] * o[3]);
                            u32x2 w; w.x = cvtpk(o[0], o[1]); w.y = cvtpk(o[2], o[3]); *(u32x2*)(outb + (size_t)row * DMODEL + c) = w; }
                    s += __shfl_xor(s, 16); s += __shfl_xor(s, 32);
                    if (fq == 0) atomicAdd(ss + row, s);
                }
                asm volatile("" ::: "memory"); }
        }
    }
};
struct EpiPle {
    static constexpr bool PERM = false, AFTER_DRAIN = false;
    float* y; const bf16_t* x2b; const bf16_t* ple; const float* ss;
    __device__ __forceinline__ void operator()(const f32x4 (&acc)[2][2][4][2], const Unit& u, int wr, int wc, int fr, int fq) const {
        const int row0 = u.pm * BM + wr * 64 + fr, col0 = u.pn * BM + wc * 32 + 4 * fq;
        u32x2 xw[2][4], pw[2][4]; float ssr[2];
#pragma unroll
        for (int g = 0; g <= 8; ++g) {
            if (g < 8) { const int ai = g >> 2, m = g & 3, row = row0 + ai * HALF + m * 16;
                {   ssr[g & 1] = ss[row];
#pragma unroll
                    for (int bj = 0; bj < 2; ++bj)
#pragma unroll
                        for (int n = 0; n < 2; ++n) { const size_t off = (size_t)row * DMODEL + col0 + bj * HALF + n * 16; xw[g & 1][bj * 2 + n] = *(const u32x2*)(x2b + off); pw[g & 1][bj * 2 + n] = *(const u32x2*)(ple + off); }
                } }
            if (g > 0) { const int h = g - 1, ai = h >> 2, m = h & 3, row = row0 + ai * HALF + m * 16;
                {   const float sc = __builtin_amdgcn_rsqf(ssr[h & 1] * (1.0f / DMODEL) + RMS_EPS);
#pragma unroll
                    for (int bj = 0; bj < 2; ++bj)
#pragma unroll
                        for (int n = 0; n < 2; ++n) { const size_t off = (size_t)row * DMODEL + col0 + bj * HALF + n * 16;
                            const u32x2 xv = xw[h & 1][bj * 2 + n], pv = pw[h & 1][bj * 2 + n];
                            const f32x4 x2 = {__uint_as_float(xv.x << 16), __uint_as_float(xv.x & 0xffff0000u), __uint_as_float(xv.y << 16), __uint_as_float(xv.y & 0xffff0000u)};
                            const f32x4 pl = {__uint_as_float(pv.x << 16), __uint_as_float(pv.x & 0xffff0000u), __uint_as_float(pv.y << 16), __uint_as_float(pv.y & 0xffff0000u)};
                            const f32x4 z = acc[ai][bj][m][n] * sc; f32x4 o;
#pragma unroll
                            for (int k = 0; k < 4; ++k) { const float gte = __builtin_amdgcn_rcpf(1.0f + __builtin_amdgcn_exp2f(-1.4426950408889634f * z[k])); o[k] = x2[k] + gte * pl[k]; }
                            *(f32x4*)(y + off) = o; }
                }
                asm volatile("" ::: "memory"); }
        }
    }
};

template <class Epi, class Sched, bool ALIGN_EPI = false, bool SP2 = false>
__device__ __forceinline__ void gemm_phase(PG8_LAS unsigned char* lds, const Gemm g, const Sched& S, const Epi& E) {
    const int tid = threadIdx.x, wid = __builtin_amdgcn_readfirstlane(tid >> 6), lane = tid & 63, wr = wid >> 2, wc = wid & 3, fr = lane & 15, fq = lane >> 4;
    const int K = g.K, nt = K / BK;
    unsigned voffA[2], voffB[2];
#pragma unroll
    for (int i = 0; i < 2; ++i) { int R, C; stage_rc(tid * 16 + i * 8192, R, C); const int Rb = Epi::PERM ? ((R & ~31) + perm32(R & 31)) : R;
        voffA[i] = (unsigned)(R * (int)g.rsA + C * 2); voffB[i] = (unsigned)(Rb * (int)g.rsB + C * 2); }
    const size_t kstepA = (size_t)g.ksA, kstepB = (size_t)g.ksB;
    const size_t hstepA = (size_t)HALF * g.rsA, hstepB = (size_t)HALF * g.rsB;
    const size_t tstepA = 2 * hstepA, tstepB = 2 * hstepB;
    const unsigned ldsw = (unsigned)wid * 1024u;
    const int aoff = lds_byte(wr * 64 + fr, fq * 8), boff = lds_byte(wc * 32 + fr, fq * 8);
#define PG8_SA(b, h) (((b) * 2 + (h)) * HTB)
#define PG8_SB(b, h) ((4 + (b) * 2 + (h)) * HTB)
#define PG8_STAGE(bufoff, gbase, voff) do { _Pragma("unroll") for (int _i = 0; _i < 2; ++_i) \
        __builtin_amdgcn_global_load_lds((const unsigned*)((const char*)(gbase) + (voff)[_i]), (PG8_LAS unsigned*)(lds + (bufoff) + ldsw + _i * 8192), 16, 0, 0); } while (0)
#define PG8_LDA(dst, b, h) do { _Pragma("unroll") for (int m = 0; m < 4; ++m) _Pragma("unroll") for (int k = 0; k < 2; ++k) dst[m][k] = *(const PG8_LAS bf16x8*)(lds + PG8_SA(b, h) + aoff + m * 2048 + k * 1024); } while (0)
#define PG8_LDB(dst, b, h) do { _Pragma("unroll") for (int n = 0; n < 2; ++n) _Pragma("unroll") for (int k = 0; k < 2; ++k) dst[n][k] = *(const PG8_LAS bf16x8*)(lds + PG8_SB(b, h) + boff + n * 2048 + k * 1024); } while (0)
#define PG8_MMA(ai, bj, At, Bt) do { __builtin_amdgcn_s_setprio(1); _Pragma("unroll") for (int m = 0; m < 4; ++m) _Pragma("unroll") for (int n = 0; n < 2; ++n) _Pragma("unroll") for (int k = 0; k < 2; ++k) \
        acc[ai][bj][m][n] = __builtin_amdgcn_mfma_f32_16x16x32_bf16(Bt[n][k], At[m][k], acc[ai][bj][m][n], 0, 0, 0); __builtin_amdgcn_s_setprio(0); } while (0)
#define PG8_WAIT_V(n) asm volatile("s_waitcnt vmcnt(" #n ")" ::: "memory")
#define PG8_WAIT_L(n) asm volatile("s_waitcnt lgkmcnt(" #n ")" ::: "memory")
#define PG8_BAR __builtin_amdgcn_s_barrier()
#define PG8_SCHED __builtin_amdgcn_sched_barrier(0)
    Unit cur, nxt; int ui = 0;
    if (!S.next(0, cur)) return;
    f32x4 acc[2][2][4][2];
#pragma unroll
    for (int a = 0; a < 2; ++a)
#pragma unroll
        for (int b = 0; b < 2; ++b)
#pragma unroll
            for (int m = 0; m < 4; ++m)
#pragma unroll
                for (int n = 0; n < 2; ++n) acc[a][b][m][n] = (f32x4){0.f, 0.f, 0.f, 0.f};
    bf16x8 At[4][2], B0[2][2], B1[2][2];
    const char* cA = (const char*)g.A + (size_t)cur.pm * tstepA; const char* cB = (const char*)g.Bt + (size_t)cur.pn * tstepB;
    S.a_ready(cur);
    if constexpr (SP2) {
        PG8_STAGE(PG8_SB(0, 0), cB, voffB); PG8_STAGE(PG8_SB(0, 1), cB + hstepB, voffB); PG8_STAGE(PG8_SA(0, 0), cA, voffA); PG8_STAGE(PG8_SA(0, 1), cA + hstepA, voffA);
        if (wr == 1) PG8_BAR;
        PG8_WAIT_V(2); PG8_BAR;
        PG8_STAGE(PG8_SB(1, 0), cB + kstepB, voffB); PG8_STAGE(PG8_SA(1, 0), cA + kstepA, voffA); PG8_STAGE(PG8_SB(1, 1), cB + hstepB + kstepB, voffB);
        PG8_WAIT_V(6); PG8_BAR;
    } else {
        PG8_STAGE(PG8_SB(0, 0), cB, voffB); PG8_STAGE(PG8_SA(0, 0), cA, voffA); PG8_STAGE(PG8_SB(0, 1), cB + hstepB, voffB); PG8_STAGE(PG8_SA(0, 1), cA + hstepA, voffA);
        if (wr == 1) PG8_BAR;
        PG8_WAIT_V(4); PG8_BAR;
        PG8_STAGE(PG8_SB(1, 0), cB + kstepB, voffB); PG8_STAGE(PG8_SA(1, 0), cA + kstepA, voffA); PG8_STAGE(PG8_SB(1, 1), cB + hstepB + kstepB, voffB);
        PG8_WAIT_V(6); PG8_BAR;
    }
    for (;;) {
        const bool has_next = S.next(ui + 1, nxt);
        const char* nA = has_next ? (const char*)g.A + (size_t)nxt.pm * tstepA : cA; const char* nB = has_next ? (const char*)g.Bt + (size_t)nxt.pn * tstepB : cB;
        for (int t = 0; t < nt; t += 2) {
            const bool last = (t == nt - 2);
            const char* a1 = cA + (size_t)(t + 1) * kstepA;
            const char* a2 = last ? nA : cA + (size_t)(t + 2) * kstepA; const char* b2 = last ? nB : cB + (size_t)(t + 2) * kstepB;
            const char* a3 = a2 + kstepA; const char* b3 = b2 + kstepB;
            if (last && has_next) S.a_ready(nxt);
            if constexpr (SP2) {
            PG8_LDB(B0, 0, 0); PG8_LDB(B1, 0, 1); PG8_SCHED; PG8_LDA(At, 0, 0); PG8_STAGE(PG8_SA(1, 1), a1 + hstepA, voffA);
            PG8_WAIT_V(8); PG8_WAIT_L(0); PG8_BAR; PG8_MMA(0, 0, At, B0); PG8_MMA(0, 1, At, B1); PG8_BAR; PG8_SCHED;
            PG8_LDA(At, 0, 1); PG8_STAGE(PG8_SB(0, 0), b2, voffB); PG8_STAGE(PG8_SB(0, 1), b2 + hstepB, voffB); PG8_STAGE(PG8_SA(0, 0), a2, voffA);
            PG8_WAIT_V(8); PG8_WAIT_L(0); PG8_BAR; PG8_MMA(1, 0, At, B0); PG8_MMA(1, 1, At, B1); PG8_BAR; PG8_SCHED;
            PG8_LDB(B0, 1, 0); PG8_LDB(B1, 1, 1); PG8_SCHED; PG8_LDA(At, 1, 0); PG8_STAGE(PG8_SA(0, 1), a2 + hstepA, voffA);
            PG8_WAIT_V(8); PG8_WAIT_L(0); PG8_BAR; PG8_MMA(0, 0, At, B0); PG8_MMA(0, 1, At, B1); PG8_BAR; PG8_SCHED;
            PG8_LDA(At, 1, 1); PG8_STAGE(PG8_SB(1, 0), b3, voffB); PG8_STAGE(PG8_SB(1, 1), b3 + hstepB, voffB); PG8_STAGE(PG8_SA(1, 0), a3, voffA);
            PG8_WAIT_V(8); PG8_WAIT_L(0); PG8_BAR; PG8_MMA(1, 0, At, B0); PG8_MMA(1, 1, At, B1); PG8_BAR; PG8_SCHED;
            } else {
            PG8_LDB(B0, 0, 0); PG8_SCHED; PG8_LDA(At, 0, 0); PG8_STAGE(PG8_SA(1, 1), a1 + hstepA, voffA);
            PG8_WAIT_L(8); PG8_BAR; PG8_WAIT_L(0); PG8_MMA(0, 0, At, B0); PG8_BAR; PG8_SCHED;
            PG8_LDB(B1, 0, 1); PG8_STAGE(PG8_SB(0, 0), b2, voffB);
            PG8_BAR; PG8_WAIT_L(0); PG8_MMA(0, 1, At, B1); PG8_BAR;
            PG8_LDA(At, 0, 1); PG8_STAGE(PG8_SA(0, 0), a2, voffA);
            PG8_BAR; PG8_WAIT_L(0); PG8_MMA(1, 0, At, B0); PG8_BAR; PG8_SCHED;
            PG8_STAGE(PG8_SB(0, 1), b2 + hstepB, voffB);
            PG8_WAIT_V(6); PG8_BAR; PG8_MMA(1, 1, At, B1); PG8_BAR;
            PG8_LDB(B0, 1, 0); PG8_SCHED; PG8_LDA(At, 1, 0); PG8_STAGE(PG8_SA(0, 1), a2 + hstepA, voffA);
            PG8_WAIT_L(8); PG8_BAR; PG8_WAIT_L(0); PG8_MMA(0, 0, At, B0); PG8_BAR; PG8_SCHED;
            PG8_LDB(B1, 1, 1); PG8_STAGE(PG8_SB(1, 0), b3, voffB);
            PG8_BAR; PG8_WAIT_L(0); PG8_MMA(0, 1, At, B1); PG8_BAR;
            PG8_LDA(At, 1, 1); PG8_STAGE(PG8_SA(1, 0), a3, voffA);
            PG8_BAR; PG8_WAIT_L(0); PG8_MMA(1, 0, At, B0); PG8_BAR; PG8_SCHED;
            PG8_STAGE(PG8_SB(1, 1), b3 + hstepB, voffB);
            PG8_WAIT_V(6); PG8_BAR; PG8_MMA(1, 1, At, B1); PG8_BAR;
            }
        }
        if constexpr (ALIGN_EPI) { if (wr == 0) PG8_BAR; }
        if constexpr (!Epi::AFTER_DRAIN) { E(acc, cur, wr, wc, fr, fq); S.done(cur); }
        if (!has_next) break;
#pragma unroll
        for (int a = 0; a < 2; ++a)
#pragma unroll
            for (int b = 0; b < 2; ++b)
#pragma unroll
                for (int m = 0; m < 4; ++m)
#pragma unroll
                    for (int n = 0; n < 2; ++n) acc[a][b][m][n] = (f32x4){0.f, 0.f, 0.f, 0.f};
        cur = nxt; cA = nA; cB = nB; ++ui;
        if constexpr (ALIGN_EPI) { if (wr == 1) PG8_BAR; }
    }
    PG8_WAIT_V(0);
    if constexpr (!ALIGN_EPI) { if (wr == 0) PG8_BAR; }
    PG8_BAR;
    if constexpr (Epi::AFTER_DRAIN) { E.fused(acc, cur, wr, wc, fr, fq, lds, wid, lane); S.done(cur); }
#undef PG8_SA
#undef PG8_SB
#undef PG8_STAGE
#undef PG8_LDA
#undef PG8_LDB
#undef PG8_MMA
#undef PG8_WAIT_V
#undef PG8_WAIT_L
#undef PG8_BAR
#undef PG8_SCHED
}
}
#define GAS __attribute__((address_space(1)))
#define LAS __attribute__((address_space(3)))
typedef unsigned short bf16;
typedef unsigned v4u __attribute__((ext_vector_type(4)));
typedef float f32x4 __attribute__((ext_vector_type(4)));
typedef short bf16x8 __attribute__((ext_vector_type(8)));
typedef GAS unsigned gu32;
typedef GAS unsigned long long gu64;
#define RLX_AGENT __ATOMIC_RELAXED, __HIP_MEMORY_SCOPE_AGENT
#define LDS_WAIT() asm volatile("s_waitcnt lgkmcnt(0)" ::: "memory")
#define VM_WAIT() asm volatile("s_waitcnt vmcnt(0)" ::: "memory")
__device__ __forceinline__ unsigned long long rt() { return __builtin_amdgcn_s_memrealtime(); }
__device__ __forceinline__ unsigned f2bf(float f) { unsigned u = __builtin_bit_cast(unsigned, f); return (u + 0x7fffu + ((u >> 16) & 1u)) >> 16; }
__device__ __forceinline__ unsigned pk2(float lo, float hi) { return f2bf(lo) | (f2bf(hi) << 16); }
#define XB_TMO      128
#define XB_XCNT(j)  (256  + 64 * (j))
#define XB_XSUB(j)  (1280 + 64 * (j))
#define XB_XGEN(j)  (2304 + 64 * (j))
#define XB_TOP      3328
#define XB_TOPGEN   3392
#define XCD_BAR_WORDS 3456
#define XB_SPIN_CAP (1u << 18)

__device__ __forceinline__ unsigned xb_ld(unsigned* p)              { return __hip_atomic_load(p, __ATOMIC_RELAXED, __HIP_MEMORY_SCOPE_AGENT); }
__device__ __forceinline__ unsigned xb_add(unsigned* p, unsigned v) { return __hip_atomic_fetch_add(p, v, __ATOMIC_RELAXED, __HIP_MEMORY_SCOPE_AGENT); }
__device__ __forceinline__ unsigned xb_xcc_id() { return (unsigned)__builtin_amdgcn_s_getreg((3 << 11) | 20) & 0xFu; }
#define XB_SPIN(cond, bar) do { unsigned _sp = 0; while (cond) { __builtin_amdgcn_s_sleep(1); \
    if ((++_sp & 255u) == 0u) { if (xb_ld(&(bar)[XB_TMO])) break; if (_sp > XB_SPIN_CAP) { atomicAdd(&(bar)[XB_TMO], 1u); break; } } } } while (0)

struct XcdBarrier {
    unsigned* bar; unsigned x;
    volatile LAS unsigned* st;
};

__device__ __forceinline__ XcdBarrier xcd_barrier_post(unsigned* bar, volatile LAS unsigned* st) {
    XcdBarrier b; b.bar = bar; b.x = xb_xcc_id(); b.st = st;
    if (threadIdx.x == 0) (void)xb_add(&bar[XB_XCNT(b.x)], 1u);
    return b;
}
__device__ __forceinline__ void xcd_barrier_complete(unsigned* bar, unsigned x, unsigned& nloc, unsigned& nx) {
    const unsigned G = gridDim.x * gridDim.y * gridDim.z;
    unsigned sum, cnt, mine, sp = 0u;
    for (;;) {
        sum = 0u; cnt = 0u; mine = 0u;
#pragma unroll
        for (unsigned j = 0; j < 16; ++j) { const unsigned c = xb_ld(&bar[XB_XCNT(j)]); sum += c; cnt += (c > 0u) ? 1u : 0u; mine = (j == x) ? c : mine; }
        if (sum == G) break;
        __builtin_amdgcn_s_sleep(1);
        if ((++sp & 255u) == 0u) { if (xb_ld(&bar[XB_TMO])) break; if (sp > XB_SPIN_CAP) { atomicAdd(&bar[XB_TMO], 1u); break; } }
    }
    nloc = mine > 0u ? mine : 1u; nx = cnt > 0u ? cnt : 1u;
}

__device__ __forceinline__ void xcd_barrier(const XcdBarrier& b) {
    asm volatile("s_waitcnt vmcnt(0)" ::: "memory");
    __syncthreads();
    if (threadIdx.x == 0) {
        unsigned* bar = b.bar;
        __builtin_amdgcn_s_waitcnt(0);
        unsigned nloc = b.st[0], nx = b.st[1];
        if (nloc == 0u) { xcd_barrier_complete(bar, b.x, nloc, nx); b.st[0] = nloc; b.st[1] = nx; }
        const unsigned old = xb_add(&bar[XB_XSUB(b.x)], 1u);
        const unsigned gen = old / nloc;
        if (old + 1u == (gen + 1u) * nloc) {
            __builtin_amdgcn_fence(__ATOMIC_RELEASE, "agent");
            asm volatile("s_waitcnt vmcnt(0)" ::: "memory");
            const unsigned og = xb_add(&bar[XB_TOP], 1u);
            const unsigned tg = og / nx;
            if (og + 1u == (tg + 1u) * nx) xb_add(&bar[XB_TOPGEN], 1u);
            else XB_SPIN(xb_ld(&bar[XB_TOPGEN]) == tg, bar);
            __builtin_amdgcn_fence(__ATOMIC_ACQUIRE, "agent");
            xb_add(&bar[XB_XGEN(b.x)], 1u);
            asm volatile("s_waitcnt vmcnt(0)" ::: "memory");
        } else {
            XB_SPIN(xb_ld(&bar[XB_XGEN(b.x)]) == gen, bar);
            __builtin_amdgcn_fence(__ATOMIC_ACQUIRE, "agent");
            asm volatile("s_waitcnt vmcnt(0)" ::: "memory");
        }
    }
    __syncthreads();
}

#ifndef MK_N_LAUNCHES
#define MK_N_LAUNCHES 1
#endif
constexpr int N_LAUNCHES = MK_N_LAUNCHES;
constexpr int N_PHASES = 11;
constexpr int NWAVES = 8, NTHR = 512;
constexpr int DM = 4096, SEQ = 4096, NBATCH = 2, MPROMPT = 8192, MSAMPLE = 128, MREAL = 8320, MPAD = 8448;
constexpr int NIN = 8704, DFF = 11008, NUP = 22016, PLED = 256;
constexpr int C_AQ = 0, C_AK = 2048, C_AV = 2304, C_RQ = 2560, C_RK = 3584, C_RV = 4608, C_RG = 6656;
constexpr int NCHUNK = 32;
constexpr int PAST = 8192;
constexpr float EPS = 1e-6f;
enum { I_XP = 0, I_XS, I_PP, I_PS, I_CK, I_CV, I_SR, I_SC, I_RB, I_GMIX, I_WIN, I_GQ, I_GK, I_SINK, I_WOUT, I_GFFN, I_WUP, I_CW, I_CB, I_WDOWN, I_GPLE, I_WGATE, I_WPROJ, N_INPUTS };
constexpr size_t O_YP = 0, O_YS = 33554432, O_WKP = 34078720, O_WVP = 34144256, O_RP = 34209792, O_CP = 34734080, O_WKS = 34822144, O_WVS = 39016448, O_RS = 43210752, O_CS = 76765184, O_END = 82401280;
constexpr size_t MiB = 1u << 20;
constexpr size_t WS_CTL = 0, CTL_ZERO_BYTES = 1 * MiB;
constexpr size_t WS_ROT = 1 * MiB, WS_WIN = 4 * MiB, WS_WOUT = 72 * MiB, WS_WUP = 104 * MiB, WS_WDOWN = 276 * MiB, WS_WGATE = 362 * MiB, WS_WPROJ = 394 * MiB;
constexpr size_t WS_A = 396 * MiB, WS_X1 = 462 * MiB, WS_PB = 594 * MiB, WS_PLE = 599 * MiB, WS_ACT = 665 * MiB, WS_U = 843 * MiB;
constexpr size_t WS_PROJ = 843 * MiB, WS_MIX = 984 * MiB, WS_KVT = 1050 * MiB, WS_ST = 1114 * MiB, WS_END = 1198 * MiB;
static_assert(WS_WIN + (size_t)NIN * DM * 2 <= WS_WOUT && WS_WUP + (size_t)NUP * DM * 2 <= WS_WDOWN && WS_WDOWN + (size_t)DM * DFF * 2 <= WS_WGATE, "ws map (weights)");
static_assert(WS_A + (size_t)MPAD * DM * 2 <= WS_X1 && WS_X1 + (size_t)MPAD * DM * 4 <= WS_PB && WS_PB + (size_t)MPAD * PLED * 2 <= WS_PLE && WS_PLE + (size_t)MPAD * DM * 2 <= WS_ACT, "ws map (act)");
static_assert(WS_ACT + (size_t)MPAD * DFF * 2 <= WS_U && WS_U + (size_t)MPAD * NUP * 2 <= WS_END, "ws map (u)");
static_assert(WS_PROJ + (size_t)MPAD * NIN * 2 <= WS_MIX && WS_MIX + (size_t)MPAD * DM * 2 <= WS_KVT && WS_KVT + (size_t)16 * NCHUNK * 32768 * 4 <= WS_ST && WS_ST + (size_t)16 * NCHUNK * 32768 * 2 <= WS_END, "ws map (overlay)");
static_assert(WS_ROT + (size_t)4097 * 64 * 8 <= WS_WIN, "ws map (rot)");
constexpr int CW_TMO = 0, CW_CODE = 1, CW_BAR = 4096, CW_SS1 = 65536, CW_SS2 = 65536 + 16384, CW_XRANK = 200000;
static_assert((CW_SS2 + MPAD) * 4 <= (int)CTL_ZERO_BYTES && (CW_XRANK + 16 * 64) * 4 <= (int)CTL_ZERO_BYTES && CW_XRANK >= CW_SS2 + MPAD, "ctl");
constexpr int RING_OFF = 0, RING_BYTES = 131072, LDS_BYTES = 147456, LDSCTL_OFF = LDS_BYTES - 1024, MISC_OFF = LDSCTL_OFF + 320;
static_assert(8 * 64 * 65 * 4 <= LDSCTL_OFF, "transpose scratch");

#define DEVI __device__ __forceinline__
typedef unsigned u32x2 __attribute__((ext_vector_type(2)));
typedef float f2v __attribute__((ext_vector_type(2)));

DEVI size_t tiled_off(int row, int k) { return ((size_t)(k >> 5) * 128 + row) * 32 + (k & 31); }
DEVI float bflo(unsigned w) { return __uint_as_float(w << 16); }
DEVI float bfhi(unsigned w) { return __uint_as_float(w & 0xffff0000u); }
DEVI float bf1(unsigned short b) { return __uint_as_float((unsigned)b << 16); }
DEVI void unpack8(const v4u r, float (&f)[8]) { f[0] = bflo(r.x); f[1] = bfhi(r.x); f[2] = bflo(r.y); f[3] = bfhi(r.y); f[4] = bflo(r.z); f[5] = bfhi(r.z); f[6] = bflo(r.w); f[7] = bfhi(r.w); }
DEVI unsigned cvtpk(float lo, float hi) { return pg8::cvtpk(lo, hi); }
DEVI v4u pack8(const float (&f)[8]) { v4u w; w.x = cvtpk(f[0], f[1]); w.y = cvtpk(f[2], f[3]); w.z = cvtpk(f[4], f[5]); w.w = cvtpk(f[6], f[7]); return w; }
DEVI float wave_sum(float v) {
#pragma unroll
    for (int o = 1; o < 64; o <<= 1) v += __shfl_xor(v, o);
    return v;
}
DEVI float wave_max(float v) {
#pragma unroll
    for (int o = 1; o < 64; o <<= 1) v = fmaxf(v, __shfl_xor(v, o));
    return v;
}
#define MFMA16(a, b, c) __builtin_amdgcn_mfma_f32_16x16x32_bf16((a), (b), (c), 0, 0, 0)

struct Args { const float* in[N_INPUTS]; float* out; unsigned char* ws; int ph_lo, ph_hi; };
#define P_Win_t ((bf16*)(args.ws + WS_WIN))
#define P_Wout_t ((bf16*)(args.ws + WS_WOUT))
#define P_Wup_t ((bf16*)(args.ws + WS_WUP))
#define P_Wdown_t ((bf16*)(args.ws + WS_WDOWN))
#define P_Wgate_t ((bf16*)(args.ws + WS_WGATE))
#define P_Wproj_t ((bf16*)(args.ws + WS_WPROJ))
#define P_A ((bf16*)(args.ws + WS_A))
#define P_PB ((bf16*)(args.ws + WS_PB))
#define P_PLEB ((bf16*)(args.ws + WS_PLE))
#define P_ACT ((bf16*)(args.ws + WS_ACT))
#define P_U ((bf16*)(args.ws + WS_U))
#define P_PROJ ((bf16*)(args.ws + WS_PROJ))
#define P_MIX ((bf16*)(args.ws + WS_MIX))
#define P_ST ((bf16*)(args.ws + WS_ST))
#define P_X1 ((float*)(args.ws + WS_X1))
#define P_KVT ((bf16*)(args.ws + WS_KVT))
#define P_ROT ((f2v*)(args.ws + WS_ROT))
#define P_OACC ((float*)(args.ws + WS_X1))
#define P_MIXS ((bf16*)(args.ws + WS_X1 + 2 * MiB))
#define P_X2BS ((bf16*)(args.ws + WS_X1 + 4 * MiB))
#define P_ACTS ((bf16*)(args.ws + WS_X1 + 8 * MiB))
#define P_PBS  ((bf16*)(args.ws + WS_X1 + 12 * MiB))
#define P_SS1 ((float*)(args.ws + WS_CTL) + CW_SS1)
#define P_SS2 ((float*)(args.ws + WS_CTL) + CW_SS2)
struct Frame {
    LAS unsigned char* lds;
    volatile LAS unsigned* MISC;
    gu32* ctl;
    int tid, lane, wave, G, vc;
};

struct TrItem { const float* W; const float* ks; bf16* WT; int K, N, r; };
constexpr int IT_IN = (DM / 64) * (NIN / 64), IT_OUT = (DM / 64) * (DM / 64), IT_UP = (DM / 64) * (NUP / 64), IT_DOWN = (DFF / 64) * (DM / 64), IT_GATE = IT_OUT, IT_PROJ = (PLED / 64) * (DM / 64);
constexpr int TR_UP_IN_P0 = 5000;
constexpr int TR_END_P0 = IT_IN + TR_UP_IN_P0, TR_END_G1 = IT_IN + IT_UP + IT_OUT + IT_PROJ, TR_END_G3 = TR_END_G1 + IT_DOWN + IT_GATE;
DEVI TrItem tr_decode(const Args& args, int it) {
    TrItem t; int r = it;
    if (r < IT_IN) { t.W = args.in[I_WIN]; t.ks = nullptr; t.WT = P_Win_t; t.K = DM; t.N = NIN; t.r = r; return t; } r -= IT_IN;
    if (r < IT_UP) { t.W = args.in[I_WUP]; t.ks = args.in[I_GFFN]; t.WT = P_Wup_t; t.K = DM; t.N = NUP; t.r = r; return t; } r -= IT_UP;
    if (r < IT_OUT) { t.W = args.in[I_WOUT]; t.ks = nullptr; t.WT = P_Wout_t; t.K = DM; t.N = DM; t.r = r; return t; } r -= IT_OUT;
    if (r < IT_PROJ) { t.W = args.in[I_WPROJ]; t.ks = nullptr; t.WT = P_Wproj_t; t.K = PLED; t.N = DM; t.r = r; return t; } r -= IT_PROJ;
    if (r < IT_DOWN) { t.W = args.in[I_WDOWN]; t.ks = nullptr; t.WT = P_Wdown_t; t.K = DFF; t.N = DM; t.r = r; return t; } r -= IT_DOWN;
    t.W = args.in[I_WGATE]; t.ks = args.in[I_GPLE]; t.WT = P_Wgate_t; t.K = DM; t.N = DM; t.r = r; return t;
}
constexpr int TR_NITEMS = (DM / 64) * (NIN / 64) + 2 * (DM / 64) * (DM / 64) + (DM / 64) * (NUP / 64) + (DFF / 64) * (DM / 64) + (PLED / 64) * (DM / 64);
constexpr int TR_SCR_BYTES = 64 * 65 * 4;
struct TrRegs { f32x4 v[16]; f32x4 k0, k1; };
DEVI void tr_load(const TrItem& t, int lane, TrRegs& R) {
    const int nblk = t.N / 64, kb = t.r / nblk, nb = t.r - kb * nblk; const float* src = t.W + (size_t)(64 * kb + (lane >> 4)) * t.N + 64 * nb + (lane & 15) * 4;
#pragma unroll
    for (int i = 0; i < 16; ++i) R.v[i] = __builtin_nontemporal_load((const GAS f32x4*)(src + (size_t)(4 * i) * t.N));
    if (t.ks) { const float* kp = t.ks + 64 * kb + 8 * (lane & 7); R.k0 = *(const GAS f32x4*)kp; R.k1 = *(const GAS f32x4*)(kp + 4); }
    else { R.k0 = (f32x4){1.f, 1.f, 1.f, 1.f}; R.k1 = R.k0; }
}
DEVI void tr_store(const TrItem& t, int lane, const TrRegs& R, LAS float* scr) {
    const int nblk = t.N / 64, kb = t.r / nblk, nb = t.r - kb * nblk, k0 = 64 * kb, n0 = 64 * nb;
#pragma unroll
    for (int i = 0; i < 16; ++i) { LAS float* d = scr + (4 * i + (lane >> 4)) * 65 + (lane & 15) * 4; d[0] = R.v[i][0]; d[1] = R.v[i][1]; d[2] = R.v[i][2]; d[3] = R.v[i][3]; }
    LDS_WAIT(); asm volatile("" ::: "memory");
    const int c = lane & 7;
#pragma unroll
    for (int j = 0; j < 8; ++j) { const int n = (lane >> 3) + 8 * j; const LAS float* s = scr + (8 * c) * 65 + n;
        v4u o; o.x = cvtpk(s[0 * 65] * R.k0[0], s[1 * 65] * R.k0[1]); o.y = cvtpk(s[2 * 65] * R.k0[2], s[3 * 65] * R.k0[3]); o.z = cvtpk(s[4 * 65] * R.k1[0], s[5 * 65] * R.k1[1]); o.w = cvtpk(s[6 * 65] * R.k1[2], s[7 * 65] * R.k1[3]);
        *(GAS v4u*)(t.WT + (size_t)(n0 + n) * t.K + k0 + 8 * c) = o; }
    LDS_WAIT(); asm volatile("" ::: "memory");
}
DEVI void tr_run(const Args& args, int it, int last, int stride, int lane, LAS float* scr) {
    if (it >= last) return;
    TrRegs Ra, Rb; TrItem t = tr_decode(args, it); tr_load(t, lane, Ra);
    for (;;) {
        int nx = it + stride; bool more = nx < last; TrItem tn = t;
        if (more) { tn = tr_decode(args, nx); tr_load(tn, lane, Rb); }
        tr_store(t, lane, Ra, scr);
        if (!more) break;
        t = tn; it = nx; nx = it + stride; more = nx < last;
        if (more) { tn = tr_decode(args, nx); tr_load(tn, lane, Ra); }
        tr_store(t, lane, Rb, scr);
        if (!more) break;
        t = tn; it = nx;
    }
}
DEVI void rms_row_to_bf16(const float* xrow, const float* g, bf16* orow, int lane) {
    const GAS f32x4* xr = (const GAS f32x4*)xrow + lane; const GAS f32x4* gr = (const GAS f32x4*)g + lane;
    f32x4 v[16]; float s = 0.f;
#pragma unroll
    for (int j = 0; j < 16; ++j) { v[j] = __builtin_nontemporal_load(xr + 64 * j); s += (v[j].x * v[j].x + v[j].y * v[j].y) + (v[j].z * v[j].z + v[j].w * v[j].w); }
    f32x4 gv_[16];
#pragma unroll
    for (int j = 0; j < 16; ++j) gv_[j] = gr[64 * j];
    const float rstd = 1.0f / sqrtf(wave_sum(s) * (1.0f / DM) + EPS);
    GAS u32x2* o8 = (GAS u32x2*)orow + lane;
#pragma unroll
    for (int j = 0; j < 16; ++j) { const f32x4 gv = gv_[j]; u32x2 w; w.x = cvtpk(v[j].x * rstd * gv.x, v[j].y * rstd * gv.y); w.y = cvtpk(v[j].z * rstd * gv.z, v[j].w * rstd * gv.w); o8[64 * j] = w; }
}
DEVI void p0_prologue(Frame& F, const Args& args) {
    LAS float* scr = (LAS float*)(F.lds + RING_OFF + F.wave * TR_SCR_BYTES);
    const int gw = blockIdx.x * NWAVES + F.wave, NGW = F.G * NWAVES;
    const int gt = blockIdx.x * NTHR + F.tid, NGT = F.G * NTHR;
#ifndef P0X_DUP
#define P0X_DUP 1
#endif
    for (int xr_ = 0; xr_ < P0X_DUP; ++xr_) {
    for (int idx = gt; idx < 4097 * 64; idx += NGT) { const int pi = idx >> 6, i = idx & 63; const float pos = (pi == 4096) ? (float)PAST : (float)pi;
        const float inv = powf(10000.0f, -(float)i * (1.0f / 64.0f)); const float ang = pos * inv; float sn, cs; sincosf(ang, &sn, &cs); P_ROT[idx] = (f2v){cs, sn}; }
    for (int idx = gt; idx < MPAD * 32; idx += NGT) { const int row = idx >> 5, ch = idx & 31; v4u o = {0u, 0u, 0u, 0u};
        if (row < MREAL) { const float* src = (row < MPROMPT) ? args.in[I_PP] + (size_t)row * PLED : args.in[I_PS] + (size_t)(row - MPROMPT) * PLED;
            const f32x4 a = *(const GAS f32x4*)(src + ch * 8), b = *(const GAS f32x4*)(src + ch * 8 + 4); o.x = cvtpk(a.x, a.y); o.y = cvtpk(a.z, a.w); o.z = cvtpk(b.x, b.y); o.w = cvtpk(b.z, b.w); }
        *(GAS v4u*)(P_PB + (size_t)row * PLED + ch * 8) = o; if (row >= MPROMPT && row < MREAL) *(GAS v4u*)(P_PBS + tiled_off(row - MPROMPT, ch * 8)) = o; }
    for (int idx = gt; idx < 1024 * 256 / 4; idx += NGT) *(GAS f32x4*)(P_OACC + (size_t)idx * 4) = (f32x4){0.f, 0.f, 0.f, 0.f};
    for (int idx = gt; idx < (MPAD - MREAL) * (DM / 8); idx += NGT) { const v4u z = {0u, 0u, 0u, 0u}; const size_t off = (size_t)MREAL * DM + (size_t)idx * 8;
        *(GAS v4u*)(P_A + off) = z; *(GAS v4u*)(P_MIX + off) = z; }
    for (int m = gw; m < MREAL; m += NGW) { const float* xr = (m < MPROMPT) ? args.in[I_XP] + (size_t)m * DM : args.in[I_XS] + (size_t)(m - MPROMPT) * DM; rms_row_to_bf16(xr, args.in[I_GMIX], P_A + (size_t)m * DM, F.lane); }
    }
    tr_run(args, gw, TR_END_P0, NGW, F.lane, scr);
}

DEVI int t5_bucket(int n) {
    if (n < 16) return n;
    const float v = logf((float)n * (1.0f / 16.0f)) / 2.0794415416798357f * 16.0f;
    const int l = 16 + (int)v; return l < 31 ? l : 31;
}
DEVI void attn_prompt_unit(Frame& F, const Args& args, int unit) {
    const int qb = unit & 31, kvh = (unit >> 5) & 3, b = unit >> 7;
    LAS bf16* Kh = (LAS bf16*)(F.lds);
    LAS bf16* Vt = (LAS bf16*)(F.lds + 36864);
    LAS float* biasT = (LAS float*)(F.lds + 36864 + 33792);
    const int tid = F.tid, lane = F.lane, g = F.wave, fr = lane & 15, fq = lane >> 4;
    const float* gk = args.in[I_GK]; const float* gq = args.in[I_GQ];
    const int sitem = unit * 8 + g, su = sitem >> 1, hf = sitem & 1, sh = su & 7, sb = su >> 3;
    const float sgamma = 1.0f - exp2f(-5.0f - (float)sh);
    float sq_sel, sk_sel, sqk; f32x4 sv4;
    {   const bf16* pq = P_PROJ + (size_t)(MPROMPT + sb) * NIN + C_RQ + sh * 128; const bf16* pk = P_PROJ + (size_t)(MPROMPT + sb) * NIN + C_RK + sh * 128;
        const float qa = bf1(pq[lane]), qb_ = bf1(pq[lane + 64]), ka = bf1(pk[lane]), kb_ = bf1(pk[lane + 64]); const f2v cs = P_ROT[(size_t)4096 * 64 + lane];
        const float q_lo = qa * cs.x - qb_ * cs.y, q_hi = qb_ * cs.x + qa * cs.y, k_lo = (ka * cs.x - kb_ * cs.y) * 0.08838834764831845f, k_hi = (kb_ * cs.x + ka * cs.y) * 0.08838834764831845f;
        sqk = wave_sum(q_lo * k_lo + q_hi * k_hi); sq_sel = (hf ? q_hi : q_lo) * sgamma; sk_sel = hf ? k_hi : k_lo;
        const u32x2 vw = *(const GAS u32x2*)(P_PROJ + (size_t)(MPROMPT + sb) * NIN + C_RV + sh * 256 + 4 * lane); sv4 = (f32x4){bflo(vw.x), bfhi(vw.x), bflo(vw.y), bfhi(vw.y)}; }
    const size_t soff = (size_t)su * 32768 + (size_t)(64 * hf) * 256 + 4 * lane;
    f32x4 sbuf[8], so4 = {0.f, 0.f, 0.f, 0.f};
#pragma unroll
    for (int i = 0; i < 8; ++i) sbuf[i] = __builtin_nontemporal_load((const GAS f32x4*)(args.in[I_SR] + soff + (size_t)i * 256));
    __syncthreads();
    for (int task = tid; task < 2048; task += NTHR) {
        const int key = task >> 3, ch = task & 7, tok = (qb - 1) * 128 + key;
        v4u kr = {0u, 0u, 0u, 0u}, vr = {0u, 0u, 0u, 0u};
        if (tok >= 0) { const bf16* rp = P_PROJ + (size_t)(b * SEQ + tok) * NIN + kvh * 64 + ch * 8; kr = *(const GAS v4u*)(rp + C_AK); vr = *(const GAS v4u*)(rp + C_AV); }
        float kf[8], vf[8]; unpack8(kr, kf); unpack8(vr, vf);
        float ss = 0.f;
#pragma unroll
        for (int i = 0; i < 8; ++i) ss += kf[i] * kf[i];
        ss += __shfl_xor(ss, 1); ss += __shfl_xor(ss, 2); ss += __shfl_xor(ss, 4);
        const float rstd = 1.0f / sqrtf(ss * (1.0f / 64.0f) + EPS);
#pragma unroll
        for (int i = 0; i < 8; ++i) kf[i] = kf[i] * rstd * gk[ch * 8 + i];
        *(LAS v4u*)(Kh + key * 72 + ch * 8) = pack8(kf);
        const unsigned vw[4] = {vr.x, vr.y, vr.z, vr.w};
#pragma unroll
        for (int i = 0; i < 8; ++i) Vt[(ch * 8 + i) * 264 + key] = (bf16)((i & 1) ? (vw[i >> 1] >> 16) : (vw[i >> 1] & 0xffffu));
        if (qb == 31 && key >= 128) {
            float* ok = args.out + O_WKP + ((size_t)(b * 128 + (key - 128)) * 4 + kvh) * 64 + ch * 8; float* ov = args.out + O_WVP + ((size_t)(b * 128 + (key - 128)) * 4 + kvh) * 64 + ch * 8;
            *(GAS f32x4*)ok = (f32x4){kf[0], kf[1], kf[2], kf[3]}; *(GAS f32x4*)(ok + 4) = (f32x4){kf[4], kf[5], kf[6], kf[7]};
            *(GAS f32x4*)ov = (f32x4){vf[0], vf[1], vf[2], vf[3]}; *(GAS f32x4*)(ov + 4) = (f32x4){vf[4], vf[5], vf[6], vf[7]};
        }
    }
    for (int i = tid; i < 8 * 129; i += NTHR) { const int gg = i / 129, dist = i - gg * 129; biasT[gg * 132 + dist] = args.in[I_RB][t5_bucket(dist) * 32 + kvh * 8 + gg]; }
    __syncthreads();
    const int head = kvh * 8 + g; const float sink = args.in[I_SINK][head];
    float gqv[2][8];
#pragma unroll
    for (int s = 0; s < 2; ++s)
#pragma unroll
        for (int i = 0; i < 8; ++i) gqv[s][i] = gq[32 * s + 8 * fq + i] * 0.125f;
    const bf16* qbase = P_PROJ + ((size_t)b * SEQ + qb * 128 + fr) * NIN + C_AQ + head * 64 + 8 * fq;
    v4u qn0 = *(const GAS v4u*)qbase, qn1 = *(const GAS v4u*)(qbase + 32);
    for (int j = 0; j < 8; ++j) {
        {
#pragma unroll
            for (int i = 0; i < 8; ++i) { const float qd = __builtin_bit_cast(float, __builtin_amdgcn_readlane(__builtin_bit_cast(int, sq_sel), 8 * j + i)), kd = __builtin_bit_cast(float, __builtin_amdgcn_readlane(__builtin_bit_cast(int, sk_sel), 8 * j + i));
                const f32x4 s0 = sbuf[i]; so4 += s0 * qd; const f32x4 s1 = s0 * sgamma + sv4 * kd;
                __builtin_nontemporal_store(s1, (GAS f32x4*)(args.out + O_RS + soff + (size_t)(8 * j + i) * 256)); }
            if (j < 7) {
#pragma unroll
                for (int i = 0; i < 8; ++i) sbuf[i] = __builtin_nontemporal_load((const GAS f32x4*)(args.in[I_SR] + soff + (size_t)(8 * (j + 1) + i) * 256)); }
        }
        const size_t row = (size_t)b * SEQ + qb * 128 + 16 * j + fr;
        float q0[8], q1[8]; unpack8(qn0, q0); unpack8(qn1, q1);
        { const int jn = j < 7 ? j + 1 : 7; qn0 = *(const GAS v4u*)(qbase + (size_t)(16 * jn) * NIN); qn1 = *(const GAS v4u*)(qbase + (size_t)(16 * jn) * NIN + 32); }
        float ss = 0.f;
#pragma unroll
        for (int i = 0; i < 8; ++i) ss += q0[i] * q0[i] + q1[i] * q1[i];
        ss += __shfl_xor(ss, 16); ss += __shfl_xor(ss, 32);
        const float rstd = 1.0f / sqrtf(ss * (1.0f / 64.0f) + EPS);
#pragma unroll
        for (int i = 0; i < 8; ++i) { q0[i] *= rstd * gqv[0][i]; q1[i] *= rstd * gqv[1][i]; }
        bf16x8 qf[2]; qf[0] = __builtin_bit_cast(bf16x8, pack8(q0)); qf[1] = __builtin_bit_cast(bf16x8, pack8(q1));
        const int start = (16 * j < 96) ? 16 * j : 96;
        f32x4 sacc[10];
#pragma unroll
        for (int t = 0; t < 10; ++t) { sacc[t] = (f32x4){0.f, 0.f, 0.f, 0.f};
#pragma unroll
            for (int s = 0; s < 2; ++s) { const bf16x8 kfr = *(const LAS bf16x8*)(Kh + (start + 16 * t + fr) * 72 + 32 * s + 8 * fq); sacc[t] = MFMA16(kfr, qf[s], sacc[t]); } }
        float mx = -INFINITY;
#pragma unroll
        for (int t = 0; t < 10; ++t)
#pragma unroll
            for (int r = 0; r < 4; ++r) { const int key = start + 16 * t + 4 * fq + r, dist = 128 + 16 * j + fr - key; const bool valid = (dist >= 0) && (dist <= 128) && (qb > 0 || key >= 128);
                const int dc = dist < 0 ? 0 : (dist > 128 ? 128 : dist);
                const float sv = valid ? sacc[t][r] + biasT[g * 132 + dc] : -INFINITY; sacc[t][r] = sv; mx = fmaxf(mx, sv); }
        mx = fmaxf(mx, __shfl_xor(mx, 16)); mx = fmaxf(mx, __shfl_xor(mx, 32)); mx = fmaxf(mx, sink);
        float l = 0.f;
#pragma unroll
        for (int t = 0; t < 10; ++t)
#pragma unroll
            for (int r = 0; r < 4; ++r) { const float e = __expf(sacc[t][r] - mx); sacc[t][r] = e; l += e; }
        l += __shfl_xor(l, 16); l += __shfl_xor(l, 32); l += __expf(sink - mx);
        const float rl = 1.0f / l;
        bf16x8 pf[5];
#pragma unroll
        for (int ks = 0; ks < 5; ++ks) { v4u w; w.x = cvtpk(sacc[2 * ks][0] * rl, sacc[2 * ks][1] * rl); w.y = cvtpk(sacc[2 * ks][2] * rl, sacc[2 * ks][3] * rl);
            w.z = cvtpk(sacc[2 * ks + 1][0] * rl, sacc[2 * ks + 1][1] * rl); w.w = cvtpk(sacc[2 * ks + 1][2] * rl, sacc[2 * ks + 1][3] * rl); pf[ks] = __builtin_bit_cast(bf16x8, w); }
        bf16* op = P_MIX + row * DM + head * 64 + 4 * fq;
#pragma unroll
        for (int dt = 0; dt < 4; ++dt) { f32x4 o = (f32x4){0.f, 0.f, 0.f, 0.f};
#pragma unroll
            for (int ks = 0; ks < 5; ++ks) { const LAS bf16* vp = Vt + (16 * dt + fr) * 264 + start + 32 * ks + 4 * fq; const u32x2 a = *(const LAS u32x2*)vp, c = *(const LAS u32x2*)(vp + 16);
                const v4u vv = {a.x, a.y, c.x, c.y}; o = MFMA16(__builtin_bit_cast(bf16x8, vv), pf[ks], o); }
            u32x2 w; w.x = cvtpk(o[0], o[1]); w.y = cvtpk(o[2], o[3]); *(GAS u32x2*)(op + 16 * dt) = w; }
    }
    if (hf == 0) so4 += sv4 * sqk;
    { float* oa = P_OACC + (size_t)su * 256 + 4 * lane; atomicAdd(oa, so4[0]); atomicAdd(oa + 1, so4[1]); atomicAdd(oa + 2, so4[2]); atomicAdd(oa + 3, so4[3]); }
}
DEVI void sret_finalize(Frame& F, const Args& args) {
    const int gw = blockIdx.x * NWAVES + F.wave, NGW = F.G * NWAVES, lane = F.lane;
    for (int su = gw; su < 1024; su += NGW) { const int sh = su & 7, sb = su >> 3;
        const f32x4 o = *(const GAS f32x4*)(P_OACC + (size_t)su * 256 + 4 * lane);
        const float ssq = wave_sum((o[0] * o[0] + o[1] * o[1]) + (o[2] * o[2] + o[3] * o[3])); const float rn = 1.0f / sqrtf(ssq * (1.0f / 256.0f) + EPS);
        const u32x2 gw2 = *(const GAS u32x2*)(P_PROJ + (size_t)(MPROMPT + sb) * NIN + C_RG + sh * 256 + 4 * lane); const float gg[4] = {bflo(gw2.x), bfhi(gw2.x), bflo(gw2.y), bfhi(gw2.y)}; float r4[4];
#pragma unroll
        for (int r = 0; r < 4; ++r) r4[r] = gg[r] / (1.0f + __expf(-gg[r])) * o[r] * rn;
        u32x2 ow; ow.x = cvtpk(r4[0], r4[1]); ow.y = cvtpk(r4[2], r4[3]); *(GAS u32x2*)(P_MIXS + tiled_off(sb, 2048 + sh * 256 + 4 * lane)) = ow; }
}
DEVI void attn_sample_unit(Frame& F, const Args& args, int unit) {
    const int kvh = unit & 3, b = unit >> 2;
    LAS float* Kc = (LAS float*)(F.lds);
    LAS float* Vc = (LAS float*)(F.lds + 33792);
    LAS float* qs = (LAS float*)(F.lds + 33792 + 33280);
    LAS float* pl = qs + 512;
    LAS float* biasT = pl + 8 * 132;
    const int tid = F.tid, lane = F.lane, g = F.wave;
    const size_t prow = (size_t)(MPROMPT + b) * NIN;
    __syncthreads();
    for (int idx = tid; idx < 128 * 16; idx += NTHR) { const int j = idx >> 4, c4 = idx & 15; const size_t src = ((size_t)(b * 128 + j) * 4 + kvh) * 64 + c4 * 4;
        const f32x4 kv = *(const GAS f32x4*)(args.in[I_CK] + src), vv = *(const GAS f32x4*)(args.in[I_CV] + src);
        Kc[j * 65 + c4 * 4 + 0] = kv.x; Kc[j * 65 + c4 * 4 + 1] = kv.y; Kc[j * 65 + c4 * 4 + 2] = kv.z; Kc[j * 65 + c4 * 4 + 3] = kv.w;
        *(LAS f32x4*)(Vc + j * 64 + c4 * 4) = vv;
        if (j >= 1) { const size_t dst = ((size_t)(b * 128 + (j - 1)) * 4 + kvh) * 64 + c4 * 4; *(GAS f32x4*)(args.out + O_WKS + dst) = kv; *(GAS f32x4*)(args.out + O_WVS + dst) = vv; } }
    {
        const int head = kvh * 8 + g; const float qv = bf1(P_PROJ[prow + C_AQ + head * 64 + lane]);
        const float ss = wave_sum(qv * qv); qs[g * 64 + lane] = qv * (1.0f / sqrtf(ss * (1.0f / 64.0f) + EPS)) * args.in[I_GQ][lane] * 0.125f;
    }
    if (g == 0) { const float kv = bf1(P_PROJ[prow + C_AK + kvh * 64 + lane]); const float ss = wave_sum(kv * kv); const float kn = kv * (1.0f / sqrtf(ss * (1.0f / 64.0f) + EPS)) * args.in[I_GK][lane];
        Kc[128 * 65 + lane] = kn; args.out[O_WKS + ((size_t)(b * 128 + 127) * 4 + kvh) * 64 + lane] = kn; }
    if (g == 1) { const float vv = bf1(P_PROJ[prow + C_AV + kvh * 64 + lane]); Vc[128 * 64 + lane] = vv; args.out[O_WVS + ((size_t)(b * 128 + 127) * 4 + kvh) * 64 + lane] = vv; }
    for (int i = tid; i < 8 * 129; i += NTHR) { const int gg = i / 129, dist = i - gg * 129; biasT[gg * 132 + dist] = args.in[I_RB][t5_bucket(dist) * 32 + kvh * 8 + gg]; }
    __syncthreads();
    {
        const float sink = args.in[I_SINK][kvh * 8 + g];
        float s0 = 0.f, s1 = 0.f, s2 = 0.f;
        for (int d = 0; d < 64; ++d) { const float q = qs[g * 64 + d]; s0 += q * Kc[lane * 65 + d]; s1 += q * Kc[(lane + 64) * 65 + d]; s2 += q * Kc[128 * 65 + d]; }
        s0 += biasT[g * 132 + (128 - lane)]; s1 += biasT[g * 132 + (64 - lane)]; s2 += biasT[g * 132 + 0];
        float mx = wave_max(fmaxf(s0, s1)); mx = fmaxf(mx, fmaxf(s2, sink));
        const float e0 = __expf(s0 - mx), e1 = __expf(s1 - mx), e2 = __expf(s2 - mx);
        const float l = wave_sum(e0 + e1) + e2 + __expf(sink - mx); const float rl = 1.0f / l;
        pl[g * 132 + lane] = e0 * rl; pl[g * 132 + 64 + lane] = e1 * rl; if (lane == 0) pl[g * 132 + 128] = e2 * rl;
    }
    __syncthreads();
    {
        float o = 0.f;
        for (int j = 0; j < 129; ++j) o += pl[g * 132 + j] * Vc[j * 64 + lane];
        P_MIXS[tiled_off(b, (kvh * 8 + g) * 64 + lane)] = (bf16)(cvtpk(o, 0.f) & 0xffffu);
    }
}
struct RetKRegs { v4u r0[2], r1[2]; f32x4 cs[2][4]; };
DEVI void ret_k_issue(int tid, const Args& args, RetKRegs& R, int b, int h, int c) {
#pragma unroll
    for (int it = 0; it < 2; ++it) { const int task = tid + it * NTHR, m = task & 127, ch = task >> 7;
        const int t = c * 128 + m; const bf16* rp = P_PROJ + (size_t)(b * SEQ + t) * NIN + C_RK + h * 128 + ch * 8;
        R.r0[it] = *(const GAS v4u*)rp; R.r1[it] = *(const GAS v4u*)(rp + 64);
        const GAS f32x4* rt = (const GAS f32x4*)((const GAS f2v*)P_ROT + (size_t)t * 64 + ch * 8);
#pragma unroll
        for (int j = 0; j < 4; ++j) R.cs[it][j] = rt[j]; }
}
template <bool TRANSPOSED> DEVI void ret_k_write(int tid, const RetKRegs& R, LAS bf16* Kd, float lg2) {
#pragma unroll
    for (int it = 0; it < 2; ++it) { const int task = tid + it * NTHR, m = task & 127, ch = task >> 7;
        float a[8], bb[8]; unpack8(R.r0[it], a); unpack8(R.r1[it], bb);
        float sc = 0.08838834764831845f; if (TRANSPOSED) sc *= exp2f((float)(127 - m) * lg2);
        float lo[8], hi[8];
#pragma unroll
        for (int i = 0; i < 8; ++i) { const float cx = R.cs[it][i >> 1][(i & 1) * 2], cy = R.cs[it][i >> 1][(i & 1) * 2 + 1]; lo[i] = (a[i] * cx - bb[i] * cy) * sc; hi[i] = (bb[i] * cx + a[i] * cy) * sc; }
        if (TRANSPOSED) {
#pragma unroll
            for (int i = 0; i < 8; i += 2) { const unsigned wl = cvtpk(lo[i], lo[i + 1]), wh = cvtpk(hi[i], hi[i + 1]);
                Kd[(ch * 8 + i) * 136 + m] = (bf16)(wl & 0xffffu); Kd[(ch * 8 + i + 1) * 136 + m] = (bf16)(wl >> 16);
                Kd[(64 + ch * 8 + i) * 136 + m] = (bf16)(wh & 0xffffu); Kd[(64 + ch * 8 + i + 1) * 136 + m] = (bf16)(wh >> 16); }
        } else { *(LAS v4u*)(Kd + m * 136 + ch * 8) = pack8(lo); *(LAS v4u*)(Kd + m * 136 + 64 + ch * 8) = pack8(hi); }
    }
}
struct RetVRegs { v4u r[8]; };
DEVI void ret_v_issue(int tid, const Args& args, RetVRegs& R, int b, int h, int c) {
#pragma unroll
    for (int it = 0; it < 8; ++it) { const int task = tid + it * NTHR, m = task & 127, ch = task >> 7;
        R.r[it] = *(const GAS v4u*)(P_PROJ + (size_t)(b * SEQ + c * 128 + m) * NIN + C_RV + h * 256 + ch * 8); }
}
DEVI void ret_v_write(int tid, const RetVRegs& R, LAS bf16* Vt) {
#pragma unroll
    for (int it = 0; it < 8; ++it) { const int task = tid + it * NTHR, m = task & 127, ch = task >> 7;
        const unsigned w[4] = {R.r[it].x, R.r[it].y, R.r[it].z, R.r[it].w};
#pragma unroll
        for (int i = 0; i < 8; ++i) Vt[(ch * 8 + i) * 136 + m] = (bf16)((i & 1) ? (w[i >> 1] >> 16) : (w[i >> 1] & 0xffffu)); }
}
DEVI float ret_log2_gamma(int h) { return log2f(1.0f - exp2f(-5.0f - (float)h)); }
DEVI void ret_kv_unit(Frame& F, const Args& args, int unit) {
    const int c = unit & 31, h = (unit >> 5) & 7, b = unit >> 8;
    LAS bf16* Kt = (LAS bf16*)(F.lds); LAS bf16* Vt = (LAS bf16*)(F.lds + 34816);
    const int lane = F.lane, w = F.wave, fr = lane & 15, fq = lane >> 4;
    int tidl = F.tid; asm volatile("" : "+v"(tidl));
    RetKRegs RK; RetVRegs RV; ret_k_issue(tidl, args, RK, b, h, c); ret_v_issue(tidl, args, RV, b, h, c);
    __syncthreads();
    ret_k_write<true>(tidl, RK, Kt, ret_log2_gamma(h)); ret_v_write(tidl, RV, Vt);
    __syncthreads();
    f32x4 acc[8][2];
#pragma unroll
    for (int dt = 0; dt < 8; ++dt) { acc[dt][0] = (f32x4){0.f, 0.f, 0.f, 0.f}; acc[dt][1] = (f32x4){0.f, 0.f, 0.f, 0.f}; }
#pragma unroll
    for (int ks = 0; ks < 4; ++ks) {
        bf16x8 vf[2];
#pragma unroll
        for (int et = 0; et < 2; ++et) vf[et] = *(const LAS bf16x8*)(Vt + (32 * w + 16 * et + fr) * 136 + 32 * ks + 8 * fq);
#pragma unroll
        for (int dt = 0; dt < 8; ++dt) { const bf16x8 kf = *(const LAS bf16x8*)(Kt + (16 * dt + fr) * 136 + 32 * ks + 8 * fq);
            acc[dt][0] = MFMA16(kf, vf[0], acc[dt][0]); acc[dt][1] = MFMA16(kf, vf[1], acc[dt][1]); }
    }
    bf16* dst = P_KVT + (size_t)unit * 32768;
#pragma unroll
    for (int dt = 0; dt < 8; ++dt)
#pragma unroll
        for (int et = 0; et < 2; ++et) { u32x2 kw; kw.x = cvtpk(acc[dt][et][0], acc[dt][et][1]); kw.y = cvtpk(acc[dt][et][2], acc[dt][et][3]); *(GAS u32x2*)(dst + (size_t)(32 * w + 16 * et + fr) * 128 + 16 * dt + 4 * fq) = kw; }
}
DEVI void ret_sample_unit(Frame& F, const Args& args, int unit) {
    const int h = unit & 7, b = unit >> 3;
    LAS float* qv = (LAS float*)(F.lds); LAS float* kv = qv + 128; LAS float* vv = kv + 128; LAS float* red = vv + 256; LAS float* red2 = red + 8 * 256;
    const int tid = F.tid, lane = F.lane, w = F.wave;
    const size_t prow = (size_t)(MPROMPT + b) * NIN;
    const float gamma = 1.0f - exp2f(-5.0f - (float)h);
    const size_t sbase = (size_t)unit * 32768;
    f32x4 s0v[16];
#pragma unroll
    for (int i = 0; i < 16; ++i) s0v[i] = __builtin_nontemporal_load((const GAS f32x4*)(args.in[I_SR] + sbase + (size_t)(w + 8 * i) * 256 + 4 * lane));
    __syncthreads();
    if (tid < 128) { const int d = tid & 63, isk = tid >> 6; const bf16* rp = P_PROJ + prow + (isk ? C_RK : C_RQ) + h * 128;
        const float a = bf1(rp[d]), bb = bf1(rp[d + 64]); const f2v cs = P_ROT[(size_t)4096 * 64 + d]; const float sc = isk ? 0.08838834764831845f : 1.0f;
        LAS float* dstv = isk ? kv : qv; dstv[d] = (a * cs.x - bb * cs.y) * sc; dstv[d + 64] = (bb * cs.x + a * cs.y) * sc; }
    else if (tid < 384) { vv[tid - 128] = bf1(P_PROJ[prow + C_RV + h * 256 + (tid - 128)]); }
    __syncthreads();
    const float qk = wave_sum(qv[lane] * kv[lane] + qv[lane + 64] * kv[lane + 64]);
    const f32x4 v4 = *(const LAS f32x4*)(vv + 4 * lane);
    f32x4 o4 = {0.f, 0.f, 0.f, 0.f};
#pragma unroll
    for (int i = 0; i < 16; ++i) { const int d = w + 8 * i; const size_t off = sbase + (size_t)d * 256 + 4 * lane;
        const f32x4 s0 = s0v[i]; const float qd = qv[d] * gamma, kd = kv[d];
        o4 += s0 * qd; const f32x4 s1 = s0 * gamma + v4 * kd; __builtin_nontemporal_store(s1, (GAS f32x4*)(args.out + O_RS + off)); }
    *(LAS f32x4*)(red + w * 256 + 4 * lane) = o4;
    __syncthreads();
    float o = 0.f;
    if (tid < 256) {
#pragma unroll
        for (int i = 0; i < 8; ++i) o += red[i * 256 + tid];
        o += qk * vv[tid]; }
    const float ssq = wave_sum(o * o);
    if (lane == 0) red2[w] = ssq;
    __syncthreads();
    if (tid < 256) { const float tot = red2[0] + red2[1] + red2[2] + red2[3]; const float rn = 1.0f / sqrtf(tot * (1.0f / 256.0f) + EPS);
        const float rg = bf1(P_PROJ[prow + C_RG + h * 256 + tid]); const float sg = rg / (1.0f + __expf(-rg));
        P_MIX[(size_t)(MPROMPT + b) * DM + 2048 + h * 256 + tid] = (bf16)(cvtpk(sg * o * rn, 0.f) & 0xffffu); }
}
DEVI void ret_scan(Frame& F, const Args& args) {
    LAS float* tl = (LAS float*)(F.lds);
    for (int tile = blockIdx.x; tile < 16 * 16; tile += F.G) {
        const int g4 = tile * NTHR + F.tid, bh = g4 >> 13, within = g4 & 8191, h = bh & 7;
        const float g128 = exp2f(128.0f * ret_log2_gamma(h));
        f32x4 S = {0.f, 0.f, 0.f, 0.f};
        const GAS u32x2* src = (const GAS u32x2*)P_KVT + (size_t)bh * NCHUNK * 8192 + within; GAS u32x2* dst = (GAS u32x2*)P_ST + (size_t)bh * NCHUNK * 8192 + within;
        u32x2 kws[NCHUNK];
#pragma unroll
        for (int c = 0; c < NCHUNK; ++c) kws[c] = __builtin_nontemporal_load(src + (size_t)c * 8192);
#pragma unroll
        for (int c = 0; c < NCHUNK; ++c) { const u32x2 kw = kws[c]; const f32x4 kv = {bflo(kw.x), bfhi(kw.x), bflo(kw.y), bfhi(kw.y)};
            u32x2 w; w.x = cvtpk(S[0], S[1]); w.y = cvtpk(S[2], S[3]); dst[(size_t)c * 8192] = w; S = S * g128 + kv; }
        const int el = F.tid >> 5, d0 = (F.tid & 31) * 4;
        __syncthreads();
#pragma unroll
        for (int i = 0; i < 4; ++i) tl[el * 129 + d0 + i] = S[i];
        __syncthreads();
        { const int d = F.tid >> 2, e4 = F.tid & 3, e0 = (within >> 5) - el;
          const f32x4 o = {tl[(4 * e4 + 0) * 129 + d], tl[(4 * e4 + 1) * 129 + d], tl[(4 * e4 + 2) * 129 + d], tl[(4 * e4 + 3) * 129 + d]};
          *(GAS f32x4*)(args.out + O_RP + ((size_t)bh * 128 + d) * 256 + e0 + 4 * e4) = o; }
    }
}
DEVI void ret_stage_half(Frame& F, const Args& args, LAS bf16* Vh, LAS bf16* Sh, int b, int h, int c, int unit, int hf) {
    for (int task = F.tid; task < 2048; task += NTHR) {
        const int m = task & 127, ch = task >> 7;
        const v4u r = *(const GAS v4u*)(P_PROJ + (size_t)(b * SEQ + c * 128 + m) * NIN + C_RV + h * 256 + 128 * hf + ch * 8);
        const unsigned w[4] = {r.x, r.y, r.z, r.w};
#pragma unroll
        for (int i = 0; i < 8; ++i) Vh[(ch * 8 + i) * 136 + m] = (bf16)((i & 1) ? (w[i >> 1] >> 16) : (w[i >> 1] & 0xffffu));
    }
    const bf16* stp = P_ST + (size_t)unit * 32768 + (size_t)(128 * hf) * 128;
    for (int task = F.tid; task < 2048; task += NTHR) { const int e = task >> 4, ch = task & 15; *(LAS v4u*)(Sh + e * 136 + ch * 8) = *(const GAS v4u*)(stp + (size_t)e * 128 + ch * 8); }
}
DEVI void ret_out_unit(Frame& F, const Args& args, int unit) {
    const int c = unit & 31, h = (unit >> 5) & 7, b = unit >> 8;
    LAS bf16* Km = (LAS bf16*)(F.lds); LAS bf16* Vh = (LAS bf16*)(F.lds + 34816); LAS bf16* Sh = (LAS bf16*)(F.lds + 2 * 34816);
    const int lane = F.lane, w = F.wave, fr = lane & 15, fq = lane >> 4;
    const float lg2 = ret_log2_gamma(h);
    __syncthreads();
    { RetKRegs RK; ret_k_issue(F.tid, args, RK, b, h, c); ret_k_write<false>(F.tid, RK, Km, lg2); }
    ret_stage_half(F, args, Vh, Sh, b, h, c, unit, 0);
    __syncthreads();
    int l = 16 * w + fr; asm volatile("" : "+v"(l));
    const int t = c * 128 + l; const size_t row = (size_t)b * SEQ + t;
    bf16x8 qf[4], qdf[4];
    {
        float qa[4][8]; const bf16* qp = P_PROJ + row * NIN + C_RQ + h * 128 + 8 * fq;
#pragma unroll
        for (int s = 0; s < 4; ++s) { const v4u r = *(const GAS v4u*)(qp + 32 * s); unpack8(r, qa[s]); }
        const float dec = exp2f((float)(l + 1) * lg2);
#pragma unroll
        for (int s = 0; s < 2; ++s) { const GAS f2v* rt = (const GAS f2v*)P_ROT + (size_t)t * 64 + 32 * s + 8 * fq;
            float lo[8], hi[8], lod[8], hid[8];
#pragma unroll
            for (int i = 0; i < 8; ++i) { const f2v cs = rt[i]; lo[i] = qa[s][i] * cs.x - qa[s + 2][i] * cs.y; hi[i] = qa[s + 2][i] * cs.x + qa[s][i] * cs.y; lod[i] = lo[i] * dec; hid[i] = hi[i] * dec; }
            qf[s] = __builtin_bit_cast(bf16x8, pack8(lo)); qf[s + 2] = __builtin_bit_cast(bf16x8, pack8(hi)); qdf[s] = __builtin_bit_cast(bf16x8, pack8(lod)); qdf[s + 2] = __builtin_bit_cast(bf16x8, pack8(hid)); }
    }
    f32x4 sacc[8];
#pragma unroll
    for (int mt = 0; mt < 8; ++mt) { sacc[mt] = (f32x4){0.f, 0.f, 0.f, 0.f};
        if (mt <= w) {
#pragma unroll
            for (int s = 0; s < 4; ++s) { const bf16x8 kf = *(const LAS bf16x8*)(Km + (16 * mt + fr) * 136 + 32 * s + 8 * fq); sacc[mt] = MFMA16(kf, qf[s], sacc[mt]); }
#pragma unroll
            for (int r = 0; r < 4; ++r) { const int diff = l - (16 * mt + 4 * fq + r); sacc[mt][r] = (diff >= 0) ? sacc[mt][r] * exp2f((float)diff * lg2) : 0.f; }
        } }
    bf16x8 pf[4];
#pragma unroll
    for (int ks = 0; ks < 4; ++ks) { v4u pw; pw.x = cvtpk(sacc[2 * ks][0], sacc[2 * ks][1]); pw.y = cvtpk(sacc[2 * ks][2], sacc[2 * ks][3]); pw.z = cvtpk(sacc[2 * ks + 1][0], sacc[2 * ks + 1][1]); pw.w = cvtpk(sacc[2 * ks + 1][2], sacc[2 * ks + 1][3]); pf[ks] = __builtin_bit_cast(bf16x8, pw); }
    f32x4 oacc[16];
#pragma unroll
    for (int hf = 0; hf < 2; ++hf) {
        if (hf == 1) { __syncthreads(); ret_stage_half(F, args, Vh, Sh, b, h, c, unit, 1); __syncthreads(); }
#pragma unroll
        for (int et = 0; et < 8; ++et) { f32x4 o = (f32x4){0.f, 0.f, 0.f, 0.f};
#pragma unroll
            for (int ks = 0; ks < 4; ++ks) if (2 * ks <= w) { const LAS bf16* vp = Vh + (16 * et + fr) * 136 + 32 * ks + 4 * fq; const u32x2 a = *(const LAS u32x2*)vp, cc = *(const LAS u32x2*)(vp + 16);
                const v4u vv = {a.x, a.y, cc.x, cc.y}; o = MFMA16(__builtin_bit_cast(bf16x8, vv), pf[ks], o); }
#pragma unroll
            for (int s = 0; s < 4; ++s) { const bf16x8 sf = *(const LAS bf16x8*)(Sh + (16 * et + fr) * 136 + 32 * s + 8 * fq); o = MFMA16(sf, qdf[s], o); }
            oacc[8 * hf + et] = o; }
    }
    float ss = 0.f;
#pragma unroll
    for (int et = 0; et < 16; ++et) ss += (oacc[et][0] * oacc[et][0] + oacc[et][1] * oacc[et][1]) + (oacc[et][2] * oacc[et][2] + oacc[et][3] * oacc[et][3]);
    ss += __shfl_xor(ss, 16); ss += __shfl_xor(ss, 32);
    const float rn = 1.0f / sqrtf(ss * (1.0f / 256.0f) + EPS);
    const bf16* gp = P_PROJ + row * NIN + C_RG + h * 256 + 4 * fq; bf16* op = P_MIX + row * DM + 2048 + h * 256 + 4 * fq;
#pragma unroll
    for (int et = 0; et < 16; ++et) { const u32x2 gw = *(const GAS u32x2*)(gp + 16 * et); const float gg[4] = {bflo(gw.x), bfhi(gw.x), bflo(gw.y), bfhi(gw.y)}; float r4[4];
#pragma unroll
        for (int r = 0; r < 4; ++r) r4[r] = gg[r] / (1.0f + __expf(-gg[r])) * oacc[et][r] * rn;
        u32x2 ow; ow.x = cvtpk(r4[0], r4[1]); ow.y = cvtpk(r4[2], r4[3]); *(GAS u32x2*)(op + 16 * et) = ow; }
}
DEVI void conv_gate_pass(Frame& F, const Args& args) {
    const int gt = blockIdx.x * NTHR + F.tid, NGT = F.G * NTHR;
    const float* cw = args.in[I_CW]; const float* cb = args.in[I_CB];
    constexpr int NCG = DFF / 8;
    constexpr int P7_SEG = 88, P7_NSEG = (MPROMPT + P7_SEG - 1) / P7_SEG;
    static_assert(P7_SEG % 8 == 0 && (MPROMPT - (P7_NSEG - 1) * P7_SEG) % 8 == 0 && SEQ % P7_SEG != 1 && SEQ % P7_SEG != 0, "segment / sequence geometry");
    for (int task = gt; task < P7_NSEG * NCG; task += NGT) {
        const int seg = task / NCG, cg = task - seg * NCG, r0 = seg * P7_SEG, j0 = cg * 8; const int nb = ((MPROMPT - r0 < P7_SEG) ? (MPROMPT - r0) : P7_SEG) / 4;
        float w0[16], w1[16], w2[16], bs[16];
#pragma unroll
        for (int i = 0; i < 8; ++i) { w0[i] = cw[j0 + i]; w1[i] = cw[NUP + j0 + i]; w2[i] = cw[2 * NUP + j0 + i]; bs[i] = cb[j0 + i];
            w0[8 + i] = cw[DFF + j0 + i]; w1[8 + i] = cw[NUP + DFF + j0 + i]; w2[8 + i] = cw[2 * NUP + DFF + j0 + i]; bs[8 + i] = cb[DFF + j0 + i]; }
        float p2[16], p1[16];
        const bool first = (r0 & (SEQ - 1)) == 0;
        if (first) {
#pragma unroll
            for (int i = 0; i < 16; ++i) { p2[i] = 0.f; p1[i] = 0.f; }
        } else { const bf16* ua = P_U + (size_t)(r0 - 2) * NUP + j0; float t8[8];
            unpack8(*(const GAS v4u*)ua, t8);
#pragma unroll
            for (int i = 0; i < 8; ++i) p2[i] = t8[i];
            unpack8(*(const GAS v4u*)(ua + DFF), t8);
#pragma unroll
            for (int i = 0; i < 8; ++i) p2[8 + i] = t8[i];
            unpack8(*(const GAS v4u*)(ua + NUP), t8);
#pragma unroll
            for (int i = 0; i < 8; ++i) p1[i] = t8[i];
            unpack8(*(const GAS v4u*)(ua + NUP + DFF), t8);
#pragma unroll
            for (int i = 0; i < 8; ++i) p1[8 + i] = t8[i]; }
        v4u ba[8], bb[8];
#define P7_LOAD(buf, b) do { _Pragma("unroll") for (int q = 0; q < 4; ++q) { const bf16* up_ = P_U + (size_t)(r0 + 4 * (b) + q) * NUP + j0; buf[2 * q] = __builtin_nontemporal_load((const GAS v4u*)up_); buf[2 * q + 1] = __builtin_nontemporal_load((const GAS v4u*)(up_ + DFF)); } } while (0)
#define P7_COMP(buf, b) do { _Pragma("unroll") for (int q = 0; q < 4; ++q) { const int row = r0 + 4 * (b) + q; if ((row & (SEQ - 1)) == 0) { _Pragma("unroll") for (int i = 0; i < 16; ++i) { p2[i] = 0.f; p1[i] = 0.f; } } float cur[16]; { float t8[8]; unpack8(buf[2 * q], t8); \
            _Pragma("unroll") for (int i = 0; i < 8; ++i) cur[i] = t8[i]; unpack8(buf[2 * q + 1], t8); _Pragma("unroll") for (int i = 0; i < 8; ++i) cur[8 + i] = t8[i]; } \
            float a8[8]; \
            _Pragma("unroll") for (int i = 0; i < 8; i += 2) { const float cg0 = bs[i] + w0[i] * p2[i] + w1[i] * p1[i] + w2[i] * cur[i], cg1 = bs[i + 1] + w0[i + 1] * p2[i + 1] + w1[i + 1] * p1[i + 1] + w2[i + 1] * cur[i + 1]; \
                const float cv0 = bs[8 + i] + w0[8 + i] * p2[8 + i] + w1[8 + i] * p1[8 + i] + w2[8 + i] * cur[8 + i], cv1 = bs[9 + i] + w0[9 + i] * p2[9 + i] + w1[9 + i] * p1[9 + i] + w2[9 + i] * cur[9 + i]; \
                const pg8::f32x2 ge = pg8::gelu_pk((pg8::f32x2){cg0, cg1}); a8[i] = ge.x * cv0; a8[i + 1] = ge.y * cv1; } \
            *(GAS v4u*)(P_ACT + (size_t)row * DFF + j0) = pack8(a8); \
            if ((row & (SEQ - 1)) >= SEQ - 2) { float* oc = args.out + O_CP + ((size_t)(row >> 12) * 2 + ((row & (SEQ - 1)) - (SEQ - 2))) * NUP + j0; \
                _Pragma("unroll") for (int i = 0; i < 8; ++i) { oc[i] = cur[i]; oc[DFF + i] = cur[8 + i]; } } \
            _Pragma("unroll") for (int i = 0; i < 16; ++i) { p2[i] = p1[i]; p1[i] = cur[i]; } } } while (0)
        P7_LOAD(ba, 0);
#pragma unroll 1
        for (int b = 0; b < nb; b += 2) {
            P7_LOAD(bb, b + 1);
            P7_COMP(ba, b);
            if (b + 2 < nb) P7_LOAD(ba, b + 2);
            P7_COMP(bb, b + 1);
        }
#undef P7_LOAD
#undef P7_COMP
    }
    for (int task = gt; task < 2 * MSAMPLE * NCG; task += NGT) {
        const int rb = task / NCG, cg = task - rb * NCG, j0 = cg * 8;
        if (rb >= MSAMPLE) { const v4u z = {0u, 0u, 0u, 0u}; *(GAS v4u*)(P_ACT + (size_t)(MREAL + rb - MSAMPLE) * DFF + j0) = z; continue; }
        const int row = MPROMPT + rb; const bf16* up = P_U + (size_t)row * NUP + j0;
        float cur[16]; { float t8[8]; unpack8(*(const GAS v4u*)up, t8);
#pragma unroll
            for (int i = 0; i < 8; ++i) cur[i] = t8[i];
            unpack8(*(const GAS v4u*)(up + DFF), t8);
#pragma unroll
            for (int i = 0; i < 8; ++i) cur[8 + i] = t8[i]; }
        const float* sc0 = args.in[I_SC] + (size_t)rb * 2 * NUP + j0; const float* sc1 = sc0 + NUP;
        float* oc0 = args.out + O_CS + (size_t)rb * 2 * NUP + j0; float* oc1 = oc0 + NUP;
        float a8[8];
#pragma unroll
        for (int i = 0; i < 8; i += 2) {
            const float p2g0 = sc0[i], p2g1 = sc0[i + 1], p1g0 = sc1[i], p1g1 = sc1[i + 1], p2v0 = sc0[DFF + i], p2v1 = sc0[DFF + i + 1], p1v0 = sc1[DFF + i], p1v1 = sc1[DFF + i + 1];
            const float cg0 = cb[j0 + i] + cw[j0 + i] * p2g0 + cw[NUP + j0 + i] * p1g0 + cw[2 * NUP + j0 + i] * cur[i];
            const float cg1 = cb[j0 + i + 1] + cw[j0 + i + 1] * p2g1 + cw[NUP + j0 + i + 1] * p1g1 + cw[2 * NUP + j0 + i + 1] * cur[i + 1];
            const float cv0 = cb[DFF + j0 + i] + cw[DFF + j0 + i] * p2v0 + cw[NUP + DFF + j0 + i] * p1v0 + cw[2 * NUP + DFF + j0 + i] * cur[8 + i];
            const float cv1 = cb[DFF + j0 + i + 1] + cw[DFF + j0 + i + 1] * p2v1 + cw[NUP + DFF + j0 + i + 1] * p1v1 + cw[2 * NUP + DFF + j0 + i + 1] * cur[8 + i + 1];
            const pg8::f32x2 ge = pg8::gelu_pk((pg8::f32x2){cg0, cg1}); a8[i] = ge.x * cv0; a8[i + 1] = ge.y * cv1;
            oc0[i] = p1g0; oc0[i + 1] = p1g1; oc0[DFF + i] = p1v0; oc0[DFF + i + 1] = p1v1;
            oc1[i] = cur[i]; oc1[i + 1] = cur[i + 1]; oc1[DFF + i] = cur[8 + i]; oc1[DFF + i + 1] = cur[8 + i + 1]; }
        *(GAS v4u*)(P_ACTS + tiled_off(rb, j0)) = pack8(a8);
    }
}

template <bool TILED> DEVI f32x4 sliver_gemm_t(LAS unsigned char* lds, const bf16* A, const bf16* Bt, int K, int n0, int lane, int wave) {
    const int fr = lane & 15, fq = lane >> 4, ks = K >> 3, nst = ks >> 5;
    const bf16* ap = TILED ? A + ((size_t)(wave * (ks >> 5)) * 128 + fr) * 32 + 8 * fq : A + (size_t)fr * K + wave * ks + 8 * fq; const bf16* bp = Bt + (size_t)(n0 + fr) * K + wave * ks + 8 * fq;
    const size_t rt_stride = TILED ? (size_t)16 * 32 : (size_t)16 * K; const int ast = TILED ? 128 : 1;
    f32x4 acc[8];
#pragma unroll
    for (int rt = 0; rt < 8; ++rt) acc[rt] = (f32x4){0.f, 0.f, 0.f, 0.f};
    const int rot = (int)(blockIdx.x >> 3) % nst;
#define SLV_OFF(st) (32 * (((st) + rot) >= nst ? ((st) + rot) - nst : ((st) + rot)))
    v4u a0[8], a1[8], b0, b1;
    { const int o0 = SLV_OFF(0); b0 = *(const GAS v4u*)(bp + o0);
#pragma unroll
      for (int rt = 0; rt < 8; ++rt) a0[rt] = *(const GAS v4u*)(ap + rt * rt_stride + (size_t)o0 * ast); }
    for (int st = 0; st < nst; st += 2) {
        if (st + 1 < nst) { const int o1 = SLV_OFF(st + 1); b1 = *(const GAS v4u*)(bp + o1);
#pragma unroll
            for (int rt = 0; rt < 8; ++rt) a1[rt] = *(const GAS v4u*)(ap + rt * rt_stride + (size_t)o1 * ast); }
#pragma unroll
        for (int rt = 0; rt < 8; ++rt) acc[rt] = MFMA16(__builtin_bit_cast(bf16x8, b0), __builtin_bit_cast(bf16x8, a0[rt]), acc[rt]);
        if (st + 1 < nst) {
            if (st + 2 < nst) { const int o2 = SLV_OFF(st + 2); b0 = *(const GAS v4u*)(bp + o2);
#pragma unroll
                for (int rt = 0; rt < 8; ++rt) a0[rt] = *(const GAS v4u*)(ap + rt * rt_stride + (size_t)o2 * ast); }
#pragma unroll
            for (int rt = 0; rt < 8; ++rt) acc[rt] = MFMA16(__builtin_bit_cast(bf16x8, b1), __builtin_bit_cast(bf16x8, a1[rt]), acc[rt]);
        }
    }
#undef SLV_OFF
    LAS f32x4* red = (LAS f32x4*)lds;
    __syncthreads();
#pragma unroll
    for (int rt = 0; rt < 8; ++rt) red[(wave * 8 + rt) * 64 + lane] = acc[rt];
    __syncthreads();
    f32x4 r = red[wave * 64 + lane];
#pragma unroll
    for (int sw = 1; sw < 8; ++sw) r += red[(sw * 8 + wave) * 64 + lane];
    return r;
}
DEVI f32x4 sliver_gemm(LAS unsigned char* lds, const bf16* A, const bf16* Bt, int K, int n0, int lane, int wave) { return sliver_gemm_t<false>(lds, A, Bt, K, n0, lane, wave); }
DEVI f32x4 sliver_gemm_64x32(LAS unsigned char* lds, const bf16* A, const bf16* Bt, int K, int rh, int n0, int lane, int wave) {
    const int fr = lane & 15, fq = lane >> 4, ks = K >> 3, nst = ks >> 5;
    const bf16* ap = A + ((size_t)(wave * nst) * 128 + 64 * rh + fr) * 32 + 8 * fq; const bf16* bp = Bt + (size_t)(n0 + fr) * K + wave * ks + 8 * fq; const size_t bct = (size_t)16 * K;
    f32x4 acc[8];
#pragma unroll
    for (int i = 0; i < 8; ++i) acc[i] = (f32x4){0.f, 0.f, 0.f, 0.f};
    const int rot = (int)(blockIdx.x >> 3) % nst;
#define SLV_OFF(st) (32 * (((st) + rot) >= nst ? ((st) + rot) - nst : ((st) + rot)))
#define SLV_LD(a, b, o) do { b[0] = *(const GAS v4u*)(bp + (o)); b[1] = *(const GAS v4u*)(bp + bct + (o)); _Pragma("unroll") for (int rt = 0; rt < 4; ++rt) a[rt] = *(const GAS v4u*)(ap + rt * 512 + (size_t)(o) * 128); } while (0)
#define SLV_MM(a, b) do { _Pragma("unroll") for (int rt = 0; rt < 4; ++rt) _Pragma("unroll") for (int ct = 0; ct < 2; ++ct) acc[rt * 2 + ct] = MFMA16(__builtin_bit_cast(bf16x8, b[ct]), __builtin_bit_cast(bf16x8, a[rt]), acc[rt * 2 + ct]); } while (0)
    v4u a0[4], a1[4], a2[4], b0[2], b1[2], b2[2];
    SLV_LD(a0, b0, SLV_OFF(0)); if (1 < nst) SLV_LD(a1, b1, SLV_OFF(1));
    for (int st = 0; st < nst; st += 3) {
        if (st + 2 < nst) SLV_LD(a2, b2, SLV_OFF(st + 2));
        SLV_MM(a0, b0);
        if (st + 1 < nst) { if (st + 3 < nst) SLV_LD(a0, b0, SLV_OFF(st + 3)); SLV_MM(a1, b1); }
        if (st + 2 < nst) { if (st + 4 < nst) SLV_LD(a1, b1, SLV_OFF(st + 4)); SLV_MM(a2, b2); }
    }
#undef SLV_OFF
#undef SLV_LD
#undef SLV_MM
    LAS f32x4* red = (LAS f32x4*)lds;
    __syncthreads();
#pragma unroll
    for (int i = 0; i < 8; ++i) red[(wave * 8 + i) * 64 + lane] = acc[i];
    __syncthreads();
    f32x4 r = red[wave * 64 + lane];
#pragma unroll
    for (int sw = 1; sw < 8; ++sw) r += red[(sw * 8 + wave) * 64 + lane];
    return r;
}
template <bool BASE_BF16, bool OUT_F32> DEVI void sliver_resid(const f32x4 acc, int row, int c, const float* base  , float* outf  , bf16* outb, float* ss, bf16* outt  ) {
    const size_t off = (size_t)row * DM + c; f32x4 b4;
    if (BASE_BF16) { const u32x2 bw = *(const GAS u32x2*)(outb + off); b4 = (f32x4){bflo(bw.x), bfhi(bw.x), bflo(bw.y), bfhi(bw.y)}; } else b4 = *(const GAS f32x4*)(base + off);
    const f32x4 o = b4 + acc;
    if (OUT_F32) *(GAS f32x4*)(outf + off) = o;
    u32x2 w; w.x = cvtpk(o[0], o[1]); w.y = cvtpk(o[2], o[3]); *(GAS u32x2*)(outb + off) = w; if (outt) *(GAS u32x2*)(outt + tiled_off(row, c)) = w;
    float s = (o[0] * o[0] + o[1] * o[1]) + (o[2] * o[2] + o[3] * o[3]); s += __shfl_xor(s, 16); s += __shfl_xor(s, 32);
    if ((threadIdx.x & 48) == 0) atomicAdd(ss + row, s);
}
#ifndef SLV_DUP
#define SLV_DUP 1
#endif
#ifndef SLV_TILED
#define SLV_TILED false
#endif
#define SLV_ROW(sv) (64 * ((sv) & 1) + 16 * (F.wave >> 1) + (F.lane & 15))
#define SLV_COL(sv) (32 * ((sv) >> 1) + 16 * (F.wave & 1) + 4 * (F.lane >> 4))
__global__ void __launch_bounds__(NTHR, 2) mk_fwd(Args args) {
    extern __shared__ __attribute__((aligned(16))) unsigned char lds[];
    Frame F;
    F.lds = (LAS unsigned char*)lds;
    F.MISC = (volatile LAS unsigned*)(F.lds + MISC_OFF);
    F.tid = threadIdx.x; F.lane = F.tid & 63; F.wave = __builtin_amdgcn_readfirstlane(F.tid >> 6); F.G = gridDim.x;
    unsigned char* ws = args.ws;
    F.ctl = (gu32*)(ws + WS_CTL);
    for (int u = F.tid; u < (LDS_BYTES - LDSCTL_OFF) / 4; u += NTHR) ((LAS unsigned*)(F.lds + LDSCTL_OFF))[u] = 0u;
    __syncthreads();
    XcdBarrier bar; bar.bar = (unsigned*)(F.ctl + CW_BAR); bar.x = 0; bar.st = nullptr;
    if (N_LAUNCHES == 1) bar = xcd_barrier_post((unsigned*)(F.ctl + CW_BAR), F.MISC + 8);
#define GRID_BAR() do { if (N_LAUNCHES == 1) xcd_barrier(bar); } while (0)
    F.vc = (int)blockIdx.x;
    if (N_LAUNCHES == 1 && F.G == 256) {
        if (F.tid == 0) { const unsigned x = xb_xcc_id(); const unsigned r = __hip_atomic_fetch_add(F.ctl + CW_XRANK + 64 * x, 1u, RLX_AGENT); F.MISC[20] = (x < 8u && r < 32u) ? x + 8u * r : 0xffffffffu; }
        __syncthreads();
        const unsigned v = (unsigned)__builtin_amdgcn_readfirstlane((int)F.MISC[20]); if (v != 0xffffffffu) F.vc = (int)v;
    }

    const int lo = args.ph_lo, hi = args.ph_hi;
#ifndef DUP_MASK
#define DUP_MASK 0
#endif
#define REP(k) for (int rep_ = 0; rep_ < (((DUP_MASK >> (k)) & 1) ? 2 : 1); ++rep_)
#ifndef PHASE_MASK
#define PHASE_MASK 0x7ff
#endif
#define IN(k) (((PHASE_MASK >> (k)) & 1) && lo <= (k) && (k) < hi)
#define BOTH(k) (IN(k) && IN((k) + 1))
    typedef pg8::StaticOrder SO;
    if (IN(0)) { REP(0) p0_prologue(F, args); if (BOTH(0)) GRID_BAR(); }
    if (IN(1)) { pg8::Gemm g = pg8::gemm_rowmajor(P_A, P_Win_t, MPAD, NIN, DM); SO S; S.init(MPAD, NIN, F.G, F.vc);
        pg8::EpiBf16S<false> E{P_PROJ, NIN, nullptr};
        pg8::gemm_phase<pg8::EpiBf16S<false>, SO, true, true>(F.lds + RING_OFF, g, S, E);
        { const int nbusy = S.nwg % F.G;
          if (nbusy != 0 && F.vc >= nbusy) tr_run(args, TR_END_P0 + (F.vc - nbusy) * NWAVES + F.wave, TR_END_G1, (F.G - nbusy) * NWAVES, F.lane, (LAS float*)(F.lds + RING_OFF + F.wave * TR_SCR_BYTES));
          else if (nbusy == 0) tr_run(args, TR_END_P0 + F.vc * NWAVES + F.wave, TR_END_G1, F.G * NWAVES, F.lane, (LAS float*)(F.lds + RING_OFF + F.wave * TR_SCR_BYTES)); }
        if (BOTH(1)) GRID_BAR(); }
    if (IN(2)) {
        if (blockIdx.x & 1) {
            for (int u = blockIdx.x; u < 512; u += F.G) attn_sample_unit(F, args, u);
            for (int u = blockIdx.x; u < 512; u += F.G) ret_kv_unit(F, args, u);
            for (int u = blockIdx.x; u < 256; u += F.G) attn_prompt_unit(F, args, u);
        } else {
            for (int u = blockIdx.x; u < 256; u += F.G) attn_prompt_unit(F, args, u);
            for (int u = blockIdx.x; u < 512; u += F.G) ret_kv_unit(F, args, u);
            for (int u = blockIdx.x; u < 512; u += F.G) attn_sample_unit(F, args, u);
        }
        __syncthreads();
        if (BOTH(2)) GRID_BAR(); }
    if (IN(3)) { sret_finalize(F, args); REP(3) ret_scan(F, args); if (BOTH(3)) GRID_BAR(); }
#ifndef P4_DUP
#define P4_DUP 1
#endif
    if (IN(4)) { for (int u = blockIdx.x; u < 512 * P4_DUP; u += F.G) ret_out_unit(F, args, u & 511); __syncthreads(); if (BOTH(4)) GRID_BAR(); }
    if (IN(5)) { pg8::Gemm g = pg8::gemm_rowmajor(P_MIX, P_Wout_t, MPROMPT, DM, DM); SO S; S.init(MPROMPT, DM, F.G, F.vc);
        pg8::EpiResid<false, false> E{args.in[I_XP], args.in[I_XS], nullptr, P_A, P_SS1};
        pg8::gemm_phase<pg8::EpiResid<false, false>, SO, true, true>(F.lds + RING_OFF, g, S, E);
        for (int sv = blockIdx.x; sv < DM / 16; sv += F.G) { const f32x4 acc = sliver_gemm_64x32(F.lds, P_MIXS, P_Wout_t, DM, sv & 1, 32 * (sv >> 1), F.lane, F.wave);
            sliver_resid<false, false>(acc, SLV_ROW(sv), SLV_COL(sv), args.in[I_XS], nullptr, P_A + (size_t)MPROMPT * DM, P_SS1 + MPROMPT, nullptr); }
        if (BOTH(5)) GRID_BAR(); }
    if (IN(6)) { pg8::Gemm g = pg8::gemm_rowmajor(P_A, P_Wup_t, MPAD, NUP, DM); SO S; S.init(MPAD, NUP, F.G, F.vc);
        pg8::EpiBf16S<true> E{P_U, NUP, P_SS1};
        pg8::gemm_phase<pg8::EpiBf16S<true>, SO, true, true>(F.lds + RING_OFF, g, S, E);
        { const int nbusy = S.nwg % F.G;
          if (nbusy != 0 && F.vc >= nbusy) tr_run(args, TR_END_G1 + (F.vc - nbusy) * NWAVES + F.wave, TR_END_G3, (F.G - nbusy) * NWAVES, F.lane, (LAS float*)(F.lds + RING_OFF + F.wave * TR_SCR_BYTES));
          else if (nbusy == 0) tr_run(args, TR_END_G1 + F.vc * NWAVES + F.wave, TR_END_G3, F.G * NWAVES, F.lane, (LAS float*)(F.lds + RING_OFF + F.wave * TR_SCR_BYTES)); }
        if (BOTH(6)) GRID_BAR(); }
    if (IN(7)) { REP(7) conv_gate_pass(F, args); if (BOTH(7)) GRID_BAR(); }
    if (IN(8)) { pg8::Gemm g = pg8::gemm_rowmajor(P_ACT, P_Wdown_t, MPROMPT, DM, DFF); SO S; S.init(MPROMPT, DM, F.G, F.vc);
        pg8::EpiResid<true, false> E{nullptr, nullptr, nullptr, P_A, P_SS2};
        pg8::gemm_phase<pg8::EpiResid<true, false>, SO, true, true>(F.lds + RING_OFF, g, S, E);
        for (int sv = blockIdx.x; sv < DM / 16; sv += F.G) { const f32x4 acc = sliver_gemm_64x32(F.lds, P_ACTS, P_Wdown_t, DFF, sv & 1, 32 * (sv >> 1), F.lane, F.wave);
            sliver_resid<true, false>(acc, SLV_ROW(sv), SLV_COL(sv), nullptr, nullptr, P_A + (size_t)MPROMPT * DM, P_SS2 + MPROMPT, P_X2BS); }
        __syncthreads(); }
    if (IN(9)) { int kple = PLED; asm volatile("" : "+s"(kple));
        pg8::Gemm g = pg8::gemm_rowmajor(P_PB, P_Wproj_t, MPROMPT, DM, kple); SO S; S.init(MPROMPT, DM, F.G, F.vc);
        pg8::EpiBf16S<false> E{P_PLEB, DM, nullptr};
        pg8::gemm_phase<pg8::EpiBf16S<false>, SO, true, true>(F.lds + RING_OFF, g, S, E);
        for (int sv = blockIdx.x; sv < DM / 16; sv += F.G) { const f32x4 acc = sliver_gemm_64x32(F.lds, P_PBS, P_Wproj_t, kple, sv & 1, 32 * (sv >> 1), F.lane, F.wave);
            u32x2 w; w.x = cvtpk(acc[0], acc[1]); w.y = cvtpk(acc[2], acc[3]);
            *(GAS u32x2*)(P_PLEB + (size_t)(MPROMPT + SLV_ROW(sv)) * DM + SLV_COL(sv)) = w; }
        if (BOTH(9)) GRID_BAR(); }
    if (IN(10)) { pg8::Gemm g = pg8::gemm_rowmajor(P_A, P_Wgate_t, MPROMPT, DM, DM); SO S; S.init(MPROMPT, DM, F.G, F.vc);
        pg8::EpiPle E{args.out, P_A, P_PLEB, P_SS2};
        pg8::gemm_phase<pg8::EpiPle, SO, true, true>(F.lds + RING_OFF, g, S, E);
        for (int sv = blockIdx.x; sv < (DM / 16); sv += F.G) { const f32x4 acc = sliver_gemm_64x32(F.lds, P_X2BS, P_Wgate_t, DM, sv & 1, 32 * (sv >> 1), F.lane, F.wave);
            const int row = MPROMPT + SLV_ROW(sv), c = SLV_COL(sv); const size_t off = (size_t)row * DM + c;
            const float sc = 1.0f / sqrtf(P_SS2[row] * (1.0f / DM) + EPS);
            const u32x2 xw = *(const GAS u32x2*)(P_A + off); const f32x4 x2 = {bflo(xw.x), bfhi(xw.x), bflo(xw.y), bfhi(xw.y)}; const u32x2 pw = *(const GAS u32x2*)(P_PLEB + off); const float pl[4] = {bflo(pw.x), bfhi(pw.x), bflo(pw.y), bfhi(pw.y)}; f32x4 o;
#pragma unroll
            for (int k = 0; k < 4; ++k) { const float gte = __builtin_amdgcn_rcpf(1.0f + __builtin_amdgcn_exp2f(-1.4426950408889634f * sc * acc[k])); o[k] = x2[k] + gte * pl[k]; }
            *(GAS f32x4*)(args.out + off) = o; }
        }
#undef IN
#undef BOTH
}

extern "C" void kernel_launch(void* const* d_in, const int* in_sizes, int n_in, void* d_out, int out_size, void* d_ws, size_t ws_size, hipStream_t stream) {
    static int grid = 0;
    if (grid == 0) {
        if (n_in != N_INPUTS || (size_t)out_size != O_END || ws_size < WS_END) { fprintf(stderr, "kernel_launch: unexpected shapes: n_in %d out %d ws %zu; nothing launched\n", n_in, out_size, ws_size); grid = -1; return; }
        int dev = 0, cus = 0, per_cu = 0;
        if (hipGetDevice(&dev) != hipSuccess || hipDeviceGetAttribute(&cus, hipDeviceAttributeMultiprocessorCount, dev) != hipSuccess) { grid = -1; return; }
        if (hipFuncSetAttribute((const void*)mk_fwd, hipFuncAttributeMaxDynamicSharedMemorySize, LDS_BYTES) != hipSuccess) { fprintf(stderr, "kernel_launch: hipFuncSetAttribute failed\n"); grid = -1; return; }
        if (hipOccupancyMaxActiveBlocksPerMultiprocessor(&per_cu, (const void*)mk_fwd, NTHR, LDS_BYTES) != hipSuccess || per_cu < 1) { fprintf(stderr, "kernel_launch: occupancy query says %d blocks per CU\n", per_cu); }
        (void)hipGetLastError();
        grid = cus;
    }
    if (grid < 0) return;
    if (hipMemsetAsync((char*)d_ws + WS_CTL, 0, CTL_ZERO_BYTES, stream) != hipSuccess) return;
    Args a{};
    for (int i = 0; i < N_INPUTS; ++i) a.in[i] = (const float*)d_in[i];
    a.out = (float*)d_out; a.ws = (unsigned char*)d_ws;
    if (N_LAUNCHES == 1) { a.ph_lo = 0; a.ph_hi = N_PHASES; hipLaunchKernelGGL(mk_fwd, dim3(grid), dim3(NTHR), LDS_BYTES, stream, a); }
    else { for (int p = 0; p < N_PHASES; ++p) { a.ph_lo = p; a.ph_hi = p + 1; hipLaunchKernelGGL(mk_fwd, dim3(grid), dim3(NTHR), LDS_BYTES, stream, a); } }
}
```

```cpp
#include <hip/hip_runtime.h>
#include <cstdio>
#include <cstdint>
#include <cmath>
namespace pg8 {
#define PG8_LAS __attribute__((address_space(3)))
typedef unsigned short bf16_t;
typedef short bf16x8 __attribute__((ext_vector_type(8)));
typedef float f32x4 __attribute__((ext_vector_type(4)));
typedef unsigned u32x4 __attribute__((ext_vector_type(4)));
constexpr int BM = 256, BK = 64, HALF = 128, HTB = HALF * BK * 2  , STAGE_BYTES = 8 * HTB, NXCD = 8, WGM = 8;

__host__ __device__ __forceinline__ int lds_byte(int r, int c) { const int st = (r >> 4) * 2 + (c >> 5), rr = r & 15, cc = c & 31, ob = rr * 64 + cc * 2; return st * 1024 + (ob ^ (((ob >> 9) & 1) << 5)); }
__host__ __device__ __forceinline__ void stage_rc(int b, int& R, int& C) { const int st = b / 1024, sb = b % 1024, swz = sb ^ (((sb >> 9) & 1) << 5); R = (st >> 1) * 16 + swz / 64; C = (st & 1) * 32 + (swz % 64) / 2; }
__host__ __device__ __forceinline__ int perm32(int rho) { const int n = rho >> 4, i = rho & 15; return 8 * (i >> 2) + 4 * n + (i & 3); }

struct Unit { int pm, pn; };
struct Gemm { const bf16_t* A; const bf16_t* Bt; int M, N, K; long rsA, ksA, rsB, ksB; };
__host__ __device__ __forceinline__ Gemm gemm_rowmajor(const bf16_t* A, const bf16_t* Bt, int M, int N, int K) { return Gemm{A, Bt, M, N, K, (long)K * 2, 128, (long)K * 2, 128}; }
__host__ __device__ __forceinline__ Gemm gemm_tiled(const bf16_t* A, const bf16_t* Bt, int M, int N, int K, int rowsA, int rowsB) { return Gemm{A, Bt, M, N, K, 128, (long)rowsA * 128, 128, (long)rowsB * 128}; }

struct StaticOrder {
    int nM, nN, nwg, G, c;
    __host__ __device__ void init(int M, int N, int G_, int c_) { nM = M / BM; nN = N / BM; nwg = nM * nN; G = G_; c = c_; }
    __host__ __device__ bool next(int i, Unit& u) const {
        const long L = (long)i * G + c; if (L >= nwg) return false;
        int wgid = (int)L; { const int q = nwg / NXCD, r = nwg % NXCD, xcd = wgid % NXCD, off = wgid / NXCD; wgid = (xcd < r ? xcd * (q + 1) : r * (q + 1) + (xcd - r) * q) + off; }
        const int nig = WGM * nN, gid = wgid / nig, fm = gid * WGM, gsz = (nM - fm) < WGM ? (nM - fm) : WGM;
        u.pm = fm + ((wgid % nig) % gsz); u.pn = (wgid % nig) / gsz; return true;
    }
    __device__ __forceinline__ void a_ready(const Unit&) const {}
    __device__ __forceinline__ void done(const Unit&) const {}
};

__device__ __forceinline__ unsigned cvt_pk_bf16(float lo, float hi) { unsigned r; asm volatile("v_cvt_pk_bf16_f32 %0, %1, %2" : "=v"(r) : "v"(lo), "v"(hi)); return r; }
typedef float f32x2 __attribute__((ext_vector_type(2)));
__device__ __forceinline__ f32x2 gelu_pk(f32x2 v) {
    const f32x2 av = __builtin_elementwise_abs(v), d = av * 0.2316418882f + 1.0f;
    f32x2 t; t.x = __builtin_amdgcn_rcpf(d.x); t.y = __builtin_amdgcn_rcpf(d.y);
    f32x2 q = t * 0.5307027145f + (-0.7265760135f); q = q * t + 0.7107068705f; q = q * t + (-0.142248368f); q = q * t + 0.127414796f; q = q * t;
    const f32x2 s = (v * v) * (-0.72134752044f);
    f32x2 e; e.x = __builtin_amdgcn_exp2f(s.x); e.y = __builtin_amdgcn_exp2f(s.y);
    const f32x2 m = v * (q * e), r = v - m;
    f32x2 o; o.x = v.x < 0.f ? m.x : r.x; o.y = v.y < 0.f ? m.y : r.y; return o;
}

template <int ACT  > struct EpiBf16 {
    static constexpr bool PERM = true, AFTER_DRAIN = false; static_assert(ACT == 0 || ACT == 1, "EpiBf16: ACT is 0 (none) or 1 (gelu_pk)");
    bf16_t* O; int ldc; const float* bias; int split_cols; size_t split_stride; float scale0;
    __device__ __forceinline__ void operator()(const f32x4 (&acc)[2][2][4][2], const Unit& u, int wr, int wc, int fr, int fq) const {
        const int row0 = u.pm * BM + wr * 64 + fr; int colt = u.pn * BM; bf16_t* base = O;
        float sc = 1.f; if (split_cols) { const int t = colt / split_cols; base += (size_t)t * split_stride; colt -= t * split_cols; if (t == 0) sc = scale0; }
        const int col0 = colt + wc * 32 + 8 * fq, bcol0 = u.pn * BM + wc * 32 + 8 * fq;
        f32x4 bv[2][2];
#pragma unroll
        for (int bj = 0; bj < 2; ++bj)
#pragma unroll
            for (int n = 0; n < 2; ++n) bv[bj][n] = bias ? *(const f32x4*)(bias + bcol0 + bj * HALF + 4 * n) : (f32x4){0.f, 0.f, 0.f, 0.f};
#pragma unroll
        for (int ai = 0; ai < 2; ++ai)
#pragma unroll
            for (int m = 0; m < 4; ++m) { bf16_t* rowp = base + (size_t)(row0 + ai * HALF + m * 16) * ldc + col0;
#pragma unroll
                for (int bj = 0; bj < 2; ++bj) { f32x4 v0 = acc[ai][bj][m][0] + bv[bj][0], v1 = acc[ai][bj][m][1] + bv[bj][1];
                    if (ACT == 1) { f32x2 a = gelu_pk((f32x2){v0[0], v0[1]}), b = gelu_pk((f32x2){v0[2], v0[3]}), c = gelu_pk((f32x2){v1[0], v1[1]}), d = gelu_pk((f32x2){v1[2], v1[3]});
                        v0 = (f32x4){a.x, a.y, b.x, b.y}; v1 = (f32x4){c.x, c.y, d.x, d.y}; }
                    v0 = v0 * sc; v1 = v1 * sc; u32x4 w; w.x = cvt_pk_bf16(v0[0], v0[1]); w.y = cvt_pk_bf16(v0[2], v0[3]); w.z = cvt_pk_bf16(v1[0], v1[1]); w.w = cvt_pk_bf16(v1[2], v1[3]);
                    *(u32x4*)(rowp + bj * HALF) = w; } }
    }
};

typedef unsigned u32x2 __attribute__((ext_vector_type(2)));
typedef float f32x2b __attribute__((ext_vector_type(2))); typedef __bf16 bf16x2b __attribute__((ext_vector_type(2)));
__device__ __forceinline__ unsigned cvtpk(float lo, float hi) { f32x2b v = {lo, hi}; bf16x2b b = __builtin_convertvector(v, bf16x2b); return __builtin_bit_cast(unsigned, b); }
constexpr int ROWS_REAL = 8320, ROWS_PROMPT = 8192, DMODEL = 4096;
constexpr float RMS_EPS = 1e-6f;

template <bool SCALE> struct EpiBf16S {
    static constexpr bool PERM = true, AFTER_DRAIN = false;
    bf16_t* O; int ldc; const float* ss;
    __device__ __forceinline__ void operator()(const f32x4 (&acc)[2][2][4][2], const Unit& u, int wr, int wc, int fr, int fq) const {
        const int row0 = u.pm * BM + wr * 64 + fr, col0 = u.pn * BM + wc * 32 + 8 * fq;
        float ssr[2][4];
        if (SCALE) {
#pragma unroll
            for (int ai = 0; ai < 2; ++ai)
#pragma unroll
                for (int m = 0; m < 4; ++m) ssr[ai][m] = ss[row0 + ai * HALF + m * 16];
        }
#pragma unroll
        for (int ai = 0; ai < 2; ++ai)
#pragma unroll
            for (int m = 0; m < 4; ++m) { const int row = row0 + ai * HALF + m * 16; bf16_t* rowp = O + (size_t)row * ldc + col0;
                float sc = 1.f; if (SCALE) sc = __builtin_amdgcn_rsqf(ssr[ai][m] * (1.0f / DMODEL) + RMS_EPS);
#pragma unroll
                for (int bj = 0; bj < 2; ++bj) { const f32x4 v0 = acc[ai][bj][m][0] * sc, v1 = acc[ai][bj][m][1] * sc;
                    u32x4 w; w.x = cvtpk(v0[0], v0[1]); w.y = cvtpk(v0[2], v0[3]); w.z = cvtpk(v1[0], v1[1]); w.w = cvtpk(v1[2], v1[3]);
                    *(u32x4*)(rowp + bj * HALF) = w; } }
    }
};
template <bool BASE_BF16, bool OUT_F32> struct EpiResid {
    static constexpr bool PERM = false, AFTER_DRAIN = false;
    const float* base_p; const float* base_s; float* outf; bf16_t* outb; float* ss;
    __device__ __forceinline__ void operator()(const f32x4 (&acc)[2][2][4][2], const Unit& u, int wr, int wc, int fr, int fq) const {
        const int row0 = u.pm * BM + wr * 64 + fr, col0 = u.pn * BM + wc * 32 + 4 * fq;
        f32x4 bf[2][4]; u32x2 bw[2][4];
#pragma unroll
        for (int g = 0; g <= 8; ++g) {
            if (g < 8) { const int ai = g >> 2, m = g & 3, row = row0 + ai * HALF + m * 16;
                {   const float* bp = BASE_BF16 ? nullptr : ((row < ROWS_PROMPT) ? base_p + (size_t)row * DMODEL : base_s + (size_t)(row - ROWS_PROMPT) * DMODEL);
#pragma unroll
                    for (int bj = 0; bj < 2; ++bj)
#pragma unroll
                        for (int n = 0; n < 2; ++n) { const int c = col0 + bj * HALF + n * 16;
                            if (BASE_BF16) bw[g & 1][bj * 2 + n] = *(const u32x2*)(outb + (size_t)row * DMODEL + c); else bf[g & 1][bj * 2 + n] = *(const f32x4*)(bp + c); }
                } }
            if (g > 0) { const int h = g - 1, ai = h >> 2, m = h & 3, row = row0 + ai * HALF + m * 16;
                {   float s = 0.f;
#pragma unroll
                    for (int bj = 0; bj < 2; ++bj)
#pragma unroll
                        for (int n = 0; n < 2; ++n) { const int c = col0 + bj * HALF + n * 16; f32x4 b4;
                            if (BASE_BF16) { const u32x2 w2 = bw[h & 1][bj * 2 + n]; b4 = (f32x4){__uint_as_float(w2.x << 16), __uint_as_float(w2.x & 0xffff0000u), __uint_as_float(w2.y << 16), __uint_as_float(w2.y & 0xffff0000u)}; }
                            else b4 = bf[h & 1][bj * 2 + n];
                            const f32x4 o = b4 + acc[ai][bj][m][n];
                            if (OUT_F32) *(f32x4*)(outf + (size_t)row * DMODEL + c) = o;
                            s += (o[0] * o[0] + o[1] * o[1]) + (o[2] * o[2] + o[3] * o[3]);
                            u32x2 w; w.x = cvtpk(o[0], o[1]); w.y = cvtpk(o[2], o[3]); *(u32x2*)(outb + (size_t)row * DMODEL + c) = w; }
                    s += __shfl_xor(s, 16); s += __shfl_xor(s, 32);
                    if (fq == 0) atomicAdd(ss + row, s);
                }
                asm volatile("" ::: "memory"); }
        }
    }
};
struct EpiPle {
    static constexpr bool PERM = false, AFTER_DRAIN = false;
    float* y; const bf16_t* x2b; const bf16_t* ple; const float* ss;
    __device__ __forceinline__ void operator()(const f32x4 (&acc)[2][2][4][2], const Unit& u, int wr, int wc, int fr, int fq) const {
        const int row0 = u.pm * BM + wr * 64 + fr, col0 = u.pn * BM + wc * 32 + 4 * fq;
        u32x2 xw[2][4], pw[2][4]; float ssr[2];
#pragma unroll
        for (int g = 0; g <= 8; ++g) {
            if (g < 8) { const int ai = g >> 2, m = g & 3, row = row0 + ai * HALF + m * 16;
                {   ssr[g & 1] = ss[row];
#pragma unroll
                    for (int bj = 0; bj < 2; ++bj)
#pragma unroll
                        for (int n = 0; n < 2; ++n) { const size_t off = (size_t)row * DMODEL + col0 + bj * HALF + n * 16; xw[g & 1][bj * 2 + n] = *(const u32x2*)(x2b + off); pw[g & 1][bj * 2 + n] = *(const u32x2*)(ple + off); }
                } }
            if (g > 0) { const int h = g - 1, ai = h >> 2, m = h & 3, row = row0 + ai * HALF + m * 16;
                {   const float sc = __builtin_amdgcn_rsqf(ssr[h & 1] * (1.0f / DMODEL) + RMS_EPS);
#pragma unroll
                    for (int bj = 0; bj < 2; ++bj)
#pragma unroll
                        for (int n = 0; n < 2; ++n) { const size_t off = (size_t)row * DMODEL + col0 + bj * HALF + n * 16;
                            const u32x2 xv = xw[h & 1][bj * 2 + n], pv = pw[h & 1][bj * 2 + n];
                            const f32x4 x2 = {__uint_as_float(xv.x << 16), __uint_as_float(xv.x & 0xffff0000u), __uint_as_float(xv.y << 16), __uint_as_float(xv.y & 0xffff0000u)};
                            const f32x4 pl = {__uint_as_float(pv.x << 16), __uint_as_float(pv.x & 0xffff0000u), __uint_as_float(pv.y << 16), __uint_as_float(pv.y & 0xffff0000u)};
                            const f32x4 z = acc[ai][bj][m][n] * sc; f32x4 o;
#pragma unroll
                            for (int k = 0; k < 4; ++k) { const float gte = __builtin_amdgcn_rcpf(1.0f + __builtin_amdgcn_exp2f(-1.4426950408889634f * z[k])); o[k] = x2[k] + gte * pl[k]; }
                            *(f32x4*)(y + off) = o; }
                }
                asm volatile("" ::: "memory"); }
        }
    }
};

template <class Epi, class Sched, bool ALIGN_EPI = false, bool SP2 = false>
__device__ __forceinline__ void gemm_phase(PG8_LAS unsigned char* lds, const Gemm g, const Sched& S, const Epi& E) {
    const int tid = threadIdx.x, wid = __builtin_amdgcn_readfirstlane(tid >> 6), lane = tid & 63, wr = wid >> 2, wc = wid & 3, fr = lane & 15, fq = lane >> 4;
    const int K = g.K, nt = K / BK;
    unsigned voffA[2], voffB[2];
#pragma unroll
    for (int i = 0; i < 2; ++i) { int R, C; stage_rc(tid * 16 + i * 8192, R, C); const int Rb = Epi::PERM ? ((R & ~31) + perm32(R & 31)) : R;
        voffA[i] = (unsigned)(R * (int)g.rsA + C * 2); voffB[i] = (unsigned)(Rb * (int)g.rsB + C * 2); }
    const size_t kstepA = (size_t)g.ksA, kstepB = (size_t)g.ksB;
    const size_t hstepA = (size_t)HALF * g.rsA, hstepB = (size_t)HALF * g.rsB;
    const size_t tstepA = 2 * hstepA, tstepB = 2 * hstepB;
    const unsigned ldsw = (unsigned)wid * 1024u;
    const int aoff = lds_byte(wr * 64 + fr, fq * 8), boff = lds_byte(wc * 32 + fr, fq * 8);
#define PG8_SA(b, h) (((b) * 2 + (h)) * HTB)
#define PG8_SB(b, h) ((4 + (b) * 2 + (h)) * HTB)
#define PG8_STAGE(bufoff, gbase, voff) do { _Pragma("unroll") for (int _i = 0; _i < 2; ++_i) \
        __builtin_amdgcn_global_load_lds((const unsigned*)((const char*)(gbase) + (voff)[_i]), (PG8_LAS unsigned*)(lds + (bufoff) + ldsw + _i * 8192), 16, 0, 0); } while (0)
#define PG8_LDA(dst, b, h) do { _Pragma("unroll") for (int m = 0; m < 4; ++m) _Pragma("unroll") for (int k = 0; k < 2; ++k) dst[m][k] = *(const PG8_LAS bf16x8*)(lds + PG8_SA(b, h) + aoff + m * 2048 + k * 1024); } while (0)
#define PG8_LDB(dst, b, h) do { _Pragma("unroll") for (int n = 0; n < 2; ++n) _Pragma("unroll") for (int k = 0; k < 2; ++k) dst[n][k] = *(const PG8_LAS bf16x8*)(lds + PG8_SB(b, h) + boff + n * 2048 + k * 1024); } while (0)
#define PG8_MMA(ai, bj, At, Bt) do { __builtin_amdgcn_s_setprio(1); _Pragma("unroll") for (int m = 0; m < 4; ++m) _Pragma("unroll") for (int n = 0; n < 2; ++n) _Pragma("unroll") for (int k = 0; k < 2; ++k) \
        acc[ai][bj][m][n] = __builtin_amdgcn_mfma_f32_16x16x32_bf16(Bt[n][k], At[m][k], acc[ai][bj][m][n], 0, 0, 0); __builtin_amdgcn_s_setprio(0); } while (0)
#define PG8_WAIT_V(n) asm volatile("s_waitcnt vmcnt(" #n ")" ::: "memory")
#define PG8_WAIT_L(n) asm volatile("s_waitcnt lgkmcnt(" #n ")" ::: "memory")
#define PG8_BAR __builtin_amdgcn_s_barrier()
#define PG8_SCHED __builtin_amdgcn_sched_barrier(0)
    Unit cur, nxt; int ui = 0;
    if (!S.next(0, cur)) return;
    f32x4 acc[2][2][4][2];
#pragma unroll
    for (int a = 0; a < 2; ++a)
#pragma unroll
        for (int b = 0; b < 2; ++b)
#pragma unroll
            for (int m = 0; m < 4; ++m)
#pragma unroll
                for (int n = 0; n < 2; ++n) acc[a][b][m][n] = (f32x4){0.f, 0.f, 0.f, 0.f};
    bf16x8 At[4][2], B0[2][2], B1[2][2];
    const char* cA = (const char*)g.A + (size_t)cur.pm * tstepA; const char* cB = (const char*)g.Bt + (size_t)cur.pn * tstepB;
    S.a_ready(cur);
    if constexpr (SP2) {
        PG8_STAGE(PG8_SB(0, 0), cB, voffB); PG8_STAGE(PG8_SB(0, 1), cB + hstepB, voffB); PG8_STAGE(PG8_SA(0, 0), cA, voffA); PG8_STAGE(PG8_SA(0, 1), cA + hstepA, voffA);
        if (wr == 1) PG8_BAR;
        PG8_WAIT_V(2); PG8_BAR;
        PG8_STAGE(PG8_SB(1, 0), cB + kstepB, voffB); PG8_STAGE(PG8_SA(1, 0), cA + kstepA, voffA); PG8_STAGE(PG8_SB(1, 1), cB + hstepB + kstepB, voffB);
        PG8_WAIT_V(6); PG8_BAR;
    } else {
        PG8_STAGE(PG8_SB(0, 0), cB, voffB); PG8_STAGE(PG8_SA(0, 0), cA, voffA); PG8_STAGE(PG8_SB(0, 1), cB + hstepB, voffB); PG8_STAGE(PG8_SA(0, 1), cA + hstepA, voffA);
        if (wr == 1) PG8_BAR;
        PG8_WAIT_V(4); PG8_BAR;
        PG8_STAGE(PG8_SB(1, 0), cB + kstepB, voffB); PG8_STAGE(PG8_SA(1, 0), cA + kstepA, voffA); PG8_STAGE(PG8_SB(1, 1), cB + hstepB + kstepB, voffB);
        PG8_WAIT_V(6); PG8_BAR;
    }
    for (;;) {
        const bool has_next = S.next(ui + 1, nxt);
        const char* nA = has_next ? (const char*)g.A + (size_t)nxt.pm * tstepA : cA; const char* nB = has_next ? (const char*)g.Bt + (size_t)nxt.pn * tstepB : cB;
        for (int t = 0; t < nt; t += 2) {
            const bool last = (t == nt - 2);
            const char* a1 = cA + (size_t)(t + 1) * kstepA;
            const char* a2 = last ? nA : cA + (size_t)(t + 2) * kstepA; const char* b2 = last ? nB : cB + (size_t)(t + 2) * kstepB;
            const char* a3 = a2 + kstepA; const char* b3 = b2 + kstepB;
            if (last && has_next) S.a_ready(nxt);
            if constexpr (SP2) {
            PG8_LDB(B0, 0, 0); PG8_LDB(B1, 0, 1); PG8_SCHED; PG8_LDA(At, 0, 0); PG8_STAGE(PG8_SA(1, 1), a1 + hstepA, voffA);
            PG8_WAIT_V(8); PG8_WAIT_L(0); PG8_BAR; PG8_MMA(0, 0, At, B0); PG8_MMA(0, 1, At, B1); PG8_BAR; PG8_SCHED;
            PG8_LDA(At, 0, 1); PG8_STAGE(PG8_SB(0, 0), b2, voffB); PG8_STAGE(PG8_SB(0, 1), b2 + hstepB, voffB); PG8_STAGE(PG8_SA(0, 0), a2, voffA);
            PG8_WAIT_V(8); PG8_WAIT_L(0); PG8_BAR; PG8_MMA(1, 0, At, B0); PG8_MMA(1, 1, At, B1); PG8_BAR; PG8_SCHED;
            PG8_LDB(B0, 1, 0); PG8_LDB(B1, 1, 1); PG8_SCHED; PG8_LDA(At, 1, 0); PG8_STAGE(PG8_SA(0, 1), a2 + hstepA, voffA);
            PG8_WAIT_V(8); PG8_WAIT_L(0); PG8_BAR; PG8_MMA(0, 0, At, B0); PG8_MMA(0, 1, At, B1); PG8_BAR; PG8_SCHED;
            PG8_LDA(At, 1, 1); PG8_STAGE(PG8_SB(1, 0), b3, voffB); PG8_STAGE(PG8_SB(1, 1), b3 + hstepB, voffB); PG8_STAGE(PG8_SA(1, 0), a3, voffA);
            PG8_WAIT_V(8); PG8_WAIT_L(0); PG8_BAR; PG8_MMA(1, 0, At, B0); PG8_MMA(1, 1, At, B1); PG8_BAR; PG8_SCHED;
            } else {
            PG8_LDB(B0, 0, 0); PG8_SCHED; PG8_LDA(At, 0, 0); PG8_STAGE(PG8_SA(1, 1), a1 + hstepA, voffA);
            PG8_WAIT_L(8); PG8_BAR; PG8_WAIT_L(0); PG8_MMA(0, 0, At, B0); PG8_BAR; PG8_SCHED;
            PG8_LDB(B1, 0, 1); PG8_STAGE(PG8_SB(0, 0), b2, voffB);
            PG8_BAR; PG8_WAIT_L(0); PG8_MMA(0, 1, At, B1); PG8_BAR;
            PG8_LDA(At, 0, 1); PG8_STAGE(PG8_SA(0, 0), a2, voffA);
            PG8_BAR; PG8_WAIT_L(0); PG8_MMA(1, 0, At, B0); PG8_BAR; PG8_SCHED;
            PG8_STAGE(PG8_SB(0, 1), b2 + hstepB, voffB);
            PG8_WAIT_V(6); PG8_BAR; PG8_MMA(1, 1, At, B1); PG8_BAR;
            PG8_LDB(B0, 1, 0); PG8_SCHED; PG8_LDA(At, 1, 0); PG8_STAGE(PG8_SA(0, 1), a2 + hstepA, voffA);
            PG8_WAIT_L(8); PG8_BAR; PG8_WAIT_L(0); PG8_MMA(0, 0, At, B0); PG8_BAR; PG8_SCHED;
            PG8_LDB(B1, 1, 1); PG8_STAGE(PG8_SB(1, 0), b3, voffB);
            PG8_BAR; PG8_WAIT_L(0); PG8_MMA(0, 1, At, B1); PG8_BAR;
            PG8_LDA(At, 1, 1); PG8_STAGE(PG8_SA(1, 0), a3, voffA);
            PG8_BAR; PG8_WAIT_L(0); PG8_MMA(1, 0, At, B0); PG8_BAR; PG8_SCHED;
            PG8_STAGE(PG8_SB(1, 1), b3 + hstepB, voffB);
            PG8_WAIT_V(6); PG8_BAR; PG8_MMA(1, 1, At, B1); PG8_BAR;
            }
        }
        if constexpr (ALIGN_EPI) { if (wr == 0) PG8_BAR; }
        if constexpr (!Epi::AFTER_DRAIN) { E(acc, cur, wr, wc, fr, fq); S.done(cur); }
        if (!has_next) break;
#pragma unroll
        for (int a = 0; a < 2; ++a)
#pragma unroll
            for (int b = 0; b < 2; ++b)
#pragma unroll
                for (int m = 0; m < 4; ++m)
#pragma unroll
                    for (int n = 0; n < 2; ++n) acc[a][b][m][n] = (f32x4){0.f, 0.f, 0.f, 0.f};
        cur = nxt; cA = nA; cB = nB; ++ui;
        if constexpr (ALIGN_EPI) { if (wr == 1) PG8_BAR; }
    }
    PG8_WAIT_V(0);
    if constexpr (!ALIGN_EPI) { if (wr == 0) PG8_BAR; }
    PG8_BAR;
    if constexpr (Epi::AFTER_DRAIN) { E.fused(acc, cur, wr, wc, fr, fq, lds, wid, lane); S.done(cur); }
#undef PG8_SA
#undef PG8_SB
#undef PG8_STAGE
#undef PG8_LDA
#undef PG8_LDB
#undef PG8_MMA
#undef PG8_WAIT_V
#undef PG8_WAIT_L
#undef PG8_BAR
#undef PG8_SCHED
}
}
#define GAS __attribute__((address_space(1)))
#define LAS __attribute__((address_space(3)))
typedef unsigned short bf16;
typedef unsigned v4u __attribute__((ext_vector_type(4)));
typedef float f32x4 __attribute__((ext_vector_type(4)));
typedef short bf16x8 __attribute__((ext_vector_type(8)));
typedef GAS unsigned gu32;
typedef GAS unsigned long long gu64;
#define RLX_AGENT __ATOMIC_RELAXED, __HIP_MEMORY_SCOPE_AGENT
#define LDS_WAIT() asm volatile("s_waitcnt lgkmcnt(0)" ::: "memory")
#define VM_WAIT() asm volatile("s_waitcnt vmcnt(0)" ::: "memory")
__device__ __forceinline__ unsigned long long rt() { return __builtin_amdgcn_s_memrealtime(); }
__device__ __forceinline__ unsigned f2bf(float f) { unsigned u = __builtin_bit_cast(unsigned, f); return (u + 0x7fffu + ((u >> 16) & 1u)) >> 16; }
__device__ __forceinline__ unsigned pk2(float lo, float hi) { return f2bf(lo) | (f2bf(hi) << 16); }
#define XB_TMO      128
#define XB_XCNT(j)  (256  + 64 * (j))
#define XB_XSUB(j)  (1280 + 64 * (j))
#define XB_XGEN(j)  (2304 + 64 * (j))
#define XB_TOP      3328
#define XB_TOPGEN   3392
#define XCD_BAR_WORDS 3456
#define XB_SPIN_CAP (1u << 18)

__device__ __forceinline__ unsigned xb_ld(unsigned* p)              { return __hip_atomic_load(p, __ATOMIC_RELAXED, __HIP_MEMORY_SCOPE_AGENT); }
__device__ __forceinline__ unsigned xb_add(unsigned* p, unsigned v) { return __hip_atomic_fetch_add(p, v, __ATOMIC_RELAXED, __HIP_MEMORY_SCOPE_AGENT); }
__device__ __forceinline__ unsigned xb_xcc_id() { return (unsigned)__builtin_amdgcn_s_getreg((3 << 11) | 20) & 0xFu; }
#define XB_SPIN(cond, bar) do { unsigned _sp = 0; while (cond) { __builtin_amdgcn_s_sleep(1); \
    if ((++_sp & 255u) == 0u) { if (xb_ld(&(bar)[XB_TMO])) break; if (_sp > XB_SPIN_CAP) { atomicAdd(&(bar)[XB_TMO], 1u); break; } } } } while (0)

struct XcdBarrier {
    unsigned* bar; unsigned x;
    volatile LAS unsigned* st;
};

__device__ __forceinline__ XcdBarrier xcd_barrier_post(unsigned* bar, volatile LAS unsigned* st) {
    XcdBarrier b; b.bar = bar; b.x = xb_xcc_id(); b.st = st;
    if (threadIdx.x == 0) (void)xb_add(&bar[XB_XCNT(b.x)], 1u);
    return b;
}
__device__ __forceinline__ void xcd_barrier_complete(unsigned* bar, unsigned x, unsigned& nloc, unsigned& nx) {
    const unsigned G = gridDim.x * gridDim.y * gridDim.z;
    unsigned sum, cnt, mine, sp = 0u;
    for (;;) {
        sum = 0u; cnt = 0u; mine = 0u;
#pragma unroll
        for (unsigned j = 0; j < 16; ++j) { const unsigned c = xb_ld(&bar[XB_XCNT(j)]); sum += c; cnt += (c > 0u) ? 1u : 0u; mine = (j == x) ? c : mine; }
        if (sum == G) break;
        __builtin_amdgcn_s_sleep(1);
        if ((++sp & 255u) == 0u) { if (xb_ld(&bar[XB_TMO])) break; if (sp > XB_SPIN_CAP) { atomicAdd(&bar[XB_TMO], 1u); break; } }
    }
    nloc = mine > 0u ? mine : 1u; nx = cnt > 0u ? cnt : 1u;
}

__device__ __forceinline__ void xcd_barrier(const XcdBarrier& b) {
    asm volatile("s_waitcnt vmcnt(0)" ::: "memory");
    __syncthreads();
    if (threadIdx.x == 0) {
        unsigned* bar = b.bar;
        __builtin_amdgcn_s_waitcnt(0);
        unsigned nloc = b.st[0], nx = b.st[1];
        if (nloc == 0u) { xcd_barrier_complete(bar, b.x, nloc, nx); b.st[0] = nloc; b.st[1] = nx; }
        const unsigned old = xb_add(&bar[XB_XSUB(b.x)], 1u);
        const unsigned gen = old / nloc;
        if (old + 1u == (gen + 1u) * nloc) {
            __builtin_amdgcn_fence(__ATOMIC_RELEASE, "agent");
            asm volatile("s_waitcnt vmcnt(0)" ::: "memory");
            const unsigned og = xb_add(&bar[XB_TOP], 1u);
            const unsigned tg = og / nx;
            if (og + 1u == (tg + 1u) * nx) xb_add(&bar[XB_TOPGEN], 1u);
            else XB_SPIN(xb_ld(&bar[XB_TOPGEN]) == tg, bar);
            __builtin_amdgcn_fence(__ATOMIC_ACQUIRE, "agent");
            xb_add(&bar[XB_XGEN(b.x)], 1u);
            asm volatile("s_waitcnt vmcnt(0)" ::: "memory");
        } else {
            XB_SPIN(xb_ld(&bar[XB_XGEN(b.x)]) == gen, bar);
            __builtin_amdgcn_fence(__ATOMIC_ACQUIRE, "agent");
            asm volatile("s_waitcnt vmcnt(0)" ::: "memory");
        }
    }
    __syncthreads();
}

#ifndef MK_N_LAUNCHES
#define MK_N_LAUNCHES 1
#endif
constexpr int N_LAUNCHES = MK_N_LAUNCHES;
constexpr int N_PHASES = 11;
constexpr int NWAVES = 8, NTHR = 512;
constexpr int DM = 4096, SEQ = 4096, NBATCH = 2, MPROMPT = 8192, MSAMPLE = 128, MREAL = 8320, MPAD = 8448;
constexpr int NIN = 8704, DFF = 11008, NUP = 22016, PLED = 256;
constexpr int C_AQ = 0, C_AK = 2048, C_AV = 2304, C_RQ = 2560, C_RK = 3584, C_RV = 4608, C_RG = 6656;
constexpr int NCHUNK = 32;
constexpr int PAST = 8192;
constexpr float EPS = 1e-6f;
enum { I_XP = 0, I_XS, I_PP, I_PS, I_CK, I_CV, I_SR, I_SC, I_RB, I_GMIX, I_WIN, I_GQ, I_GK, I_SINK, I_WOUT, I_GFFN, I_WUP, I_CW, I_CB, I_WDOWN, I_GPLE, I_WGATE, I_WPROJ, N_INPUTS };
constexpr size_t O_YP = 0, O_YS = 33554432, O_WKP = 34078720, O_WVP = 34144256, O_RP = 34209792, O_CP = 34734080, O_WKS = 34822144, O_WVS = 39016448, O_RS = 43210752, O_CS = 76765184, O_END = 82401280;
constexpr size_t MiB = 1u << 20;
constexpr size_t WS_CTL = 0, CTL_ZERO_BYTES = 1 * MiB;
constexpr size_t WS_ROT = 1 * MiB, WS_WIN = 4 * MiB, WS_WOUT = 72 * MiB, WS_WUP = 104 * MiB, WS_WDOWN = 276 * MiB, WS_WGATE = 362 * MiB, WS_WPROJ = 394 * MiB;
constexpr size_t WS_A = 396 * MiB, WS_X1 = 462 * MiB, WS_PB = 594 * MiB, WS_PLE = 599 * MiB, WS_ACT = 665 * MiB, WS_U = 843 * MiB;
constexpr size_t WS_PROJ = 843 * MiB, WS_MIX = 984 * MiB, WS_KVT = 1050 * MiB, WS_ST = 1114 * MiB, WS_END = 1198 * MiB;
static_assert(WS_WIN + (size_t)NIN * DM * 2 <= WS_WOUT && WS_WUP + (size_t)NUP * DM * 2 <= WS_WDOWN && WS_WDOWN + (size_t)DM * DFF * 2 <= WS_WGATE, "ws map (weights)");
static_assert(WS_A + (size_t)MPAD * DM * 2 <= WS_X1 && WS_X1 + (size_t)MPAD * DM * 4 <= WS_PB && WS_PB + (size_t)MPAD * PLED * 2 <= WS_PLE && WS_PLE + (size_t)MPAD * DM * 2 <= WS_ACT, "ws map (act)");
static_assert(WS_ACT + (size_t)MPAD * DFF * 2 <= WS_U && WS_U + (size_t)MPAD * NUP * 2 <= WS_END, "ws map (u)");
static_assert(WS_PROJ + (size_t)MPAD * NIN * 2 <= WS_MIX && WS_MIX + (size_t)MPAD * DM * 2 <= WS_KVT && WS_KVT + (size_t)16 * NCHUNK * 32768 * 4 <= WS_ST && WS_ST + (size_t)16 * NCHUNK * 32768 * 2 <= WS_END, "ws map (overlay)");
static_assert(WS_ROT + (size_t)4097 * 64 * 8 <= WS_WIN, "ws map (rot)");
constexpr int CW_TMO = 0, CW_CODE = 1, CW_BAR = 4096, CW_SS1 = 65536, CW_SS2 = 65536 + 16384, CW_XRANK = 200000;
static_assert((CW_SS2 + MPAD) * 4 <= (int)CTL_ZERO_BYTES && (CW_XRANK + 16 * 64) * 4 <= (int)CTL_ZERO_BYTES && CW_XRANK >= CW_SS2 + MPAD, "ctl");
constexpr int RING_OFF = 0, RING_BYTES = 131072, LDS_BYTES = 147456, LDSCTL_OFF = LDS_BYTES - 1024, MISC_OFF = LDSCTL_OFF + 320;
static_assert(8 * 64 * 65 * 4 <= LDSCTL_OFF, "transpose scratch");

#define DEVI __device__ __forceinline__
typedef unsigned u32x2 __attribute__((ext_vector_type(2)));
typedef float f2v __attribute__((ext_vector_type(2)));

DEVI size_t tiled_off(int row, int k) { return ((size_t)(k >> 5) * 128 + row) * 32 + (k & 31); }
DEVI float bflo(unsigned w) { return __uint_as_float(w << 16); }
DEVI float bfhi(unsigned w) { return __uint_as_float(w & 0xffff0000u); }
DEVI float bf1(unsigned short b) { return __uint_as_float((unsigned)b << 16); }
DEVI void unpack8(const v4u r, float (&f)[8]) { f[0] = bflo(r.x); f[1] = bfhi(r.x); f[2] = bflo(r.y); f[3] = bfhi(r.y); f[4] = bflo(r.z); f[5] = bfhi(r.z); f[6] = bflo(r.w); f[7] = bfhi(r.w); }
DEVI unsigned cvtpk(float lo, float hi) { return pg8::cvtpk(lo, hi); }
DEVI v4u pack8(const float (&f)[8]) { v4u w; w.x = cvtpk(f[0], f[1]); w.y = cvtpk(f[2], f[3]); w.z = cvtpk(f[4], f[5]); w.w = cvtpk(f[6], f[7]); return w; }
DEVI float wave_sum(float v) {
#pragma unroll
    for (int o = 1; o < 64; o <<= 1) v += __shfl_xor(v, o);
    return v;
}
DEVI float wave_max(float v) {
#pragma unroll
    for (int o = 1; o < 64; o <<= 1) v = fmaxf(v, __shfl_xor(v, o));
    return v;
}
#define MFMA16(a, b, c) __builtin_amdgcn_mfma_f32_16x16x32_bf16((a), (b), (c), 0, 0, 0)

struct Args { const float* in[N_INPUTS]; float* out; unsigned char* ws; int ph_lo, ph_hi; };
#define P_Win_t ((bf16*)(args.ws + WS_WIN))
#define P_Wout_t ((bf16*)(args.ws + WS_WOUT))
#define P_Wup_t ((bf16*)(args.ws + WS_WUP))
#define P_Wdown_t ((bf16*)(args.ws + WS_WDOWN))
#define P_Wgate_t ((bf16*)(args.ws + WS_WGATE))
#define P_Wproj_t ((bf16*)(args.ws + WS_WPROJ))
#define P_A ((bf16*)(args.ws + WS_A))
#define P_PB ((bf16*)(args.ws + WS_PB))
#define P_PLEB ((bf16*)(args.ws + WS_PLE))
#define P_ACT ((bf16*)(args.ws + WS_ACT))
#define P_U ((bf16*)(args.ws + WS_U))
#define P_PROJ ((bf16*)(args.ws + WS_PROJ))
#define P_MIX ((bf16*)(args.ws + WS_MIX))
#define P_ST ((bf16*)(args.ws + WS_ST))
#define P_X1 ((float*)(args.ws + WS_X1))
#define P_KVT ((bf16*)(args.ws + WS_KVT))
#define P_ROT ((f2v*)(args.ws + WS_ROT))
#define P_OACC ((float*)(args.ws + WS_X1))
#define P_MIXS ((bf16*)(args.ws + WS_X1 + 2 * MiB))
#define P_X2BS ((bf16*)(args.ws + WS_X1 + 4 * MiB))
#define P_ACTS ((bf16*)(args.ws + WS_X1 + 8 * MiB))
#define P_PBS  ((bf16*)(args.ws + WS_X1 + 12 * MiB))
#define P_SS1 ((float*)(args.ws + WS_CTL) + CW_SS1)
#define P_SS2 ((float*)(args.ws + WS_CTL) + CW_SS2)
struct Frame {
    LAS unsigned char* lds;
    volatile LAS unsigned* MISC;
    gu32* ctl;
    int tid, lane, wave, G, vc;
};

struct TrItem { const float* W; const float* ks; bf16* WT; int K, N, r; };
constexpr int IT_IN = (DM / 64) * (NIN / 64), IT_OUT = (DM / 64) * (DM / 64), IT_UP = (DM / 64) * (NUP / 64), IT_DOWN = (DFF / 64) * (DM / 64), IT_GATE = IT_OUT, IT_PROJ = (PLED / 64) * (DM / 64);
constexpr int TR_UP_IN_P0 = 5000;
constexpr int TR_END_P0 = IT_IN + TR_UP_IN_P0, TR_END_G1 = IT_IN + IT_UP + IT_OUT + IT_PROJ, TR_END_G3 = TR_END_G1 + IT_DOWN + IT_GATE;
DEVI TrItem tr_decode(const Args& args, int it) {
    TrItem t; int r = it;
    if (r < IT_IN) { t.W = args.in[I_WIN]; t.ks = nullptr; t.WT = P_Win_t; t.K = DM; t.N = NIN; t.r = r; return t; } r -= IT_IN;
    if (r < IT_UP) { t.W = args.in[I_WUP]; t.ks = args.in[I_GFFN]; t.WT = P_Wup_t; t.K = DM; t.N = NUP; t.r = r; return t; } r -= IT_UP;
    if (r < IT_OUT) { t.W = args.in[I_WOUT]; t.ks = nullptr; t.WT = P_Wout_t; t.K = DM; t.N = DM; t.r = r; return t; } r -= IT_OUT;
    if (r < IT_PROJ) { t.W = args.in[I_WPROJ]; t.ks = nullptr; t.WT = P_Wproj_t; t.K = PLED; t.N = DM; t.r = r; return t; } r -= IT_PROJ;
    if (r < IT_DOWN) { t.W = args.in[I_WDOWN]; t.ks = nullptr; t.WT = P_Wdown_t; t.K = DFF; t.N = DM; t.r = r; return t; } r -= IT_DOWN;
    t.W = args.in[I_WGATE]; t.ks = args.in[I_GPLE]; t.WT = P_Wgate_t; t.K = DM; t.N = DM; t.r = r; return t;
}
constexpr int TR_NITEMS = (DM / 64) * (NIN / 64) + 2 * (DM / 64) * (DM / 64) + (DM / 64) * (NUP / 64) + (DFF / 64) * (DM / 64) + (PLED / 64) * (DM / 64);
constexpr int TR_SCR_BYTES = 64 * 65 * 4;
struct TrRegs { f32x4 v[16]; f32x4 k0, k1; };
DEVI void tr_load(const TrItem& t, int lane, TrRegs& R) {
    const int nblk = t.N / 64, kb = t.r / nblk, nb = t.r - kb * nblk; const float* src = t.W + (size_t)(64 * kb + (lane >> 4)) * t.N + 64 * nb + (lane & 15) * 4;
#pragma unroll
    for (int i = 0; i < 16; ++i) R.v[i] = __builtin_nontemporal_load((const GAS f32x4*)(src + (size_t)(4 * i) * t.N));
    if (t.ks) { const float* kp = t.ks + 64 * kb + 8 * (lane & 7); R.k0 = *(const GAS f32x4*)kp; R.k1 = *(const GAS f32x4*)(kp + 4); }
    else { R.k0 = (f32x4){1.f, 1.f, 1.f, 1.f}; R.k1 = R.k0; }
}
DEVI void tr_store(const TrItem& t, int lane, const TrRegs& R, LAS float* scr) {
    const int nblk = t.N / 64, kb = t.r / nblk, nb = t.r - kb * nblk, k0 = 64 * kb, n0 = 64 * nb;
#pragma unroll
    for (int i = 0; i < 16; ++i) { LAS float* d = scr + (4 * i + (lane >> 4)) * 65 + (lane & 15) * 4; d[0] = R.v[i][0]; d[1] = R.v[i][1]; d[2] = R.v[i][2]; d[3] = R.v[i][3]; }
    LDS_WAIT(); asm volatile("" ::: "memory");
    const int c = lane & 7;
#pragma unroll
    for (int j = 0; j < 8; ++j) { const int n = (lane >> 3) + 8 * j; const LAS float* s = scr + (8 * c) * 65 + n;
        v4u o; o.x = cvtpk(s[0 * 65] * R.k0[0], s[1 * 65] * R.k0[1]); o.y = cvtpk(s[2 * 65] * R.k0[2], s[3 * 65] * R.k0[3]); o.z = cvtpk(s[4 * 65] * R.k1[0], s[5 * 65] * R.k1[1]); o.w = cvtpk(s[6 * 65] * R.k1[2], s[7 * 65] * R.k1[3]);
        *(GAS v4u*)(t.WT + (size_t)(n0 + n) * t.K + k0 + 8 * c) = o; }
    LDS_WAIT(); asm volatile("" ::: "memory");
}
DEVI void tr_run(const Args& args, int it, int last, int stride, int lane, LAS float* scr) {
    if (it >= last) return;
    TrRegs Ra, Rb; TrItem t = tr_decode(args, it); tr_load(t, lane, Ra);
    for (;;) {
        int nx = it + stride; bool more = nx < last; TrItem tn = t;
        if (more) { tn = tr_decode(args, nx); tr_load(tn, lane, Rb); }
        tr_store(t, lane, Ra, scr);
        if (!more) break;
        t = tn; it = nx; nx = it + stride; more = nx < last;
        if (more) { tn = tr_decode(args, nx); tr_load(tn, lane, Ra); }
        tr_store(t, lane, Rb, scr);
        if (!more) break;
        t = tn; it = nx;
    }
}
DEVI void rms_row_to_bf16(const float* xrow, const float* g, bf16* orow, int lane) {
    const GAS f32x4* xr = (const GAS f32x4*)xrow + lane; const GAS f32x4* gr = (const GAS f32x4*)g + lane;
    f32x4 v[16]; float s = 0.f;
#pragma unroll
    for (int j = 0; j < 16; ++j) { v[j] = __builtin_nontemporal_load(xr + 64 * j); s += (v[j].x * v[j].x + v[j].y * v[j].y) + (v[j].z * v[j].z + v[j].w * v[j].w); }
    f32x4 gv_[16];
#pragma unroll
    for (int j = 0; j < 16; ++j) gv_[j] = gr[64 * j];
    const float rstd = 1.0f / sqrtf(wave_sum(s) * (1.0f / DM) + EPS);
    GAS u32x2* o8 = (GAS u32x2*)orow + lane;
#pragma unroll
    for (int j = 0; j < 16; ++j) { const f32x4 gv = gv_[j]; u32x2 w; w.x = cvtpk(v[j].x * rstd * gv.x, v[j].y * rstd * gv.y); w.y = cvtpk(v[j].z * rstd * gv.z, v[j].w * rstd * gv.w); o8[64 * j] = w; }
}
DEVI void p0_prologue(Frame& F, const Args& args) {
    LAS float* scr = (LAS float*)(F.lds + RING_OFF + F.wave * TR_SCR_BYTES);
    const int gw = blockIdx.x * NWAVES + F.wave, NGW = F.G * NWAVES;
    const int gt = blockIdx.x * NTHR + F.tid, NGT = F.G * NTHR;
#ifndef P0X_DUP
#define P0X_DUP 1
#endif
    for (int xr_ = 0; xr_ < P0X_DUP; ++xr_) {
    for (int idx = gt; idx < 4097 * 64; idx += NGT) { const int pi = idx >> 6, i = idx & 63; const float pos = (pi == 4096) ? (float)PAST : (float)pi;
        const float inv = powf(10000.0f, -(float)i * (1.0f / 64.0f)); const float ang = pos * inv; float sn, cs; sincosf(ang, &sn, &cs); P_ROT[idx] = (f2v){cs, sn}; }
    for (int idx = gt; idx < MPAD * 32; idx += NGT) { const int row = idx >> 5, ch = idx & 31; v4u o = {0u, 0u, 0u, 0u};
        if (row < MREAL) { const float* src = (row < MPROMPT) ? args.in[I_PP] + (size_t)row * PLED : args.in[I_PS] + (size_t)(row - MPROMPT) * PLED;
            const f32x4 a = *(const GAS f32x4*)(src + ch * 8), b = *(const GAS f32x4*)(src + ch * 8 + 4); o.x = cvtpk(a.x, a.y); o.y = cvtpk(a.z, a.w); o.z = cvtpk(b.x, b.y); o.w = cvtpk(b.z, b.w); }
        *(GAS v4u*)(P_PB + (size_t)row * PLED + ch * 8) = o; if (row >= MPROMPT && row < MREAL) *(GAS v4u*)(P_PBS + tiled_off(row - MPROMPT, ch * 8)) = o; }
    for (int idx = gt; idx < 1024 * 256 / 4; idx += NGT) *(GAS f32x4*)(P_OACC + (size_t)idx * 4) = (f32x4){0.f, 0.f, 0.f, 0.f};
    for (int idx = gt; idx < (MPAD - MREAL) * (DM / 8); idx += NGT) { const v4u z = {0u, 0u, 0u, 0u}; const size_t off = (size_t)MREAL * DM + (size_t)idx * 8;
        *(GAS v4u*)(P_A + off) = z; *(GAS v4u*)(P_MIX + off) = z; }
    for (int m = gw; m < MREAL; m += NGW) { const float* xr = (m < MPROMPT) ? args.in[I_XP] + (size_t)m * DM : args.in[I_XS] + (size_t)(m - MPROMPT) * DM; rms_row_to_bf16(xr, args.in[I_GMIX], P_A + (size_t)m * DM, F.lane); }
    }
    tr_run(args, gw, TR_END_P0, NGW, F.lane, scr);
}

DEVI int t5_bucket(int n) {
    if (n < 16) return n;
    const float v = logf((float)n * (1.0f / 16.0f)) / 2.0794415416798357f * 16.0f;
    const int l = 16 + (int)v; return l < 31 ? l : 31;
}
DEVI void attn_prompt_unit(Frame& F, const Args& args, int unit) {
    const int qb = unit & 31, kvh = (unit >> 5) & 3, b = unit >> 7;
    LAS bf16* Kh = (LAS bf16*)(F.lds);
    LAS bf16* Vt = (LAS bf16*)(F.lds + 36864);
    LAS float* biasT = (LAS float*)(F.lds + 36864 + 33792);
    const int tid = F.tid, lane = F.lane, g = F.wave, fr = lane & 15, fq = lane >> 4;
    const float* gk = args.in[I_GK]; const float* gq = args.in[I_GQ];
    const int sitem = unit * 8 + g, su = sitem >> 1, hf = sitem & 1, sh = su & 7, sb = su >> 3;
    const float sgamma = 1.0f - exp2f(-5.0f - (float)sh);
    float sq_sel, sk_sel, sqk; f32x4 sv4;
    {   const bf16* pq = P_PROJ + (size_t)(MPROMPT + sb) * NIN + C_RQ + sh * 128; const bf16* pk = P_PROJ + (size_t)(MPROMPT + sb) * NIN + C_RK + sh * 128;
        const float qa = bf1(pq[lane]), qb_ = bf1(pq[lane + 64]), ka = bf1(pk[lane]), kb_ = bf1(pk[lane + 64]); const f2v cs = P_ROT[(size_t)4096 * 64 + lane];
        const float q_lo = qa * cs.x - qb_ * cs.y, q_hi = qb_ * cs.x + qa * cs.y, k_lo = (ka * cs.x - kb_ * cs.y) * 0.08838834764831845f, k_hi = (kb_ * cs.x + ka * cs.y) * 0.08838834764831845f;
        sqk = wave_sum(q_lo * k_lo + q_hi * k_hi); sq_sel = (hf ? q_hi : q_lo) * sgamma; sk_sel = hf ? k_hi : k_lo;
        const u32x2 vw = *(const GAS u32x2*)(P_PROJ + (size_t)(MPROMPT + sb) * NIN + C_RV + sh * 256 + 4 * lane); sv4 = (f32x4){bflo(vw.x), bfhi(vw.x), bflo(vw.y), bfhi(vw.y)}; }
    const size_t soff = (size_t)su * 32768 + (size_t)(64 * hf) * 256 + 4 * lane;
    f32x4 sbuf[8], so4 = {0.f, 0.f, 0.f, 0.f};
#pragma unroll
    for (int i = 0; i < 8; ++i) sbuf[i] = __builtin_nontemporal_load((const GAS f32x4*)(args.in[I_SR] + soff + (size_t)i * 256));
    __syncthreads();
    for (int task = tid; task < 2048; task += NTHR) {
        const int key = task >> 3, ch = task & 7, tok = (qb - 1) * 128 + key;
        v4u kr = {0u, 0u, 0u, 0u}, vr = {0u, 0u, 0u, 0u};
        if (tok >= 0) { const bf16* rp = P_PROJ + (size_t)(b * SEQ + tok) * NIN + kvh * 64 + ch * 8; kr = *(const GAS v4u*)(rp + C_AK); vr = *(const GAS v4u*)(rp + C_AV); }
        float kf[8], vf[8]; unpack8(kr, kf); unpack8(vr, vf);
        float ss = 0.f;
#pragma unroll
        for (int i = 0; i < 8; ++i) ss += kf[i] * kf[i];
        ss += __shfl_xor(ss, 1); ss += __shfl_xor(ss, 2); ss += __shfl_xor(ss, 4);
        const float rstd = 1.0f / sqrtf(ss * (1.0f / 64.0f) + EPS);
#pragma unroll
        for (int i = 0; i < 8; ++i) kf[i] = kf[i] * rstd * gk[ch * 8 + i];
        *(LAS v4u*)(Kh + key * 72 + ch * 8) = pack8(kf);
        const unsigned vw[4] = {vr.x, vr.y, vr.z, vr.w};
#pragma unroll
        for (int i = 0; i < 8; ++i) Vt[(ch * 8 + i) * 264 + key] = (bf16)((i & 1) ? (vw[i >> 1] >> 16) : (vw[i >> 1] & 0xffffu));
        if (qb == 31 && key >= 128) {
            float* ok = args.out + O_WKP + ((size_t)(b * 128 + (key - 128)) * 4 + kvh) * 64 + ch * 8; float* ov = args.out + O_WVP + ((size_t)(b * 128 + (key - 128)) * 4 + kvh) * 64 + ch * 8;
            *(GAS f32x4*)ok = (f32x4){kf[0], kf[1], kf[2], kf[3]}; *(GAS f32x4*)(ok + 4) = (f32x4){kf[4], kf[5], kf[6], kf[7]};
            *(GAS f32x4*)ov = (f32x4){vf[0], vf[1], vf[2], vf[3]}; *(GAS f32x4*)(ov + 4) = (f32x4){vf[4], vf[5], vf[6], vf[7]};
        }
    }
    for (int i = tid; i < 8 * 129; i += NTHR) { const int gg = i / 129, dist = i - gg * 129; biasT[gg * 132 + dist] = args.in[I_RB][t5_bucket(dist) * 32 + kvh * 8 + gg]; }
    __syncthreads();
    const int head = kvh * 8 + g; const float sink = args.in[I_SINK][head];
    float gqv[2][8];
#pragma unroll
    for (int s = 0; s < 2; ++s)
#pragma unroll
        for (int i = 0; i < 8; ++i) gqv[s][i] = gq[32 * s + 8 * fq + i] * 0.125f;
    const bf16* qbase = P_PROJ + ((size_t)b * SEQ + qb * 128 + fr) * NIN + C_AQ + head * 64 + 8 * fq;
    v4u qn0 = *(const GAS v4u*)qbase, qn1 = *(const GAS v4u*)(qbase + 32);
    for (int j = 0; j < 8; ++j) {
        {
#pragma unroll
            for (int i = 0; i < 8; ++i) { const float qd = __builtin_bit_cast(float, __builtin_amdgcn_readlane(__builtin_bit_cast(int, sq_sel), 8 * j + i)), kd = __builtin_bit_cast(float, __builtin_amdgcn_readlane(__builtin_bit_cast(int, sk_sel), 8 * j + i));
                const f32x4 s0 = sbuf[i]; so4 += s0 * qd; const f32x4 s1 = s0 * sgamma + sv4 * kd;
                __builtin_nontemporal_store(s1, (GAS f32x4*)(args.out + O_RS + soff + (size_t)(8 * j + i) * 256)); }
            if (j < 7) {
#pragma unroll
                for (int i = 0; i < 8; ++i) sbuf[i] = __builtin_nontemporal_load((const GAS f32x4*)(args.in[I_SR] + soff + (size_t)(8 * (j + 1) + i) * 256)); }
        }
        const size_t row = (size_t)b * SEQ + qb * 128 + 16 * j + fr;
        float q0[8], q1[8]; unpack8(qn0, q0); unpack8(qn1, q1);
        { const int jn = j < 7 ? j + 1 : 7; qn0 = *(const GAS v4u*)(qbase + (size_t)(16 * jn) * NIN); qn1 = *(const GAS v4u*)(qbase + (size_t)(16 * jn) * NIN + 32); }
        float ss = 0.f;
#pragma unroll
        for (int i = 0; i < 8; ++i) ss += q0[i] * q0[i] + q1[i] * q1[i];
        ss += __shfl_xor(ss, 16); ss += __shfl_xor(ss, 32);
        const float rstd = 1.0f / sqrtf(ss * (1.0f / 64.0f) + EPS);
#pragma unroll
        for (int i = 0; i < 8; ++i) { q0[i] *= rstd * gqv[0][i]; q1[i] *= rstd * gqv[1][i]; }
        bf16x8 qf[2]; qf[0] = __builtin_bit_cast(bf16x8, pack8(q0)); qf[1] = __builtin_bit_cast(bf16x8, pack8(q1));
        const int start = (16 * j < 96) ? 16 * j : 96;
        f32x4 sacc[10];
#pragma unroll
        for (int t = 0; t < 10; ++t) { sacc[t] = (f32x4){0.f, 0.f, 0.f, 0.f};
#pragma unroll
            for (int s = 0; s < 2; ++s) { const bf16x8 kfr = *(const LAS bf16x8*)(Kh + (start + 16 * t + fr) * 72 + 32 * s + 8 * fq); sacc[t] = MFMA16(kfr, qf[s], sacc[t]); } }
        float mx = -INFINITY;
#pragma unroll
        for (int t = 0; t < 10; ++t)
#pragma unroll
            for (int r = 0; r < 4; ++r) { const int key = start + 16 * t + 4 * fq + r, dist = 128 + 16 * j + fr - key; const bool valid = (dist >= 0) && (dist <= 128) && (qb > 0 || key >= 128);
                const int dc = dist < 0 ? 0 : (dist > 128 ? 128 : dist);
                const float sv = valid ? sacc[t][r] + biasT[g * 132 + dc] : -INFINITY; sacc[t][r] = sv; mx = fmaxf(mx, sv); }
        mx = fmaxf(mx, __shfl_xor(mx, 16)); mx = fmaxf(mx, __shfl_xor(mx, 32)); mx = fmaxf(mx, sink);
        float l = 0.f;
#pragma unroll
        for (int t = 0; t < 10; ++t)
#pragma unroll
            for (int r = 0; r < 4; ++r) { const float e = __expf(sacc[t][r] - mx); sacc[t][r] = e; l += e; }
        l += __shfl_xor(l, 16); l += __shfl_xor(l, 32); l += __expf(sink - mx);
        const float rl = 1.0f / l;
        bf16x8 pf[5];
#pragma unroll
        for (int ks = 0; ks < 5; ++ks) { v4u w; w.x = cvtpk(sacc[2 * ks][0] * rl, sacc[2 * ks][1] * rl); w.y = cvtpk(sacc[2 * ks][2] * rl, sacc[2 * ks][3] * rl);
            w.z = cvtpk(sacc[2 * ks + 1][0] * rl, sacc[2 * ks + 1][1] * rl); w.w = cvtpk(sacc[2 * ks + 1][2] * rl, sacc[2 * ks + 1][3] * rl); pf[ks] = __builtin_bit_cast(bf16x8, w); }
        bf16* op = P_MIX + row * DM + head * 64 + 4 * fq;
#pragma unroll
        for (int dt = 0; dt < 4; ++dt) { f32x4 o = (f32x4){0.f, 0.f, 0.f, 0.f};
#pragma unroll
            for (int ks = 0; ks < 5; ++ks) { const LAS bf16* vp = Vt + (16 * dt + fr) * 264 + start + 32 * ks + 4 * fq; const u32x2 a = *(const LAS u32x2*)vp, c = *(const LAS u32x2*)(vp + 16);
                const v4u vv = {a.x, a.y, c.x, c.y}; o = MFMA16(__builtin_bit_cast(bf16x8, vv), pf[ks], o); }
            u32x2 w; w.x = cvtpk(o[0], o[1]); w.y = cvtpk(o[2], o[3]); *(GAS u32x2*)(op + 16 * dt) = w; }
    }
    if (hf == 0) so4 += sv4 * sqk;
    { float* oa = P_OACC + (size_t)su * 256 + 4 * lane; atomicAdd(oa, so4[0]); atomicAdd(oa + 1, so4[1]); atomicAdd(oa + 2, so4[2]); atomicAdd(oa + 3, so4[3]); }
}
DEVI void sret_finalize(Frame& F, const Args& args) {
    const int gw = blockIdx.x * NWAVES + F.wave, NGW = F.G * NWAVES, lane = F.lane;
    for (int su = gw; su < 1024; su += NGW) { const int sh = su & 7, sb = su >> 3;
        const f32x4 o = *(const GAS f32x4*)(P_OACC + (size_t)su * 256 + 4 * lane);
        const float ssq = wave_sum((o[0] * o[0] + o[1] * o[1]) + (o[2] * o[2] + o[3] * o[3])); const float rn = 1.0f / sqrtf(ssq * (1.0f / 256.0f) + EPS);
        const u32x2 gw2 = *(const GAS u32x2*)(P_PROJ + (size_t)(MPROMPT + sb) * NIN + C_RG + sh * 256 + 4 * lane); const float gg[4] = {bflo(gw2.x), bfhi(gw2.x), bflo(gw2.y), bfhi(gw2.y)}; float r4[4];
#pragma unroll
        for (int r = 0; r < 4; ++r) r4[r] = gg[r] / (1.0f + __expf(-gg[r])) * o[r] * rn;
        u32x2 ow; ow.x = cvtpk(r4[0], r4[1]); ow.y = cvtpk(r4[2], r4[3]); *(GAS u32x2*)(P_MIXS + tiled_off(sb, 2048 + sh * 256 + 4 * lane)) = ow; }
}
DEVI void attn_sample_unit(Frame& F, const Args& args, int unit) {
    const int kvh = unit & 3, b = unit >> 2;
    LAS float* Kc = (LAS float*)(F.lds);
    LAS float* Vc = (LAS float*)(F.lds + 33792);
    LAS float* qs = (LAS float*)(F.lds + 33792 + 33280);
    LAS float* pl = qs + 512;
    LAS float* biasT = pl + 8 * 132;
    const int tid = F.tid, lane = F.lane, g = F.wave;
    const size_t prow = (size_t)(MPROMPT + b) * NIN;
    f32x4 ck[4], cv[4];
#pragma unroll
    for (int it = 0; it < 4; ++it) { const int idx = tid + it * NTHR, j = idx >> 4, c4 = idx & 15; const size_t src = ((size_t)(b * 128 + j) * 4 + kvh) * 64 + c4 * 4;
        ck[it] = *(const GAS f32x4*)(args.in[I_CK] + src); cv[it] = *(const GAS f32x4*)(args.in[I_CV] + src); }
    const float qv_raw = bf1(P_PROJ[prow + C_AQ + (kvh * 8 + g) * 64 + lane]), gq_l = args.in[I_GQ][lane];
    const float kv_raw = bf1(P_PROJ[prow + C_AK + kvh * 64 + lane]), gk_l = args.in[I_GK][lane], vv_raw = bf1(P_PROJ[prow + C_AV + kvh * 64 + lane]);
    float rbv[3];
#pragma unroll
    for (int it = 0; it < 3; ++it) { const int i = tid + it * NTHR; const int ii = i < 8 * 129 ? i : 0; const int gg = ii / 129, dist = ii - gg * 129; rbv[it] = args.in[I_RB][t5_bucket(dist) * 32 + kvh * 8 + gg]; }
    __syncthreads();
#pragma unroll
    for (int it = 0; it < 4; ++it) { const int idx = tid + it * NTHR, j = idx >> 4, c4 = idx & 15; const f32x4 kv = ck[it], vv = cv[it];
        Kc[j * 65 + c4 * 4 + 0] = kv.x; Kc[j * 65 + c4 * 4 + 1] = kv.y; Kc[j * 65 + c4 * 4 + 2] = kv.z; Kc[j * 65 + c4 * 4 + 3] = kv.w;
        *(LAS f32x4*)(Vc + j * 64 + c4 * 4) = vv;
        if (j >= 1) { const size_t dst = ((size_t)(b * 128 + (j - 1)) * 4 + kvh) * 64 + c4 * 4; *(GAS f32x4*)(args.out + O_WKS + dst) = kv; *(GAS f32x4*)(args.out + O_WVS + dst) = vv; } }
    {
        const float ss = wave_sum(qv_raw * qv_raw); qs[g * 64 + lane] = qv_raw * (1.0f / sqrtf(ss * (1.0f / 64.0f) + EPS)) * gq_l * 0.125f;
    }
    if (g == 0) { const float ss = wave_sum(kv_raw * kv_raw); const float kn = kv_raw * (1.0f / sqrtf(ss * (1.0f / 64.0f) + EPS)) * gk_l;
        Kc[128 * 65 + lane] = kn; args.out[O_WKS + ((size_t)(b * 128 + 127) * 4 + kvh) * 64 + lane] = kn; }
    if (g == 1) { Vc[128 * 64 + lane] = vv_raw; args.out[O_WVS + ((size_t)(b * 128 + 127) * 4 + kvh) * 64 + lane] = vv_raw; }
#pragma unroll
    for (int it = 0; it < 3; ++it) { const int i = tid + it * NTHR; if (i < 8 * 129) { const int gg = i / 129, dist = i - gg * 129; biasT[gg * 132 + dist] = rbv[it]; } }
    __syncthreads();
    {
        const float sink = args.in[I_SINK][kvh * 8 + g];
        float s0 = 0.f, s1 = 0.f, s2 = 0.f;
        for (int d = 0; d < 64; ++d) { const float q = qs[g * 64 + d]; s0 += q * Kc[lane * 65 + d]; s1 += q * Kc[(lane + 64) * 65 + d]; s2 += q * Kc[128 * 65 + d]; }
        s0 += biasT[g * 132 + (128 - lane)]; s1 += biasT[g * 132 + (64 - lane)]; s2 += biasT[g * 132 + 0];
        float mx = wave_max(fmaxf(s0, s1)); mx = fmaxf(mx, fmaxf(s2, sink));
        const float e0 = __expf(s0 - mx), e1 = __expf(s1 - mx), e2 = __expf(s2 - mx);
        const float l = wave_sum(e0 + e1) + e2 + __expf(sink - mx); const float rl = 1.0f / l;
        pl[g * 132 + lane] = e0 * rl; pl[g * 132 + 64 + lane] = e1 * rl; if (lane == 0) pl[g * 132 + 128] = e2 * rl;
    }
    __syncthreads();
    {
        float o = 0.f;
        for (int j = 0; j < 129; ++j) o += pl[g * 132 + j] * Vc[j * 64 + lane];
        P_MIXS[tiled_off(b, (kvh * 8 + g) * 64 + lane)] = (bf16)(cvtpk(o, 0.f) & 0xffffu);
    }
}
struct RetKRegs { v4u r0[2], r1[2]; f32x4 cs[2][4]; };
DEVI void ret_k_issue(int tid, const Args& args, RetKRegs& R, int b, int h, int c) {
#pragma unroll
    for (int it = 0; it < 2; ++it) { const int task = tid + it * NTHR, m = task & 127, ch = task >> 7;
        const int t = c * 128 + m; const bf16* rp = P_PROJ + (size_t)(b * SEQ + t) * NIN + C_RK + h * 128 + ch * 8;
        R.r0[it] = *(const GAS v4u*)rp; R.r1[it] = *(const GAS v4u*)(rp + 64);
        const GAS f32x4* rt = (const GAS f32x4*)((const GAS f2v*)P_ROT + (size_t)t * 64 + ch * 8);
#pragma unroll
        for (int j = 0; j < 4; ++j) R.cs[it][j] = rt[j]; }
}
template <bool TRANSPOSED> DEVI void ret_k_write(int tid, const RetKRegs& R, LAS bf16* Kd, float lg2) {
#pragma unroll
    for (int it = 0; it < 2; ++it) { const int task = tid + it * NTHR, m = task & 127, ch = task >> 7;
        float a[8], bb[8]; unpack8(R.r0[it], a); unpack8(R.r1[it], bb);
        float sc = 0.08838834764831845f; if (TRANSPOSED) sc *= exp2f((float)(127 - m) * lg2);
        float lo[8], hi[8];
#pragma unroll
        for (int i = 0; i < 8; ++i) { const float cx = R.cs[it][i >> 1][(i & 1) * 2], cy = R.cs[it][i >> 1][(i & 1) * 2 + 1]; lo[i] = (a[i] * cx - bb[i] * cy) * sc; hi[i] = (bb[i] * cx + a[i] * cy) * sc; }
        if (TRANSPOSED) {
#pragma unroll
            for (int i = 0; i < 8; i += 2) { const unsigned wl = cvtpk(lo[i], lo[i + 1]), wh = cvtpk(hi[i], hi[i + 1]);
                Kd[(ch * 8 + i) * 136 + m] = (bf16)(wl & 0xffffu); Kd[(ch * 8 + i + 1) * 136 + m] = (bf16)(wl >> 16);
                Kd[(64 + ch * 8 + i) * 136 + m] = (bf16)(wh & 0xffffu); Kd[(64 + ch * 8 + i + 1) * 136 + m] = (bf16)(wh >> 16); }
        } else { *(LAS v4u*)(Kd + m * 136 + ch * 8) = pack8(lo); *(LAS v4u*)(Kd + m * 136 + 64 + ch * 8) = pack8(hi); }
    }
}
struct RetVRegs { v4u r[8]; };
DEVI void ret_v_issue(int tid, const Args& args, RetVRegs& R, int b, int h, int c) {
#pragma unroll
    for (int it = 0; it < 8; ++it) { const int task = tid + it * NTHR, m = task & 127, ch = task >> 7;
        R.r[it] = *(const GAS v4u*)(P_PROJ + (size_t)(b * SEQ + c * 128 + m) * NIN + C_RV + h * 256 + ch * 8); }
}
DEVI void ret_v_write(int tid, const RetVRegs& R, LAS bf16* Vt) {
#pragma unroll
    for (int it = 0; it < 8; ++it) { const int task = tid + it * NTHR, m = task & 127, ch = task >> 7;
        const unsigned w[4] = {R.r[it].x, R.r[it].y, R.r[it].z, R.r[it].w};
#pragma unroll
        for (int i = 0; i < 8; ++i) Vt[(ch * 8 + i) * 136 + m] = (bf16)((i & 1) ? (w[i >> 1] >> 16) : (w[i >> 1] & 0xffffu)); }
}
DEVI float ret_log2_gamma(int h) { return log2f(1.0f - exp2f(-5.0f - (float)h)); }
DEVI void ret_kv_unit(Frame& F, const Args& args, int unit) {
    const int c = unit & 31, h = (unit >> 5) & 7, b = unit >> 8;
    LAS bf16* Kt = (LAS bf16*)(F.lds); LAS bf16* Vt = (LAS bf16*)(F.lds + 34816);
    const int lane = F.lane, w = F.wave, fr = lane & 15, fq = lane >> 4;
    int tidl = F.tid; asm volatile("" : "+v"(tidl));
    RetKRegs RK; RetVRegs RV; ret_k_issue(tidl, args, RK, b, h, c); ret_v_issue(tidl, args, RV, b, h, c);
    __syncthreads();
    ret_k_write<true>(tidl, RK, Kt, ret_log2_gamma(h)); ret_v_write(tidl, RV, Vt);
    __syncthreads();
    f32x4 acc[8][2];
#pragma unroll
    for (int dt = 0; dt < 8; ++dt) { acc[dt][0] = (f32x4){0.f, 0.f, 0.f, 0.f}; acc[dt][1] = (f32x4){0.f, 0.f, 0.f, 0.f}; }
#pragma unroll
    for (int ks = 0; ks < 4; ++ks) {
        bf16x8 vf[2];
#pragma unroll
        for (int et = 0; et < 2; ++et) vf[et] = *(const LAS bf16x8*)(Vt + (32 * w + 16 * et + fr) * 136 + 32 * ks + 8 * fq);
#pragma unroll
        for (int dt = 0; dt < 8; ++dt) { const bf16x8 kf = *(const LAS bf16x8*)(Kt + (16 * dt + fr) * 136 + 32 * ks + 8 * fq);
            acc[dt][0] = MFMA16(kf, vf[0], acc[dt][0]); acc[dt][1] = MFMA16(kf, vf[1], acc[dt][1]); }
    }
    bf16* dst = P_KVT + (size_t)unit * 32768;
#pragma unroll
    for (int dt = 0; dt < 8; ++dt)
#pragma unroll
        for (int et = 0; et < 2; ++et) { u32x2 kw; kw.x = cvtpk(acc[dt][et][0], acc[dt][et][1]); kw.y = cvtpk(acc[dt][et][2], acc[dt][et][3]); *(GAS u32x2*)(dst + (size_t)(32 * w + 16 * et + fr) * 128 + 16 * dt + 4 * fq) = kw; }
}
DEVI void ret_sample_unit(Frame& F, const Args& args, int unit) {
    const int h = unit & 7, b = unit >> 3;
    LAS float* qv = (LAS float*)(F.lds); LAS float* kv = qv + 128; LAS float* vv = kv + 128; LAS float* red = vv + 256; LAS float* red2 = red + 8 * 256;
    const int tid = F.tid, lane = F.lane, w = F.wave;
    const size_t prow = (size_t)(MPROMPT + b) * NIN;
    const float gamma = 1.0f - exp2f(-5.0f - (float)h);
    const size_t sbase = (size_t)unit * 32768;
    f32x4 s0v[16];
#pragma unroll
    for (int i = 0; i < 16; ++i) s0v[i] = __builtin_nontemporal_load((const GAS f32x4*)(args.in[I_SR] + sbase + (size_t)(w + 8 * i) * 256 + 4 * lane));
    __syncthreads();
    if (tid < 128) { const int d = tid & 63, isk = tid >> 6; const bf16* rp = P_PROJ + prow + (isk ? C_RK : C_RQ) + h * 128;
        const float a = bf1(rp[d]), bb = bf1(rp[d + 64]); const f2v cs = P_ROT[(size_t)4096 * 64 + d]; const float sc = isk ? 0.08838834764831845f : 1.0f;
        LAS float* dstv = isk ? kv : qv; dstv[d] = (a * cs.x - bb * cs.y) * sc; dstv[d + 64] = (bb * cs.x + a * cs.y) * sc; }
    else if (tid < 384) { vv[tid - 128] = bf1(P_PROJ[prow + C_RV + h * 256 + (tid - 128)]); }
    __syncthreads();
    const float qk = wave_sum(qv[lane] * kv[lane] + qv[lane + 64] * kv[lane + 64]);
    const f32x4 v4 = *(const LAS f32x4*)(vv + 4 * lane);
    f32x4 o4 = {0.f, 0.f, 0.f, 0.f};
#pragma unroll
    for (int i = 0; i < 16; ++i) { const int d = w + 8 * i; const size_t off = sbase + (size_t)d * 256 + 4 * lane;
        const f32x4 s0 = s0v[i]; const float qd = qv[d] * gamma, kd = kv[d];
        o4 += s0 * qd; const f32x4 s1 = s0 * gamma + v4 * kd; __builtin_nontemporal_store(s1, (GAS f32x4*)(args.out + O_RS + off)); }
    *(LAS f32x4*)(red + w * 256 + 4 * lane) = o4;
    __syncthreads();
    float o = 0.f;
    if (tid < 256) {
#pragma unroll
        for (int i = 0; i < 8; ++i) o += red[i * 256 + tid];
        o += qk * vv[tid]; }
    const float ssq = wave_sum(o * o);
    if (lane == 0) red2[w] = ssq;
    __syncthreads();
    if (tid < 256) { const float tot = red2[0] + red2[1] + red2[2] + red2[3]; const float rn = 1.0f / sqrtf(tot * (1.0f / 256.0f) + EPS);
        const float rg = bf1(P_PROJ[prow + C_RG + h * 256 + tid]); const float sg = rg / (1.0f + __expf(-rg));
        P_MIX[(size_t)(MPROMPT + b) * DM + 2048 + h * 256 + tid] = (bf16)(cvtpk(sg * o * rn, 0.f) & 0xffffu); }
}
DEVI void ret_scan(Frame& F, const Args& args) {
    LAS float* tl = (LAS float*)(F.lds);
    for (int tile = blockIdx.x; tile < 16 * 16; tile += F.G) {
        const int g4 = tile * NTHR + F.tid, bh = g4 >> 13, within = g4 & 8191, h = bh & 7;
        const float g128 = exp2f(128.0f * ret_log2_gamma(h));
        f32x4 S = {0.f, 0.f, 0.f, 0.f};
        const GAS u32x2* src = (const GAS u32x2*)P_KVT + (size_t)bh * NCHUNK * 8192 + within; GAS u32x2* dst = (GAS u32x2*)P_ST + (size_t)bh * NCHUNK * 8192 + within;
        u32x2 kws[NCHUNK];
#pragma unroll
        for (int c = 0; c < NCHUNK; ++c) kws[c] = __builtin_nontemporal_load(src + (size_t)c * 8192);
#pragma unroll
        for (int c = 0; c < NCHUNK; ++c) { const u32x2 kw = kws[c]; const f32x4 kv = {bflo(kw.x), bfhi(kw.x), bflo(kw.y), bfhi(kw.y)};
            u32x2 w; w.x = cvtpk(S[0], S[1]); w.y = cvtpk(S[2], S[3]); dst[(size_t)c * 8192] = w; S = S * g128 + kv; }
        const int el = F.tid >> 5, d0 = (F.tid & 31) * 4;
        __syncthreads();
#pragma unroll
        for (int i = 0; i < 4; ++i) tl[el * 129 + d0 + i] = S[i];
        __syncthreads();
        { const int d = F.tid >> 2, e4 = F.tid & 3, e0 = (within >> 5) - el;
          const f32x4 o = {tl[(4 * e4 + 0) * 129 + d], tl[(4 * e4 + 1) * 129 + d], tl[(4 * e4 + 2) * 129 + d], tl[(4 * e4 + 3) * 129 + d]};
          *(GAS f32x4*)(args.out + O_RP + ((size_t)bh * 128 + d) * 256 + e0 + 4 * e4) = o; }
    }
}
DEVI void ret_stage_half(Frame& F, const Args& args, LAS bf16* Vh, LAS bf16* Sh, int b, int h, int c, int unit, int hf) {
    const bf16* stp = P_ST + (size_t)unit * 32768 + (size_t)(128 * hf) * 128;
#pragma unroll 1
    for (int task = F.tid; task < 2048; task += NTHR) {
        const int m = task & 127, ch = task >> 7, e = task >> 4, cs = task & 15;
        const v4u rv = *(const GAS v4u*)(P_PROJ + (size_t)(b * SEQ + c * 128 + m) * NIN + C_RV + h * 256 + 128 * hf + ch * 8);
        const v4u rs = *(const GAS v4u*)(stp + (size_t)e * 128 + cs * 8);
        const unsigned w[4] = {rv.x, rv.y, rv.z, rv.w};
#pragma unroll
        for (int i = 0; i < 8; ++i) Vh[(ch * 8 + i) * 136 + m] = (bf16)((i & 1) ? (w[i >> 1] >> 16) : (w[i >> 1] & 0xffffu));
        *(LAS v4u*)(Sh + e * 136 + cs * 8) = rs;
    }
}
DEVI void ret_out_unit(Frame& F, const Args& args, int unit) {
    const int c = unit & 31, h = (unit >> 5) & 7, b = unit >> 8;
    LAS bf16* Km = (LAS bf16*)(F.lds); LAS bf16* Vh = (LAS bf16*)(F.lds + 34816); LAS bf16* Sh = (LAS bf16*)(F.lds + 2 * 34816);
    const int lane = F.lane, w = F.wave, fr = lane & 15, fq = lane >> 4;
    const float lg2 = ret_log2_gamma(h);
    __syncthreads();
    { RetKRegs RK; ret_k_issue(F.tid, args, RK, b, h, c); ret_k_write<false>(F.tid, RK, Km, lg2); }
    ret_stage_half(F, args, Vh, Sh, b, h, c, unit, 0);
    __syncthreads();
    int l = 16 * w + fr; asm volatile("" : "+v"(l));
    const int t = c * 128 + l; const size_t row = (size_t)b * SEQ + t;
    bf16x8 qf[4], qdf[4];
    {
        float qa[4][8]; const bf16* qp = P_PROJ + row * NIN + C_RQ + h * 128 + 8 * fq;
#pragma unroll
        for (int s = 0; s < 4; ++s) { const v4u r = *(const GAS v4u*)(qp + 32 * s); unpack8(r, qa[s]); }
        const float dec = exp2f((float)(l + 1) * lg2);
#pragma unroll
        for (int s = 0; s < 2; ++s) { const GAS f2v* rt = (const GAS f2v*)P_ROT + (size_t)t * 64 + 32 * s + 8 * fq;
            float lo[8], hi[8], lod[8], hid[8];
#pragma unroll
            for (int i = 0; i < 8; ++i) { const f2v cs = rt[i]; lo[i] = qa[s][i] * cs.x - qa[s + 2][i] * cs.y; hi[i] = qa[s + 2][i] * cs.x + qa[s][i] * cs.y; lod[i] = lo[i] * dec; hid[i] = hi[i] * dec; }
            qf[s] = __builtin_bit_cast(bf16x8, pack8(lo)); qf[s + 2] = __builtin_bit_cast(bf16x8, pack8(hi)); qdf[s] = __builtin_bit_cast(bf16x8, pack8(lod)); qdf[s + 2] = __builtin_bit_cast(bf16x8, pack8(hid)); }
    }
    f32x4 sacc[8];
#pragma unroll
    for (int mt = 0; mt < 8; ++mt) { sacc[mt] = (f32x4){0.f, 0.f, 0.f, 0.f};
        if (mt <= w) {
#pragma unroll
            for (int s = 0; s < 4; ++s) { const bf16x8 kf = *(const LAS bf16x8*)(Km + (16 * mt + fr) * 136 + 32 * s + 8 * fq); sacc[mt] = MFMA16(kf, qf[s], sacc[mt]); }
#pragma unroll
            for (int r = 0; r < 4; ++r) { const int diff = l - (16 * mt + 4 * fq + r); sacc[mt][r] = (diff >= 0) ? sacc[mt][r] * exp2f((float)diff * lg2) : 0.f; }
        } }
    bf16x8 pf[4];
#pragma unroll
    for (int ks = 0; ks < 4; ++ks) { v4u pw; pw.x = cvtpk(sacc[2 * ks][0], sacc[2 * ks][1]); pw.y = cvtpk(sacc[2 * ks][2], sacc[2 * ks][3]); pw.z = cvtpk(sacc[2 * ks + 1][0], sacc[2 * ks + 1][1]); pw.w = cvtpk(sacc[2 * ks + 1][2], sacc[2 * ks + 1][3]); pf[ks] = __builtin_bit_cast(bf16x8, pw); }
    f32x4 oacc[16];
#pragma unroll
    for (int hf = 0; hf < 2; ++hf) {
        if (hf == 1) { __syncthreads(); ret_stage_half(F, args, Vh, Sh, b, h, c, unit, 1); __syncthreads(); }
#pragma unroll
        for (int et = 0; et < 8; ++et) { f32x4 o = (f32x4){0.f, 0.f, 0.f, 0.f};
#pragma unroll
            for (int ks = 0; ks < 4; ++ks) if (2 * ks <= w) { const LAS bf16* vp = Vh + (16 * et + fr) * 136 + 32 * ks + 4 * fq; const u32x2 a = *(const LAS u32x2*)vp, cc = *(const LAS u32x2*)(vp + 16);
                const v4u vv = {a.x, a.y, cc.x, cc.y}; o = MFMA16(__builtin_bit_cast(bf16x8, vv), pf[ks], o); }
#pragma unroll
            for (int s = 0; s < 4; ++s) { const bf16x8 sf = *(const LAS bf16x8*)(Sh + (16 * et + fr) * 136 + 32 * s + 8 * fq); o = MFMA16(sf, qdf[s], o); }
            oacc[8 * hf + et] = o; }
    }
    const bf16* gp = P_PROJ + row * NIN + C_RG + h * 256 + 4 * fq; bf16* op = P_MIX + row * DM + 2048 + h * 256 + 4 * fq;
    u32x2 gws[16];
#pragma unroll
    for (int et = 0; et < 16; ++et) gws[et] = *(const GAS u32x2*)(gp + 16 * et);
    float ss = 0.f;
#pragma unroll
    for (int et = 0; et < 16; ++et) ss += (oacc[et][0] * oacc[et][0] + oacc[et][1] * oacc[et][1]) + (oacc[et][2] * oacc[et][2] + oacc[et][3] * oacc[et][3]);
    ss += __shfl_xor(ss, 16); ss += __shfl_xor(ss, 32);
    const float rn = 1.0f / sqrtf(ss * (1.0f / 256.0f) + EPS);
#pragma unroll
    for (int et = 0; et < 16; ++et) { const u32x2 gw = gws[et]; const float gg[4] = {bflo(gw.x), bfhi(gw.x), bflo(gw.y), bfhi(gw.y)}; float r4[4];
#pragma unroll
        for (int r = 0; r < 4; ++r) r4[r] = gg[r] / (1.0f + __expf(-gg[r])) * oacc[et][r] * rn;
        u32x2 ow; ow.x = cvtpk(r4[0], r4[1]); ow.y = cvtpk(r4[2], r4[3]); *(GAS u32x2*)(op + 16 * et) = ow; }
}
DEVI void conv_gate_pass(Frame& F, const Args& args) {
    const int gt = blockIdx.x * NTHR + F.tid, NGT = F.G * NTHR;
    const float* cw = args.in[I_CW]; const float* cb = args.in[I_CB];
    constexpr int NCG = DFF / 8;
    constexpr int P7_SEG = 88, P7_NSEG = (MPROMPT + P7_SEG - 1) / P7_SEG;
    static_assert(P7_SEG % 8 == 0 && (MPROMPT - (P7_NSEG - 1) * P7_SEG) % 8 == 0 && SEQ % P7_SEG != 1 && SEQ % P7_SEG != 0, "segment / sequence geometry");
    for (int task = gt; task < P7_NSEG * NCG; task += NGT) {
        const int seg = task / NCG, cg = task - seg * NCG, r0 = seg * P7_SEG, j0 = cg * 8; const int nb = ((MPROMPT - r0 < P7_SEG) ? (MPROMPT - r0) : P7_SEG) / 4;
        float w0[16], w1[16], w2[16], bs[16];
#pragma unroll
        for (int i = 0; i < 8; ++i) { w0[i] = cw[j0 + i]; w1[i] = cw[NUP + j0 + i]; w2[i] = cw[2 * NUP + j0 + i]; bs[i] = cb[j0 + i];
            w0[8 + i] = cw[DFF + j0 + i]; w1[8 + i] = cw[NUP + DFF + j0 + i]; w2[8 + i] = cw[2 * NUP + DFF + j0 + i]; bs[8 + i] = cb[DFF + j0 + i]; }
        float p2[16], p1[16];
        const bool first = (r0 & (SEQ - 1)) == 0;
        if (first) {
#pragma unroll
            for (int i = 0; i < 16; ++i) { p2[i] = 0.f; p1[i] = 0.f; }
        } else { const bf16* ua = P_U + (size_t)(r0 - 2) * NUP + j0; float t8[8];
            unpack8(*(const GAS v4u*)ua, t8);
#pragma unroll
            for (int i = 0; i < 8; ++i) p2[i] = t8[i];
            unpack8(*(const GAS v4u*)(ua + DFF), t8);
#pragma unroll
            for (int i = 0; i < 8; ++i) p2[8 + i] = t8[i];
            unpack8(*(const GAS v4u*)(ua + NUP), t8);
#pragma unroll
            for (int i = 0; i < 8; ++i) p1[i] = t8[i];
            unpack8(*(const GAS v4u*)(ua + NUP + DFF), t8);
#pragma unroll
            for (int i = 0; i < 8; ++i) p1[8 + i] = t8[i]; }
        v4u ba[8], bb[8];
#define P7_LOAD(buf, b) do { _Pragma("unroll") for (int q = 0; q < 4; ++q) { const bf16* up_ = P_U + (size_t)(r0 + 4 * (b) + q) * NUP + j0; buf[2 * q] = __builtin_nontemporal_load((const GAS v4u*)up_); buf[2 * q + 1] = __builtin_nontemporal_load((const GAS v4u*)(up_ + DFF)); } } while (0)
#define P7_COMP(buf, b) do { _Pragma("unroll") for (int q = 0; q < 4; ++q) { const int row = r0 + 4 * (b) + q; if ((row & (SEQ - 1)) == 0) { _Pragma("unroll") for (int i = 0; i < 16; ++i) { p2[i] = 0.f; p1[i] = 0.f; } } float cur[16]; { float t8[8]; unpack8(buf[2 * q], t8); \
            _Pragma("unroll") for (int i = 0; i < 8; ++i) cur[i] = t8[i]; unpack8(buf[2 * q + 1], t8); _Pragma("unroll") for (int i = 0; i < 8; ++i) cur[8 + i] = t8[i]; } \
            float a8[8]; \
            _Pragma("unroll") for (int i = 0; i < 8; i += 2) { const float cg0 = bs[i] + w0[i] * p2[i] + w1[i] * p1[i] + w2[i] * cur[i], cg1 = bs[i + 1] + w0[i + 1] * p2[i + 1] + w1[i + 1] * p1[i + 1] + w2[i + 1] * cur[i + 1]; \
                const float cv0 = bs[8 + i] + w0[8 + i] * p2[8 + i] + w1[8 + i] * p1[8 + i] + w2[8 + i] * cur[8 + i], cv1 = bs[9 + i] + w0[9 + i] * p2[9 + i] + w1[9 + i] * p1[9 + i] + w2[9 + i] * cur[9 + i]; \
                const pg8::f32x2 ge = pg8::gelu_pk((pg8::f32x2){cg0, cg1}); a8[i] = ge.x * cv0; a8[i + 1] = ge.y * cv1; } \
            *(GAS v4u*)(P_ACT + (size_t)row * DFF + j0) = pack8(a8); \
            if ((row & (SEQ - 1)) >= SEQ - 2) { float* oc = args.out + O_CP + ((size_t)(row >> 12) * 2 + ((row & (SEQ - 1)) - (SEQ - 2))) * NUP + j0; \
                _Pragma("unroll") for (int i = 0; i < 8; ++i) { oc[i] = cur[i]; oc[DFF + i] = cur[8 + i]; } } \
            _Pragma("unroll") for (int i = 0; i < 16; ++i) { p2[i] = p1[i]; p1[i] = cur[i]; } } } while (0)
        P7_LOAD(ba, 0);
#pragma unroll 1
        for (int b = 0; b < nb; b += 2) {
            P7_LOAD(bb, b + 1);
            P7_COMP(ba, b);
            if (b + 2 < nb) P7_LOAD(ba, b + 2);
            P7_COMP(bb, b + 1);
        }
#undef P7_LOAD
#undef P7_COMP
    }
    for (int task = gt; task < 2 * MSAMPLE * NCG; task += NGT) {
        const int rb = task / NCG, cg = task - rb * NCG, j0 = cg * 8;
        if (rb >= MSAMPLE) { const v4u z = {0u, 0u, 0u, 0u}; *(GAS v4u*)(P_ACT + (size_t)(MREAL + rb - MSAMPLE) * DFF + j0) = z; continue; }
        const int row = MPROMPT + rb; const bf16* up = P_U + (size_t)row * NUP + j0;
        float cur[16]; { float t8[8]; unpack8(*(const GAS v4u*)up, t8);
#pragma unroll
            for (int i = 0; i < 8; ++i) cur[i] = t8[i];
            unpack8(*(const GAS v4u*)(up + DFF), t8);
#pragma unroll
            for (int i = 0; i < 8; ++i) cur[8 + i] = t8[i]; }
        const float* sc0 = args.in[I_SC] + (size_t)rb * 2 * NUP + j0; const float* sc1 = sc0 + NUP;
        float* oc0 = args.out + O_CS + (size_t)rb * 2 * NUP + j0; float* oc1 = oc0 + NUP;
        float a8[8];
#pragma unroll
        for (int i = 0; i < 8; i += 2) {
            const float p2g0 = sc0[i], p2g1 = sc0[i + 1], p1g0 = sc1[i], p1g1 = sc1[i + 1], p2v0 = sc0[DFF + i], p2v1 = sc0[DFF + i + 1], p1v0 = sc1[DFF + i], p1v1 = sc1[DFF + i + 1];
            const float cg0 = cb[j0 + i] + cw[j0 + i] * p2g0 + cw[NUP + j0 + i] * p1g0 + cw[2 * NUP + j0 + i] * cur[i];
            const float cg1 = cb[j0 + i + 1] + cw[j0 + i + 1] * p2g1 + cw[NUP + j0 + i + 1] * p1g1 + cw[2 * NUP + j0 + i + 1] * cur[i + 1];
            const float cv0 = cb[DFF + j0 + i] + cw[DFF + j0 + i] * p2v0 + cw[NUP + DFF + j0 + i] * p1v0 + cw[2 * NUP + DFF + j0 + i] * cur[8 + i];
            const float cv1 = cb[DFF + j0 + i + 1] + cw[DFF + j0 + i + 1] * p2v1 + cw[NUP + DFF + j0 + i + 1] * p1v1 + cw[2 * NUP + DFF + j0 + i + 1] * cur[8 + i + 1];
            const pg8::f32x2 ge = pg8::gelu_pk((pg8::f32x2){cg0, cg1}); a8[i] = ge.x * cv0; a8[i + 1] = ge.y * cv1;
            oc0[i] = p1g0; oc0[i + 1] = p1g1; oc0[DFF + i] = p1v0; oc0[DFF + i + 1] = p1v1;
            oc1[i] = cur[i]; oc1[i + 1] = cur[i + 1]; oc1[DFF + i] = cur[8 + i]; oc1[DFF + i + 1] = cur[8 + i + 1]; }
        *(GAS v4u*)(P_ACTS + tiled_off(rb, j0)) = pack8(a8);
    }
}

template <bool TILED> DEVI f32x4 sliver_gemm_t(LAS unsigned char* lds, const bf16* A, const bf16* Bt, int K, int n0, int lane, int wave) {
    const int fr = lane & 15, fq = lane >> 4, ks = K >> 3, nst = ks >> 5;
    const bf16* ap = TILED ? A + ((size_t)(wave * (ks >> 5)) * 128 + fr) * 32 + 8 * fq : A + (size_t)fr * K + wave * ks + 8 * fq; const bf16* bp = Bt + (size_t)(n0 + fr) * K + wave * ks + 8 * fq;
    const size_t rt_stride = TILED ? (size_t)16 * 32 : (size_t)16 * K; const int ast = TILED ? 128 : 1;
    f32x4 acc[8];
#pragma unroll
    for (int rt = 0; rt < 8; ++rt) acc[rt] = (f32x4){0.f, 0.f, 0.f, 0.f};
    const int rot = (int)(blockIdx.x >> 3) % nst;
#define SLV_OFF(st) (32 * (((st) + rot) >= nst ? ((st) + rot) - nst : ((st) + rot)))
    v4u a0[8], a1[8], b0, b1;
    { const int o0 = SLV_OFF(0); b0 = *(const GAS v4u*)(bp + o0);
#pragma unroll
      for (int rt = 0; rt < 8; ++rt) a0[rt] = *(const GAS v4u*)(ap + rt * rt_stride + (size_t)o0 * ast); }
    for (int st = 0; st < nst; st += 2) {
        if (st + 1 < nst) { const int o1 = SLV_OFF(st + 1); b1 = *(const GAS v4u*)(bp + o1);
#pragma unroll
            for (int rt = 0; rt < 8; ++rt) a1[rt] = *(const GAS v4u*)(ap + rt * rt_stride + (size_t)o1 * ast); }
#pragma unroll
        for (int rt = 0; rt < 8; ++rt) acc[rt] = MFMA16(__builtin_bit_cast(bf16x8, b0), __builtin_bit_cast(bf16x8, a0[rt]), acc[rt]);
        if (st + 1 < nst) {
            if (st + 2 < nst) { const int o2 = SLV_OFF(st + 2); b0 = *(const GAS v4u*)(bp + o2);
#pragma unroll
                for (int rt = 0; rt < 8; ++rt) a0[rt] = *(const GAS v4u*)(ap + rt * rt_stride + (size_t)o2 * ast); }
#pragma unroll
            for (int rt = 0; rt < 8; ++rt) acc[rt] = MFMA16(__builtin_bit_cast(bf16x8, b1), __builtin_bit_cast(bf16x8, a1[rt]), acc[rt]);
        }
    }
#undef SLV_OFF
    LAS f32x4* red = (LAS f32x4*)lds;
    __syncthreads();
#pragma unroll
    for (int rt = 0; rt < 8; ++rt) red[(wave * 8 + rt) * 64 + lane] = acc[rt];
    __syncthreads();
    f32x4 r = red[wave * 64 + lane];
#pragma unroll
    for (int sw = 1; sw < 8; ++sw) r += red[(sw * 8 + wave) * 64 + lane];
    return r;
}
DEVI f32x4 sliver_gemm(LAS unsigned char* lds, const bf16* A, const bf16* Bt, int K, int n0, int lane, int wave) { return sliver_gemm_t<false>(lds, A, Bt, K, n0, lane, wave); }
DEVI f32x4 sliver_gemm_64x32(LAS unsigned char* lds, const bf16* A, const bf16* Bt, int K, int rh, int n0, int lane, int wave) {
    const int fr = lane & 15, fq = lane >> 4, ks = K >> 3, nst = ks >> 5;
    const bf16* ap = A + ((size_t)(wave * nst) * 128 + 64 * rh + fr) * 32 + 8 * fq; const bf16* bp = Bt + (size_t)(n0 + fr) * K + wave * ks + 8 * fq; const size_t bct = (size_t)16 * K;
    f32x4 acc[8];
#pragma unroll
    for (int i = 0; i < 8; ++i) acc[i] = (f32x4){0.f, 0.f, 0.f, 0.f};
    const int rot = (int)(blockIdx.x >> 3) % nst;
#define SLV_OFF(st) (32 * (((st) + rot) >= nst ? ((st) + rot) - nst : ((st) + rot)))
#define SLV_LD(a, b, o) do { b[0] = *(const GAS v4u*)(bp + (o)); b[1] = *(const GAS v4u*)(bp + bct + (o)); _Pragma("unroll") for (int rt = 0; rt < 4; ++rt) a[rt] = *(const GAS v4u*)(ap + rt * 512 + (size_t)(o) * 128); } while (0)
#define SLV_MM(a, b) do { _Pragma("unroll") for (int rt = 0; rt < 4; ++rt) _Pragma("unroll") for (int ct = 0; ct < 2; ++ct) acc[rt * 2 + ct] = MFMA16(__builtin_bit_cast(bf16x8, b[ct]), __builtin_bit_cast(bf16x8, a[rt]), acc[rt * 2 + ct]); } while (0)
    v4u a0[4], a1[4], a2[4], b0[2], b1[2], b2[2];
    SLV_LD(a0, b0, SLV_OFF(0)); if (1 < nst) SLV_LD(a1, b1, SLV_OFF(1));
    for (int st = 0; st < nst; st += 3) {
        if (st + 2 < nst) SLV_LD(a2, b2, SLV_OFF(st + 2));
        SLV_MM(a0, b0);
        if (st + 1 < nst) { if (st + 3 < nst) SLV_LD(a0, b0, SLV_OFF(st + 3)); SLV_MM(a1, b1); }
        if (st + 2 < nst) { if (st + 4 < nst) SLV_LD(a1, b1, SLV_OFF(st + 4)); SLV_MM(a2, b2); }
    }
#undef SLV_OFF
#undef SLV_LD
#undef SLV_MM
    LAS f32x4* red = (LAS f32x4*)lds;
    __syncthreads();
#pragma unroll
    for (int i = 0; i < 8; ++i) red[(wave * 8 + i) * 64 + lane] = acc[i];
    __syncthreads();
    f32x4 r = red[wave * 64 + lane];
#pragma unroll
    for (int sw = 1; sw < 8; ++sw) r += red[(sw * 8 + wave) * 64 + lane];
    return r;
}
template <bool BASE_BF16, bool OUT_F32> DEVI void sliver_resid(const f32x4 acc, int row, int c, const float* base  , float* outf  , bf16* outb, float* ss, bf16* outt  ) {
    const size_t off = (size_t)row * DM + c; f32x4 b4;
    if (BASE_BF16) { const u32x2 bw = *(const GAS u32x2*)(outb + off); b4 = (f32x4){bflo(bw.x), bfhi(bw.x), bflo(bw.y), bfhi(bw.y)}; } else b4 = *(const GAS f32x4*)(base + off);
    const f32x4 o = b4 + acc;
    if (OUT_F32) *(GAS f32x4*)(outf + off) = o;
    u32x2 w; w.x = cvtpk(o[0], o[1]); w.y = cvtpk(o[2], o[3]); *(GAS u32x2*)(outb + off) = w; if (outt) *(GAS u32x2*)(outt + tiled_off(row, c)) = w;
    float s = (o[0] * o[0] + o[1] * o[1]) + (o[2] * o[2] + o[3] * o[3]); s += __shfl_xor(s, 16); s += __shfl_xor(s, 32);
    if ((threadIdx.x & 48) == 0) atomicAdd(ss + row, s);
}
#ifndef SLV_DUP
#define SLV_DUP 1
#endif
#ifndef SLV_TILED
#define SLV_TILED false
#endif
#define SLV_ROW(sv) (64 * ((sv) & 1) + 16 * (F.wave >> 1) + (F.lane & 15))
#define SLV_COL(sv) (32 * ((sv) >> 1) + 16 * (F.wave & 1) + 4 * (F.lane >> 4))
__global__ void __launch_bounds__(NTHR, 2) mk_fwd(Args args) {
    extern __shared__ __attribute__((aligned(16))) unsigned char lds[];
    Frame F;
    F.lds = (LAS unsigned char*)lds;
    F.MISC = (volatile LAS unsigned*)(F.lds + MISC_OFF);
    F.tid = threadIdx.x; F.lane = F.tid & 63; F.wave = __builtin_amdgcn_readfirstlane(F.tid >> 6); F.G = gridDim.x;
    unsigned char* ws = args.ws;
    F.ctl = (gu32*)(ws + WS_CTL);
    for (int u = F.tid; u < (LDS_BYTES - LDSCTL_OFF) / 4; u += NTHR) ((LAS unsigned*)(F.lds + LDSCTL_OFF))[u] = 0u;
    __syncthreads();
    XcdBarrier bar; bar.bar = (unsigned*)(F.ctl + CW_BAR); bar.x = 0; bar.st = nullptr;
    if (N_LAUNCHES == 1) bar = xcd_barrier_post((unsigned*)(F.ctl + CW_BAR), F.MISC + 8);
#define GRID_BAR() do { if (N_LAUNCHES == 1) xcd_barrier(bar); } while (0)
    F.vc = (int)blockIdx.x;
    if (N_LAUNCHES == 1 && F.G == 256) {
        if (F.tid == 0) { const unsigned x = xb_xcc_id(); const unsigned r = __hip_atomic_fetch_add(F.ctl + CW_XRANK + 64 * x, 1u, RLX_AGENT); F.MISC[20] = (x < 8u && r < 32u) ? x + 8u * r : 0xffffffffu; }
        __syncthreads();
        const unsigned v = (unsigned)__builtin_amdgcn_readfirstlane((int)F.MISC[20]); if (v != 0xffffffffu) F.vc = (int)v;
    }

    const int lo = args.ph_lo, hi = args.ph_hi;
#ifndef DUP_MASK
#define DUP_MASK 0
#endif
#define REP(k) for (int rep_ = 0; rep_ < (((DUP_MASK >> (k)) & 1) ? 2 : 1); ++rep_)
#ifndef PHASE_MASK
#define PHASE_MASK 0x7ff
#endif
#define IN(k) (((PHASE_MASK >> (k)) & 1) && lo <= (k) && (k) < hi)
#define BOTH(k) (IN(k) && IN((k) + 1))
    typedef pg8::StaticOrder SO;
    if (IN(0)) { REP(0) p0_prologue(F, args); if (BOTH(0)) GRID_BAR(); }
    if (IN(1)) { pg8::Gemm g = pg8::gemm_rowmajor(P_A, P_Win_t, MPAD, NIN, DM); SO S; S.init(MPAD, NIN, F.G, F.vc);
        pg8::EpiBf16S<false> E{P_PROJ, NIN, nullptr};
        pg8::gemm_phase<pg8::EpiBf16S<false>, SO, true, true>(F.lds + RING_OFF, g, S, E);
        { const int nbusy = S.nwg % F.G;
          if (nbusy != 0 && F.vc >= nbusy) tr_run(args, TR_END_P0 + (F.vc - nbusy) * NWAVES + F.wave, TR_END_G1, (F.G - nbusy) * NWAVES, F.lane, (LAS float*)(F.lds + RING_OFF + F.wave * TR_SCR_BYTES));
          else if (nbusy == 0) tr_run(args, TR_END_P0 + F.vc * NWAVES + F.wave, TR_END_G1, F.G * NWAVES, F.lane, (LAS float*)(F.lds + RING_OFF + F.wave * TR_SCR_BYTES)); }
        if (BOTH(1)) GRID_BAR(); }
    if (IN(2)) {
        if (blockIdx.x & 1) {
            for (int u = blockIdx.x; u < 512; u += F.G) attn_sample_unit(F, args, u);
            for (int u = blockIdx.x; u < 512; u += F.G) ret_kv_unit(F, args, u);
            for (int u = blockIdx.x; u < 256; u += F.G) attn_prompt_unit(F, args, u);
        } else {
            for (int u = blockIdx.x; u < 256; u += F.G) attn_prompt_unit(F, args, u);
            for (int u = blockIdx.x; u < 512; u += F.G) ret_kv_unit(F, args, u);
            for (int u = blockIdx.x; u < 512; u += F.G) attn_sample_unit(F, args, u);
        }
        __syncthreads();
        if (BOTH(2)) GRID_BAR(); }
    if (IN(3)) { sret_finalize(F, args); REP(3) ret_scan(F, args); if (BOTH(3)) GRID_BAR(); }
#ifndef P4_DUP
#define P4_DUP 1
#endif
    if (IN(4)) { for (int u = blockIdx.x; u < 512 * P4_DUP; u += F.G) ret_out_unit(F, args, u & 511); __syncthreads(); if (BOTH(4)) GRID_BAR(); }
    if (IN(5)) { pg8::Gemm g = pg8::gemm_rowmajor(P_MIX, P_Wout_t, MPROMPT, DM, DM); SO S; S.init(MPROMPT, DM, F.G, F.vc);
        pg8::EpiResid<false, false> E{args.in[I_XP], args.in[I_XS], nullptr, P_A, P_SS1};
        pg8::gemm_phase<pg8::EpiResid<false, false>, SO, true, true>(F.lds + RING_OFF, g, S, E);
        for (int sv = blockIdx.x; sv < DM / 16; sv += F.G) { const f32x4 acc = sliver_gemm_64x32(F.lds, P_MIXS, P_Wout_t, DM, sv & 1, 32 * (sv >> 1), F.lane, F.wave);
            sliver_resid<false, false>(acc, SLV_ROW(sv), SLV_COL(sv), args.in[I_XS], nullptr, P_A + (size_t)MPROMPT * DM, P_SS1 + MPROMPT, nullptr); }
        if (BOTH(5)) GRID_BAR(); }
    if (IN(6)) { pg8::Gemm g = pg8::gemm_rowmajor(P_A, P_Wup_t, MPAD, NUP, DM); SO S; S.init(MPAD, NUP, F.G, F.vc);
        pg8::EpiBf16S<true> E{P_U, NUP, P_SS1};
        pg8::gemm_phase<pg8::EpiBf16S<true>, SO, true, true>(F.lds + RING_OFF, g, S, E);
        { const int nbusy = S.nwg % F.G;
          if (nbusy != 0 && F.vc >= nbusy) tr_run(args, TR_END_G1 + (F.vc - nbusy) * NWAVES + F.wave, TR_END_G3, (F.G - nbusy) * NWAVES, F.lane, (LAS float*)(F.lds + RING_OFF + F.wave * TR_SCR_BYTES));
          else if (nbusy == 0) tr_run(args, TR_END_G1 + F.vc * NWAVES + F.wave, TR_END_G3, F.G * NWAVES, F.lane, (LAS float*)(F.lds + RING_OFF + F.wave * TR_SCR_BYTES)); }
        if (BOTH(6)) GRID_BAR(); }
    if (IN(7)) { REP(7) conv_gate_pass(F, args); if (BOTH(7)) GRID_BAR(); }
    if (IN(8)) { pg8::Gemm g = pg8::gemm_rowmajor(P_ACT, P_Wdown_t, MPROMPT, DM, DFF); SO S; S.init(MPROMPT, DM, F.G, F.vc);
        pg8::EpiResid<true, false> E{nullptr, nullptr, nullptr, P_A, P_SS2};
        pg8::gemm_phase<pg8::EpiResid<true, false>, SO, true, true>(F.lds + RING_OFF, g, S, E);
        for (int sv = blockIdx.x; sv < DM / 16; sv += F.G) { const f32x4 acc = sliver_gemm_64x32(F.lds, P_ACTS, P_Wdown_t, DFF, sv & 1, 32 * (sv >> 1), F.lane, F.wave);
            sliver_resid<true, false>(acc, SLV_ROW(sv), SLV_COL(sv), nullptr, nullptr, P_A + (size_t)MPROMPT * DM, P_SS2 + MPROMPT, P_X2BS); }
        __syncthreads(); }
    if (IN(9)) { int kple = PLED; asm volatile("" : "+s"(kple));
        pg8::Gemm g = pg8::gemm_rowmajor(P_PB, P_Wproj_t, MPROMPT, DM, kple); SO S; S.init(MPROMPT, DM, F.G, F.vc);
        pg8::EpiBf16S<false> E{P_PLEB, DM, nullptr};
        pg8::gemm_phase<pg8::EpiBf16S<false>, SO, true, true>(F.lds + RING_OFF, g, S, E);
        for (int sv = blockIdx.x; sv < DM / 16; sv += F.G) { const f32x4 acc = sliver_gemm_64x32(F.lds, P_PBS, P_Wproj_t, kple, sv & 1, 32 * (sv >> 1), F.lane, F.wave);
            u32x2 w; w.x = cvtpk(acc[0], acc[1]); w.y = cvtpk(acc[2], acc[3]);
            *(GAS u32x2*)(P_PLEB + (size_t)(MPROMPT + SLV_ROW(sv)) * DM + SLV_COL(sv)) = w; }
        if (BOTH(9)) GRID_BAR(); }
    if (IN(10)) { pg8::Gemm g = pg8::gemm_rowmajor(P_A, P_Wgate_t, MPROMPT, DM, DM); SO S; S.init(MPROMPT, DM, F.G, F.vc);
        pg8::EpiPle E{args.out, P_A, P_PLEB, P_SS2};
        pg8::gemm_phase<pg8::EpiPle, SO, true, true>(F.lds + RING_OFF, g, S, E);
        for (int sv = blockIdx.x; sv < (DM / 16); sv += F.G) { const f32x4 acc = sliver_gemm_64x32(F.lds, P_X2BS, P_Wgate_t, DM, sv & 1, 32 * (sv >> 1), F.lane, F.wave);
            const int row = MPROMPT + SLV_ROW(sv), c = SLV_COL(sv); const size_t off = (size_t)row * DM + c;
            const float sc = 1.0f / sqrtf(P_SS2[row] * (1.0f / DM) + EPS);
            const u32x2 xw = *(const GAS u32x2*)(P_A + off); const f32x4 x2 = {bflo(xw.x), bfhi(xw.x), bflo(xw.y), bfhi(xw.y)}; const u32x2 pw = *(const GAS u32x2*)(P_PLEB + off); const float pl[4] = {bflo(pw.x), bfhi(pw.x), bflo(pw.y), bfhi(pw.y)}; f32x4 o;
#pragma unroll
            for (int k = 0; k < 4; ++k) { const float gte = __builtin_amdgcn_rcpf(1.0f + __builtin_amdgcn_exp2f(-1.4426950408889634f * sc * acc[k])); o[k] = x2[k] + gte * pl[k]; }
            *(GAS f32x4*)(args.out + off) = o; }
        }
#undef IN
#undef BOTH
}

extern "C" void kernel_launch(void* const* d_in, const int* in_sizes, int n_in, void* d_out, int out_size, void* d_ws, size_t ws_size, hipStream_t stream) {
    static int grid = 0;
    if (grid == 0) {
        if (n_in != N_INPUTS || (size_t)out_size != O_END || ws_size < WS_END) { fprintf(stderr, "kernel_launch: unexpected shapes: n_in %d out %d ws %zu; nothing launched\n", n_in, out_size, ws_size); grid = -1; return; }
        int dev = 0, cus = 0, per_cu = 0;
        if (hipGetDevice(&dev) != hipSuccess || hipDeviceGetAttribute(&cus, hipDeviceAttributeMultiprocessorCount, dev) != hipSuccess) { grid = -1; return; }
        if (hipFuncSetAttribute((const void*)mk_fwd, hipFuncAttributeMaxDynamicSharedMemorySize, LDS_BYTES) != hipSuccess) { fprintf(stderr, "kernel_launch: hipFuncSetAttribute failed\n"); grid = -1; return; }
        if (hipOccupancyMaxActiveBlocksPerMultiprocessor(&per_cu, (const void*)mk_fwd, NTHR, LDS_BYTES) != hipSuccess || per_cu < 1) { fprintf(stderr, "kernel_launch: occupancy query says %d blocks per CU\n", per_cu); }
        (void)hipGetLastError();
        grid = cus;
    }
    if (grid < 0) return;
    if (hipMemsetAsync((char*)d_ws + WS_CTL, 0, CTL_ZERO_BYTES, stream) != hipSuccess) return;
    Args a{};
    for (int i = 0; i < N_INPUTS; ++i) a.in[i] = (const float*)d_in[i];
    a.out = (float*)d_out; a.ws = (unsigned char*)d_ws;
    if (N_LAUNCHES == 1) { a.ph_lo = 0; a.ph_hi = N_PHASES; hipLaunchKernelGGL(mk_fwd, dim3(grid), dim3(NTHR), LDS_BYTES, stream, a); }
    else { for (int p = 0; p < N_PHASES; ++p) { a.ph_lo = p; a.ph_hi = p + 1; hipLaunchKernelGGL(mk_fwd, dim3(grid), dim3(NTHR), LDS_BYTES, stream, a); } }
}
```

```cpp
#include <hip/hip_runtime.h>
#include <cstdio>
#include <cstdint>
#include <cmath>
namespace pg8 {
#define PG8_LAS __attribute__((address_space(3)))
typedef unsigned short bf16_t;
typedef short bf16x8 __attribute__((ext_vector_type(8)));
typedef float f32x4 __attribute__((ext_vector_type(4)));
typedef unsigned u32x4 __attribute__((ext_vector_type(4)));
constexpr int BM = 256, BK = 64, HALF = 128, HTB = HALF * BK * 2  , STAGE_BYTES = 8 * HTB, NXCD = 8, WGM = 8;

__host__ __device__ __forceinline__ int lds_byte(int r, int c) { const int st = (r >> 4) * 2 + (c >> 5), rr = r & 15, cc = c & 31, ob = rr * 64 + cc * 2; return st * 1024 + (ob ^ (((ob >> 9) & 1) << 5)); }
__host__ __device__ __forceinline__ void stage_rc(int b, int& R, int& C) { const int st = b / 1024, sb = b % 1024, swz = sb ^ (((sb >> 9) & 1) << 5); R = (st >> 1) * 16 + swz / 64; C = (st & 1) * 32 + (swz % 64) / 2; }
__host__ __device__ __forceinline__ int perm32(int rho) { const int n = rho >> 4, i = rho & 15; return 8 * (i >> 2) + 4 * n + (i & 3); }

struct Unit { int pm, pn; };
struct Gemm { const bf16_t* A; const bf16_t* Bt; int M, N, K; long rsA, ksA, rsB, ksB; };
__host__ __device__ __forceinline__ Gemm gemm_rowmajor(const bf16_t* A, const bf16_t* Bt, int M, int N, int K) { return Gemm{A, Bt, M, N, K, (long)K * 2, 128, (long)K * 2, 128}; }
__host__ __device__ __forceinline__ Gemm gemm_tiled(const bf16_t* A, const bf16_t* Bt, int M, int N, int K, int rowsA, int rowsB) { return Gemm{A, Bt, M, N, K, 128, (long)rowsA * 128, 128, (long)rowsB * 128}; }

struct StaticOrder {
    int nM, nN, nwg, G, c;
    __host__ __device__ void init(int M, int N, int G_, int c_) { nM = M / BM; nN = N / BM; nwg = nM * nN; G = G_; c = c_; }
    __host__ __device__ bool next(int i, Unit& u) const {
        const long L = (long)i * G + c; if (L >= nwg) return false;
        int wgid = (int)L; { const int q = nwg / NXCD, r = nwg % NXCD, xcd = wgid % NXCD, off = wgid / NXCD; wgid = (xcd < r ? xcd * (q + 1) : r * (q + 1) + (xcd - r) * q) + off; }
        const int nig = WGM * nN, gid = wgid / nig, fm = gid * WGM, gsz = (nM - fm) < WGM ? (nM - fm) : WGM;
        u.pm = fm + ((wgid % nig) % gsz); u.pn = (wgid % nig) / gsz; return true;
    }
    __device__ __forceinline__ void a_ready(const Unit&) const {}
    __device__ __forceinline__ void done(const Unit&) const {}
};

__device__ __forceinline__ unsigned cvt_pk_bf16(float lo, float hi) { unsigned r; asm volatile("v_cvt_pk_bf16_f32 %0, %1, %2" : "=v"(r) : "v"(lo), "v"(hi)); return r; }
typedef float f32x2 __attribute__((ext_vector_type(2)));
__device__ __forceinline__ f32x2 gelu_pk(f32x2 v) {
    const f32x2 av = __builtin_elementwise_abs(v), d = av * 0.2316418882f + 1.0f;
    f32x2 t; t.x = __builtin_amdgcn_rcpf(d.x); t.y = __builtin_amdgcn_rcpf(d.y);
    f32x2 q = t * 0.5307027145f + (-0.7265760135f); q = q * t + 0.7107068705f; q = q * t + (-0.142248368f); q = q * t + 0.127414796f; q = q * t;
    const f32x2 s = (v * v) * (-0.72134752044f);
    f32x2 e; e.x = __builtin_amdgcn_exp2f(s.x); e.y = __builtin_amdgcn_exp2f(s.y);
    const f32x2 m = v * (q * e), r = v - m;
    f32x2 o; o.x = v.x < 0.f ? m.x : r.x; o.y = v.y < 0.f ? m.y : r.y; return o;
}

template <int ACT  > struct EpiBf16 {
    static constexpr bool PERM = true, AFTER_DRAIN = false; static_assert(ACT == 0 || ACT == 1, "EpiBf16: ACT is 0 (none) or 1 (gelu_pk)");
    bf16_t* O; int ldc; const float* bias; int split_cols; size_t split_stride; float scale0;
    __device__ __forceinline__ void operator()(const f32x4 (&acc)[2][2][4][2], const Unit& u, int wr, int wc, int fr, int fq) const {
        const int row0 = u.pm * BM + wr * 64 + fr; int colt = u.pn * BM; bf16_t* base = O;
        float sc = 1.f; if (split_cols) { const int t = colt / split_cols; base += (size_t)t * split_stride; colt -= t * split_cols; if (t == 0) sc = scale0; }
        const int col0 = colt + wc * 32 + 8 * fq, bcol0 = u.pn * BM + wc * 32 + 8 * fq;
        f32x4 bv[2][2];
#pragma unroll
        for (int bj = 0; bj < 2; ++bj)
#pragma unroll
            for (int n = 0; n < 2; ++n) bv[bj][n] = bias ? *(const f32x4*)(bias + bcol0 + bj * HALF + 4 * n) : (f32x4){0.f, 0.f, 0.f, 0.f};
#pragma unroll
        for (int ai = 0; ai < 2; ++ai)
#pragma unroll
            for (int m = 0; m < 4; ++m) { bf16_t* rowp = base + (size_t)(row0 + ai * HALF + m * 16) * ldc + col0;
#pragma unroll
                for (int bj = 0; bj < 2; ++bj) { f32x4 v0 = acc[ai][bj][m][0] + bv[bj][0], v1 = acc[ai][bj][m][1] + bv[bj][1];
                    if (ACT == 1) { f32x2 a = gelu_pk((f32x2){v0[0], v0[1]}), b = gelu_pk((f32x2){v0[2], v0[3]}), c = gelu_pk((f32x2){v1[0], v1[1]}), d = gelu_pk((f32x2){v1[2], v1[3]});
                        v0 = (f32x4){a.x, a.y, b.x, b.y}; v1 = (f32x4){c.x, c.y, d.x, d.y}; }
                    v0 = v0 * sc; v1 = v1 * sc; u32x4 w; w.x = cvt_pk_bf16(v0[0], v0[1]); w.y = cvt_pk_bf16(v0[2], v0[3]); w.z = cvt_pk_bf16(v1[0], v1[1]); w.w = cvt_pk_bf16(v1[2], v1[3]);
                    *(u32x4*)(rowp + bj * HALF) = w; } }
    }
};

typedef unsigned u32x2 __attribute__((ext_vector_type(2)));
typedef float f32x2b __attribute__((ext_vector_type(2))); typedef __bf16 bf16x2b __attribute__((ext_vector_type(2)));
__device__ __forceinline__ unsigned cvtpk(float lo, float hi) { f32x2b v = {lo, hi}; bf16x2b b = __builtin_convertvector(v, bf16x2b); return __builtin_bit_cast(unsigned, b); }
constexpr int ROWS_REAL = 8320, ROWS_PROMPT = 8192, DMODEL = 4096;
constexpr float RMS_EPS = 1e-6f;

template <bool SCALE> struct EpiBf16S {
    static constexpr bool PERM = true, AFTER_DRAIN = false;
    bf16_t* O; int ldc; const float* ss;
    __device__ __forceinline__ void operator()(const f32x4 (&acc)[2][2][4][2], const Unit& u, int wr, int wc, int fr, int fq) const {
        const int row0 = u.pm * BM + wr * 64 + fr, col0 = u.pn * BM + wc * 32 + 8 * fq;
        float ssr[2][4];
        if (SCALE) {
#pragma unroll
            for (int ai = 0; ai < 2; ++ai)
#pragma unroll
                for (int m = 0; m < 4; ++m) ssr[ai][m] = ss[row0 + ai * HALF + m * 16];
        }
#pragma unroll
        for (int ai = 0; ai < 2; ++ai)
#pragma unroll
            for (int m = 0; m < 4; ++m) { const int row = row0 + ai * HALF + m * 16; bf16_t* rowp = O + (size_t)row * ldc + col0;
                float sc = 1.f; if (SCALE) sc = __builtin_amdgcn_rsqf(ssr[ai][m] * (1.0f / DMODEL) + RMS_EPS);
#pragma unroll
                for (int bj = 0; bj < 2; ++bj) { const f32x4 v0 = acc[ai][bj][m][0] * sc, v1 = acc[ai][bj][m][1] * sc;
                    u32x4 w; w.x = cvtpk(v0[0], v0[1]); w.y = cvtpk(v0[2], v0[3]); w.z = cvtpk(v1[0], v1[1]); w.w = cvtpk(v1[2], v1[3]);
                    *(u32x4*)(rowp + bj * HALF) = w; } }
    }
};
template <bool BASE_BF16, bool OUT_F32> struct EpiResid {
    static constexpr bool PERM = false, AFTER_DRAIN = false;
    const float* base_p; const float* base_s; float* outf; bf16_t* outb; float* ss;
    __device__ __forceinline__ void operator()(const f32x4 (&acc)[2][2][4][2], const Unit& u, int wr, int wc, int fr, int fq) const {
        const int row0 = u.pm * BM + wr * 64 + fr, col0 = u.pn * BM + wc * 32 + 4 * fq;
        f32x4 bf[2][4]; u32x2 bw[2][4];
#pragma unroll
        for (int g = 0; g <= 8; ++g) {
            if (g < 8) { const int ai = g >> 2, m = g & 3, row = row0 + ai * HALF + m * 16;
                {   const float* bp = BASE_BF16 ? nullptr : ((row < ROWS_PROMPT) ? base_p + (size_t)row * DMODEL : base_s + (size_t)(row - ROWS_PROMPT) * DMODEL);
#pragma unroll
                    for (int bj = 0; bj < 2; ++bj)
#pragma unroll
                        for (int n = 0; n < 2; ++n) { const int c = col0 + bj * HALF + n * 16;
                            if (BASE_BF16) bw[g & 1][bj * 2 + n] = *(const u32x2*)(outb + (size_t)row * DMODEL + c); else bf[g & 1][bj * 2 + n] = *(const f32x4*)(bp + c); }
                } }
            if (g > 0) { const int h = g - 1, ai = h >> 2, m = h & 3, row = row0 + ai * HALF + m * 16;
                {   float s = 0.f;
#pragma unroll
                    for (int bj = 0; bj < 2; ++bj)
#pragma unroll
                        for (int n = 0; n < 2; ++n) { const int c = col0 + bj * HALF + n * 16; f32x4 b4;
                            if (BASE_BF16) { const u32x2 w2 = bw[h & 1][bj * 2 + n]; b4 = (f32x4){__uint_as_float(w2.x << 16), __uint_as_float(w2.x & 0xffff0000u), __uint_as_float(w2.y << 16), __uint_as_float(w2.y & 0xffff0000u)}; }
                            else b4 = bf[h & 1][bj * 2 + n];
                            const f32x4 o = b4 + acc[ai][bj][m][n];
                            if (OUT_F32) *(f32x4*)(outf + (size_t)row * DMODEL + c) = o;
                            s += (o[0] * o[0] + o[1] * o[1]) + (o[2] * o[2] + o[3] * o[3]);
                            u32x2 w; w.x = cvtpk(o[0], o[1]); w.y = cvtpk(o[2], o[3]); *(u32x2*)(outb + (size_t)row * DMODEL + c) = w; }
                    s += __shfl_xor(s, 16); s += __shfl_xor(s, 32);
                    if (fq == 0) atomicAdd(ss + row, s);
                }
                asm volatile("" ::: "memory"); }
        }
    }
};
struct EpiPle {
    static constexpr bool PERM = false, AFTER_DRAIN = false;
    float* y; const bf16_t* x2b; const bf16_t* ple; const float* ss;
    __device__ __forceinline__ void operator()(const f32x4 (&acc)[2][2][4][2], const Unit& u, int wr, int wc, int fr, int fq) const {
        const int row0 = u.pm * BM + wr * 64 + fr, col0 = u.pn * BM + wc * 32 + 4 * fq;
        u32x2 xw[2][4], pw[2][4]; float ssr[2];
#pragma unroll
        for (int g = 0; g <= 8; ++g) {
            if (g < 8) { const int ai = g >> 2, m = g & 3, row = row0 + ai * HALF + m * 16;
                {   ssr[g & 1] = ss[row];
#pragma unroll
                    for (int bj = 0; bj < 2; ++bj)
#pragma unroll
                        for (int n = 0; n < 2; ++n) { const size_t off = (size_t)row * DMODEL + col0 + bj * HALF + n * 16; xw[g & 1][bj * 2 + n] = *(const u32x2*)(x2b + off); pw[g & 1][bj * 2 + n] = *(const u32x2*)(ple + off); }
                } }
            if (g > 0) { const int h = g - 1, ai = h >> 2, m = h & 3, row = row0 + ai * HALF + m * 16;
                {   const float sc = __builtin_amdgcn_rsqf(ssr[h & 1] * (1.0f / DMODEL) + RMS_EPS);
#pragma unroll
                    for (int bj = 0; bj < 2; ++bj)
#pragma unroll
                        for (int n = 0; n < 2; ++n) { const size_t off = (size_t)row * DMODEL + col0 + bj * HALF + n * 16;
                            const u32x2 xv = xw[h & 1][bj * 2 + n], pv = pw[h & 1][bj * 2 + n];
                            const f32x4 x2 = {__uint_as_float(xv.x << 16), __uint_as_float(xv.x & 0xffff0000u), __uint_as_float(xv.y << 16), __uint_as_float(xv.y & 0xffff0000u)};
                            const f32x4 pl = {__uint_as_float(pv.x << 16), __uint_as_float(pv.x & 0xffff0000u), __uint_as_float(pv.y << 16), __uint_as_float(pv.y & 0xffff0000u)};
                            const f32x4 z = acc[ai][bj][m][n] * sc; f32x4 o;
#pragma unroll
                            for (int k = 0; k < 4; ++k) { const float gte = __builtin_amdgcn_rcpf(1.0f + __builtin_amdgcn_exp2f(-1.4426950408889634f * z[k])); o[k] = x2[k] + gte * pl[k]; }
                            *(f32x4*)(y + off) = o; }
                }
                asm volatile("" ::: "memory"); }
        }
    }
};

template <class Epi, class Sched, bool ALIGN_EPI = false, bool SP2 = false>
__device__ __forceinline__ void gemm_phase(PG8_LAS unsigned char* lds, const Gemm g, const Sched& S, const Epi& E) {
    const int tid = threadIdx.x, wid = __builtin_amdgcn_readfirstlane(tid >> 6), lane = tid & 63, wr = wid >> 2, wc = wid & 3, fr = lane & 15, fq = lane >> 4;
    const int K = g.K, nt = K / BK;
    unsigned voffA[2], voffB[2];
#pragma unroll
    for (int i = 0; i < 2; ++i) { int R, C; stage_rc(tid * 16 + i * 8192, R, C); const int Rb = Epi::PERM ? ((R & ~31) + perm32(R & 31)) : R;
        voffA[i] = (unsigned)(R * (int)g.rsA + C * 2); voffB[i] = (unsigned)(Rb * (int)g.rsB + C * 2); }
    const size_t kstepA = (size_t)g.ksA, kstepB = (size_t)g.ksB;
    const size_t hstepA = (size_t)HALF * g.rsA, hstepB = (size_t)HALF * g.rsB;
    const size_t tstepA = 2 * hstepA, tstepB = 2 * hstepB;
    const unsigned ldsw = (unsigned)wid * 1024u;
    const int aoff = lds_byte(wr * 64 + fr, fq * 8), boff = lds_byte(wc * 32 + fr, fq * 8);
#define PG8_SA(b, h) (((b) * 2 + (h)) * HTB)
#define PG8_SB(b, h) ((4 + (b) * 2 + (h)) * HTB)
#define PG8_STAGE(bufoff, gbase, voff) do { _Pragma("unroll") for (int _i = 0; _i < 2; ++_i) \
        __builtin_amdgcn_global_load_lds((const unsigned*)((const char*)(gbase) + (voff)[_i]), (PG8_LAS unsigned*)(lds + (bufoff) + ldsw + _i * 8192), 16, 0, 0); } while (0)
#define PG8_LDA(dst, b, h) do { _Pragma("unroll") for (int m = 0; m < 4; ++m) _Pragma("unroll") for (int k = 0; k < 2; ++k) dst[m][k] = *(const PG8_LAS bf16x8*)(lds + PG8_SA(b, h) + aoff + m * 2048 + k * 1024); } while (0)
#define PG8_LDB(dst, b, h) do { _Pragma("unroll") for (int n = 0; n < 2; ++n) _Pragma("unroll") for (int k = 0; k < 2; ++k) dst[n][k] = *(const PG8_LAS bf16x8*)(lds + PG8_SB(b, h) + boff + n * 2048 + k * 1024); } while (0)
#define PG8_MMA(ai, bj, At, Bt) do { __builtin_amdgcn_s_setprio(1); _Pragma("unroll") for (int m = 0; m < 4; ++m) _Pragma("unroll") for (int n = 0; n < 2; ++n) _Pragma("unroll") for (int k = 0; k < 2; ++k) \
        acc[ai][bj][m][n] = __builtin_amdgcn_mfma_f32_16x16x32_bf16(Bt[n][k], At[m][k], acc[ai][bj][m][n], 0, 0, 0); __builtin_amdgcn_s_setprio(0); } while (0)
#define PG8_WAIT_V(n) asm volatile("s_waitcnt vmcnt(" #n ")" ::: "memory")
#define PG8_WAIT_L(n) asm volatile("s_waitcnt lgkmcnt(" #n ")" ::: "memory")
#define PG8_BAR __builtin_amdgcn_s_barrier()
#define PG8_SCHED __builtin_amdgcn_sched_barrier(0)
    Unit cur, nxt; int ui = 0;
    if (!S.next(0, cur)) return;
    f32x4 acc[2][2][4][2];
#pragma unroll
    for (int a = 0; a < 2; ++a)
#pragma unroll
        for (int b = 0; b < 2; ++b)
#pragma unroll
            for (int m = 0; m < 4; ++m)
#pragma unroll
                for (int n = 0; n < 2; ++n) acc[a][b][m][n] = (f32x4){0.f, 0.f, 0.f, 0.f};
    bf16x8 At[4][2], B0[2][2], B1[2][2];
    const char* cA = (const char*)g.A + (size_t)cur.pm * tstepA; const char* cB = (const char*)g.Bt + (size_t)cur.pn * tstepB;
    S.a_ready(cur);
    if constexpr (SP2) {
        PG8_STAGE(PG8_SB(0, 0), cB, voffB); PG8_STAGE(PG8_SB(0, 1), cB + hstepB, voffB); PG8_STAGE(PG8_SA(0, 0), cA, voffA); PG8_STAGE(PG8_SA(0, 1), cA + hstepA, voffA);
        if (wr == 1) PG8_BAR;
        PG8_WAIT_V(2); PG8_BAR;
        PG8_STAGE(PG8_SB(1, 0), cB + kstepB, voffB); PG8_STAGE(PG8_SA(1, 0), cA + kstepA, voffA); PG8_STAGE(PG8_SB(1, 1), cB + hstepB + kstepB, voffB);
        PG8_WAIT_V(6); PG8_BAR;
    } else {
        PG8_STAGE(PG8_SB(0, 0), cB, voffB); PG8_STAGE(PG8_SA(0, 0), cA, voffA); PG8_STAGE(PG8_SB(0, 1), cB + hstepB, voffB); PG8_STAGE(PG8_SA(0, 1), cA + hstepA, voffA);
        if (wr == 1) PG8_BAR;
        PG8_WAIT_V(4); PG8_BAR;
        PG8_STAGE(PG8_SB(1, 0), cB + kstepB, voffB); PG8_STAGE(PG8_SA(1, 0), cA + kstepA, voffA); PG8_STAGE(PG8_SB(1, 1), cB + hstepB + kstepB, voffB);
        PG8_WAIT_V(6); PG8_BAR;
    }
    for (;;) {
        const bool has_next = S.next(ui + 1, nxt);
        const char* nA = has_next ? (const char*)g.A + (size_t)nxt.pm * tstepA : cA; const char* nB = has_next ? (const char*)g.Bt + (size_t)nxt.pn * tstepB : cB;
        for (int t = 0; t < nt; t += 2) {
            const bool last = (t == nt - 2);
            const char* a1 = cA + (size_t)(t + 1) * kstepA;
            const char* a2 = last ? nA : cA + (size_t)(t + 2) * kstepA; const char* b2 = last ? nB : cB + (size_t)(t + 2) * kstepB;
            const char* a3 = a2 + kstepA; const char* b3 = b2 + kstepB;
            if (last && has_next) S.a_ready(nxt);
            if constexpr (SP2) {
            PG8_LDB(B0, 0, 0); PG8_LDB(B1, 0, 1); PG8_SCHED; PG8_LDA(At, 0, 0); PG8_STAGE(PG8_SA(1, 1), a1 + hstepA, voffA);
            PG8_WAIT_V(8); PG8_WAIT_L(0); PG8_BAR; PG8_MMA(0, 0, At, B0); PG8_MMA(0, 1, At, B1); PG8_BAR; PG8_SCHED;
            PG8_LDA(At, 0, 1); PG8_STAGE(PG8_SB(0, 0), b2, voffB); PG8_STAGE(PG8_SB(0, 1), b2 + hstepB, voffB); PG8_STAGE(PG8_SA(0, 0), a2, voffA);
            PG8_WAIT_V(8); PG8_WAIT_L(0); PG8_BAR; PG8_MMA(1, 0, At, B0); PG8_MMA(1, 1, At, B1); PG8_BAR; PG8_SCHED;
            PG8_LDB(B0, 1, 0); PG8_LDB(B1, 1, 1); PG8_SCHED; PG8_LDA(At, 1, 0); PG8_STAGE(PG8_SA(0, 1), a2 + hstepA, voffA);
            PG8_WAIT_V(8); PG8_WAIT_L(0); PG8_BAR; PG8_MMA(0, 0, At, B0); PG8_MMA(0, 1, At, B1); PG8_BAR; PG8_SCHED;
            PG8_LDA(At, 1, 1); PG8_STAGE(PG8_SB(1, 0), b3, voffB); PG8_STAGE(PG8_SB(1, 1), b3 + hstepB, voffB); PG8_STAGE(PG8_SA(1, 0), a3, voffA);
            PG8_WAIT_V(8); PG8_WAIT_L(0); PG8_BAR; PG8_MMA(1, 0, At, B0); PG8_MMA(1, 1, At, B1); PG8_BAR; PG8_SCHED;
            } else {
            PG8_LDB(B0, 0, 0); PG8_SCHED; PG8_LDA(At, 0, 0); PG8_STAGE(PG8_SA(1, 1), a1 + hstepA, voffA);
            PG8_WAIT_L(8); PG8_BAR; PG8_WAIT_L(0); PG8_MMA(0, 0, At, B0); PG8_BAR; PG8_SCHED;
            PG8_LDB(B1, 0, 1); PG8_STAGE(PG8_SB(0, 0), b2, voffB);
            PG8_BAR; PG8_WAIT_L(0); PG8_MMA(0, 1, At, B1); PG8_BAR;
            PG8_LDA(At, 0, 1); PG8_STAGE(PG8_SA(0, 0), a2, voffA);
            PG8_BAR; PG8_WAIT_L(0); PG8_MMA(1, 0, At, B0); PG8_BAR; PG8_SCHED;
            PG8_STAGE(PG8_SB(0, 1), b2 + hstepB, voffB);
            PG8_WAIT_V(6); PG8_BAR; PG8_MMA(1, 1, At, B1); PG8_BAR;
            PG8_LDB(B0, 1, 0); PG8_SCHED; PG8_LDA(At, 1, 0); PG8_STAGE(PG8_SA(0, 1), a2 + hstepA, voffA);
            PG8_WAIT_L(8); PG8_BAR; PG8_WAIT_L(0); PG8_MMA(0, 0, At, B0); PG8_BAR; PG8_SCHED;
            PG8_LDB(B1, 1, 1); PG8_STAGE(PG8_SB(1, 0), b3, voffB);
            PG8_BAR; PG8_WAIT_L(0); PG8_MMA(0, 1, At, B1); PG8_BAR;
            PG8_LDA(At, 1, 1); PG8_STAGE(PG8_SA(1, 0), a3, voffA);
            PG8_BAR; PG8_WAIT_L(0); PG8_MMA(1, 0, At, B0); PG8_BAR; PG8_SCHED;
            PG8_STAGE(PG8_SB(1, 1), b3 + hstepB, voffB);
            PG8_WAIT_V(6); PG8_BAR; PG8_MMA(1, 1, At, B1); PG8_BAR;
            }
        }
        if constexpr (ALIGN_EPI) { if (wr == 0) PG8_BAR; }
        if constexpr (!Epi::AFTER_DRAIN) { E(acc, cur, wr, wc, fr, fq); S.done(cur); }
        if (!has_next) break;
#pragma unroll
        for (int a = 0; a < 2; ++a)
#pragma unroll
            for (int b = 0; b < 2; ++b)
#pragma unroll
                for (int m = 0; m < 4; ++m)
#pragma unroll
                    for (int n = 0; n < 2; ++n) acc[a][b][m][n] = (f32x4){0.f, 0.f, 0.f, 0.f};
        cur = nxt; cA = nA; cB = nB; ++ui;
        if constexpr (ALIGN_EPI) { if (wr == 1) PG8_BAR; }
    }
    PG8_WAIT_V(0);
    if constexpr (!ALIGN_EPI) { if (wr == 0) PG8_BAR; }
    PG8_BAR;
    if constexpr (Epi::AFTER_DRAIN) { E.fused(acc, cur, wr, wc, fr, fq, lds, wid, lane); S.done(cur); }
#undef PG8_SA
#undef PG8_SB
#undef PG8_STAGE
#undef PG8_LDA
#undef PG8_LDB
#undef PG8_MMA
#undef PG8_WAIT_V
#undef PG8_WAIT_L
#undef PG8_BAR
#undef PG8_SCHED
}
}
#define GAS __attribute__((address_space(1)))
#define LAS __attribute__((address_space(3)))
typedef unsigned short bf16;
typedef unsigned v4u __attribute__((ext_vector_type(4)));
typedef float f32x4 __attribute__((ext_vector_type(4)));
typedef short bf16x8 __attribute__((ext_vector_type(8)));
typedef GAS unsigned gu32;
typedef GAS unsigned long long gu64;
#define RLX_AGENT __ATOMIC_RELAXED, __HIP_MEMORY_SCOPE_AGENT
#define LDS_WAIT() asm volatile("s_waitcnt lgkmcnt(0)" ::: "memory")
#define VM_WAIT() asm volatile("s_waitcnt vmcnt(0)" ::: "memory")
__device__ __forceinline__ unsigned long long rt() { return __builtin_amdgcn_s_memrealtime(); }
__device__ __forceinline__ unsigned f2bf(float f) { unsigned u = __builtin_bit_cast(unsigned, f); return (u + 0x7fffu + ((u >> 16) & 1u)) >> 16; }
__device__ __forceinline__ unsigned pk2(float lo, float hi) { return f2bf(lo) | (f2bf(hi) << 16); }
#define XB_TMO      128
#define XB_XCNT(j)  (256  + 64 * (j))
#define XB_XSUB(j)  (1280 + 64 * (j))
#define XB_XGEN(j)  (2304 + 64 * (j))
#define XB_TOP      3328
#define XB_TOPGEN   3392
#define XCD_BAR_WORDS 3456
#define XB_SPIN_CAP (1u << 18)

__device__ __forceinline__ unsigned xb_ld(unsigned* p)              { return __hip_atomic_load(p, __ATOMIC_RELAXED, __HIP_MEMORY_SCOPE_AGENT); }
__device__ __forceinline__ unsigned xb_add(unsigned* p, unsigned v) { return __hip_atomic_fetch_add(p, v, __ATOMIC_RELAXED, __HIP_MEMORY_SCOPE_AGENT); }
__device__ __forceinline__ unsigned xb_xcc_id() { return (unsigned)__builtin_amdgcn_s_getreg((3 << 11) | 20) & 0xFu; }
#define XB_SPIN(cond, bar) do { unsigned _sp = 0; while (cond) { __builtin_amdgcn_s_sleep(1); \
    if ((++_sp & 255u) == 0u) { if (xb_ld(&(bar)[XB_TMO])) break; if (_sp > XB_SPIN_CAP) { atomicAdd(&(bar)[XB_TMO], 1u); break; } } } } while (0)

struct XcdBarrier {
    unsigned* bar; unsigned x;
    volatile LAS unsigned* st;
};

__device__ __forceinline__ XcdBarrier xcd_barrier_post(unsigned* bar, volatile LAS unsigned* st) {
    XcdBarrier b; b.bar = bar; b.x = xb_xcc_id(); b.st = st;
    if (threadIdx.x == 0) (void)xb_add(&bar[XB_XCNT(b.x)], 1u);
    return b;
}
__device__ __forceinline__ void xcd_barrier_complete(unsigned* bar, unsigned x, unsigned& nloc, unsigned& nx) {
    const unsigned G = gridDim.x * gridDim.y * gridDim.z;
    unsigned sum, cnt, mine, sp = 0u;
    for (;;) {
        sum = 0u; cnt = 0u; mine = 0u;
#pragma unroll
        for (unsigned j = 0; j < 16; ++j) { const unsigned c = xb_ld(&bar[XB_XCNT(j)]); sum += c; cnt += (c > 0u) ? 1u : 0u; mine = (j == x) ? c : mine; }
        if (sum == G) break;
        __builtin_amdgcn_s_sleep(1);
        if ((++sp & 255u) == 0u) { if (xb_ld(&bar[XB_TMO])) break; if (sp > XB_SPIN_CAP) { atomicAdd(&bar[XB_TMO], 1u); break; } }
    }
    nloc = mine > 0u ? mine : 1u; nx = cnt > 0u ? cnt : 1u;
}

__device__ __forceinline__ void xcd_barrier(const XcdBarrier& b) {
    asm volatile("s_waitcnt vmcnt(0)" ::: "memory");
    __syncthreads();
    if (threadIdx.x == 0) {
        unsigned* bar = b.bar;
        __builtin_amdgcn_s_waitcnt(0);
        unsigned nloc = b.st[0], nx = b.st[1];
        if (nloc == 0u) { xcd_barrier_complete(bar, b.x, nloc, nx); b.st[0] = nloc; b.st[1] = nx; }
        const unsigned old = xb_add(&bar[XB_XSUB(b.x)], 1u);
        const unsigned gen = old / nloc;
        if (old + 1u == (gen + 1u) * nloc) {
            __builtin_amdgcn_fence(__ATOMIC_RELEASE, "agent");
            asm volatile("s_waitcnt vmcnt(0)" ::: "memory");
            const unsigned og = xb_add(&bar[XB_TOP], 1u);
            const unsigned tg = og / nx;
            if (og + 1u == (tg + 1u) * nx) xb_add(&bar[XB_TOPGEN], 1u);
            else XB_SPIN(xb_ld(&bar[XB_TOPGEN]) == tg, bar);
            __builtin_amdgcn_fence(__ATOMIC_ACQUIRE, "agent");
            xb_add(&bar[XB_XGEN(b.x)], 1u);
            asm volatile("s_waitcnt vmcnt(0)" ::: "memory");
        } else {
            XB_SPIN(xb_ld(&bar[XB_XGEN(b.x)]) == gen, bar);
            __builtin_amdgcn_fence(__ATOMIC_ACQUIRE, "agent");
            asm volatile("s_waitcnt vmcnt(0)" ::: "memory");
        }
    }
    __syncthreads();
}

#ifndef MK_N_LAUNCHES
#define MK_N_LAUNCHES 1
#endif
constexpr int N_LAUNCHES = MK_N_LAUNCHES;
constexpr int N_PHASES = 11;
constexpr int NWAVES = 8, NTHR = 512;
constexpr int DM = 4096, SEQ = 4096, NBATCH = 2, MPROMPT = 8192, MSAMPLE = 128, MREAL = 8320, MPAD = 8448;
constexpr int NIN = 8704, DFF = 11008, NUP = 22016, PLED = 256;
constexpr int C_AQ = 0, C_AK = 2048, C_AV = 2304, C_RQ = 2560, C_RK = 3584, C_RV = 4608, C_RG = 6656;
constexpr int NCHUNK = 32;
constexpr int PAST = 8192;
constexpr float EPS = 1e-6f;
enum { I_XP = 0, I_XS, I_PP, I_PS, I_CK, I_CV, I_SR, I_SC, I_RB, I_GMIX, I_WIN, I_GQ, I_GK, I_SINK, I_WOUT, I_GFFN, I_WUP, I_CW, I_CB, I_WDOWN, I_GPLE, I_WGATE, I_WPROJ, N_INPUTS };
constexpr size_t O_YP = 0, O_YS = 33554432, O_WKP = 34078720, O_WVP = 34144256, O_RP = 34209792, O_CP = 34734080, O_WKS = 34822144, O_WVS = 39016448, O_RS = 43210752, O_CS = 76765184, O_END = 82401280;
constexpr size_t MiB = 1u << 20;
constexpr size_t WS_CTL = 0, CTL_ZERO_BYTES = 1 * MiB;
constexpr size_t WS_ROT = 1 * MiB, WS_WIN = 4 * MiB, WS_WOUT = 72 * MiB, WS_WUP = 104 * MiB, WS_WDOWN = 276 * MiB, WS_WGATE = 362 * MiB, WS_WPROJ = 394 * MiB;
constexpr size_t WS_A = 396 * MiB, WS_X1 = 462 * MiB, WS_PB = 594 * MiB, WS_PLE = 599 * MiB, WS_ACT = 665 * MiB, WS_U = 843 * MiB;
constexpr size_t WS_PROJ = 843 * MiB, WS_MIX = 984 * MiB, WS_KVT = 1050 * MiB, WS_ST = 1114 * MiB, WS_END = 1198 * MiB;
static_assert(WS_WIN + (size_t)NIN * DM * 2 <= WS_WOUT && WS_WUP + (size_t)NUP * DM * 2 <= WS_WDOWN && WS_WDOWN + (size_t)DM * DFF * 2 <= WS_WGATE, "ws map (weights)");
static_assert(WS_A + (size_t)MPAD * DM * 2 <= WS_X1 && WS_X1 + (size_t)MPAD * DM * 4 <= WS_PB && WS_PB + (size_t)MPAD * PLED * 2 <= WS_PLE && WS_PLE + (size_t)MPAD * DM * 2 <= WS_ACT, "ws map (act)");
static_assert(WS_ACT + (size_t)MPAD * DFF * 2 <= WS_U && WS_U + (size_t)MPAD * NUP * 2 <= WS_END, "ws map (u)");
static_assert(WS_PROJ + (size_t)MPAD * NIN * 2 <= WS_MIX && WS_MIX + (size_t)MPAD * DM * 2 <= WS_KVT && WS_KVT + (size_t)16 * NCHUNK * 32768 * 4 <= WS_ST && WS_ST + (size_t)16 * NCHUNK * 32768 * 2 <= WS_END, "ws map (overlay)");
static_assert(WS_ROT + (size_t)4097 * 64 * 8 <= WS_WIN, "ws map (rot)");
constexpr int CW_TMO = 0, CW_CODE = 1, CW_BAR = 4096, CW_SS1 = 65536, CW_SS2 = 65536 + 16384, CW_XRANK = 200000;
static_assert((CW_SS2 + MPAD) * 4 <= (int)CTL_ZERO_BYTES && (CW_XRANK + 16 * 64) * 4 <= (int)CTL_ZERO_BYTES && CW_XRANK >= CW_SS2 + MPAD, "ctl");
constexpr int RING_OFF = 0, RING_BYTES = 131072, LDS_BYTES = 147456, LDSCTL_OFF = LDS_BYTES - 1024, MISC_OFF = LDSCTL_OFF + 320;
static_assert(8 * 64 * 65 * 4 <= LDSCTL_OFF, "transpose scratch");

#define DEVI __device__ __forceinline__
typedef unsigned u32x2 __attribute__((ext_vector_type(2)));
typedef float f2v __attribute__((ext_vector_type(2)));

DEVI size_t tiled_off(int row, int k) { return ((size_t)(k >> 5) * 128 + row) * 32 + (k & 31); }
DEVI float bflo(unsigned w) { return __uint_as_float(w << 16); }
DEVI float bfhi(unsigned w) { return __uint_as_float(w & 0xffff0000u); }
DEVI float bf1(unsigned short b) { return __uint_as_float((unsigned)b << 16); }
DEVI void unpack8(const v4u r, float (&f)[8]) { f[0] = bflo(r.x); f[1] = bfhi(r.x); f[2] = bflo(r.y); f[3] = bfhi(r.y); f[4] = bflo(r.z); f[5] = bfhi(r.z); f[6] = bflo(r.w); f[7] = bfhi(r.w); }
DEVI unsigned cvtpk(float lo, float hi) { return pg8::cvtpk(lo, hi); }
DEVI v4u pack8(const float (&f)[8]) { v4u w; w.x = cvtpk(f[0], f[1]); w.y = cvtpk(f[2], f[3]); w.z = cvtpk(f[4], f[5]); w.w = cvtpk(f[6], f[7]); return w; }
DEVI float wave_sum(float v) {
#pragma unroll
    for (int o = 1; o < 64; o <<= 1) v += __shfl_xor(v, o);
    return v;
}
DEVI float wave_max(float v) {
#pragma unroll
    for (int o = 1; o < 64; o <<= 1) v = fmaxf(v, __shfl_xor(v, o));
    return v;
}
#define MFMA16(a, b, c) __builtin_amdgcn_mfma_f32_16x16x32_bf16((a), (b), (c), 0, 0, 0)

struct Args { const float* in[N_INPUTS]; float* out; unsigned char* ws; int ph_lo, ph_hi; };
#define P_Win_t ((bf16*)(args.ws + WS_WIN))
#define P_Wout_t ((bf16*)(args.ws + WS_WOUT))
#define P_Wup_t ((bf16*)(args.ws + WS_WUP))
#define P_Wdown_t ((bf16*)(args.ws + WS_WDOWN))
#define P_Wgate_t ((bf16*)(args.ws + WS_WGATE))
#define P_Wproj_t ((bf16*)(args.ws + WS_WPROJ))
#define P_A ((bf16*)(args.ws + WS_A))
#define P_PB ((bf16*)(args.ws + WS_PB))
#define P_PLEB ((bf16*)(args.ws + WS_PLE))
#define P_ACT ((bf16*)(args.ws + WS_ACT))
#define P_U ((bf16*)(args.ws + WS_U))
#define P_PROJ ((bf16*)(args.ws + WS_PROJ))
#define P_MIX ((bf16*)(args.ws + WS_MIX))
#define P_ST ((bf16*)(args.ws + WS_ST))
#define P_X1 ((float*)(args.ws + WS_X1))
#define P_KVT ((bf16*)(args.ws + WS_KVT))
#define P_ROT ((f2v*)(args.ws + WS_ROT))
#define P_OACC ((float*)(args.ws + WS_X1))
#define P_MIXS ((bf16*)(args.ws + WS_X1 + 2 * MiB))
#define P_X2BS ((bf16*)(args.ws + WS_X1 + 4 * MiB))
#define P_ACTS ((bf16*)(args.ws + WS_X1 + 8 * MiB))
#define P_PBS  ((bf16*)(args.ws + WS_X1 + 12 * MiB))
#define P_SS1 ((float*)(args.ws + WS_CTL) + CW_SS1)
#define P_SS2 ((float*)(args.ws + WS_CTL) + CW_SS2)
struct Frame {
    LAS unsigned char* lds;
    volatile LAS unsigned* MISC;
    gu32* ctl;
    int tid, lane, wave, G, vc;
};

struct TrItem { const float* W; const float* ks; bf16* WT; int K, N, r; };
constexpr int IT_IN = (DM / 64) * (NIN / 64), IT_OUT = (DM / 64) * (DM / 64), IT_UP = (DM / 64) * (NUP / 64), IT_DOWN = (DFF / 64) * (DM / 64), IT_GATE = IT_OUT, IT_PROJ = (PLED / 64) * (DM / 64);
constexpr int TR_UP_IN_P0 = 5000;
constexpr int TR_END_P0 = IT_IN + TR_UP_IN_P0, TR_END_G1 = IT_IN + IT_UP + IT_OUT + IT_PROJ, TR_END_G3 = TR_END_G1 + IT_DOWN + IT_GATE;
DEVI TrItem tr_decode(const Args& args, int it) {
    TrItem t; int r = it;
    if (r < IT_IN) { t.W = args.in[I_WIN]; t.ks = nullptr; t.WT = P_Win_t; t.K = DM; t.N = NIN; t.r = r; return t; } r -= IT_IN;
    if (r < IT_UP) { t.W = args.in[I_WUP]; t.ks = args.in[I_GFFN]; t.WT = P_Wup_t; t.K = DM; t.N = NUP; t.r = r; return t; } r -= IT_UP;
    if (r < IT_OUT) { t.W = args.in[I_WOUT]; t.ks = nullptr; t.WT = P_Wout_t; t.K = DM; t.N = DM; t.r = r; return t; } r -= IT_OUT;
    if (r < IT_PROJ) { t.W = args.in[I_WPROJ]; t.ks = nullptr; t.WT = P_Wproj_t; t.K = PLED; t.N = DM; t.r = r; return t; } r -= IT_PROJ;
    if (r < IT_DOWN) { t.W = args.in[I_WDOWN]; t.ks = nullptr; t.WT = P_Wdown_t; t.K = DFF; t.N = DM; t.r = r; return t; } r -= IT_DOWN;
    t.W = args.in[I_WGATE]; t.ks = args.in[I_GPLE]; t.WT = P_Wgate_t; t.K = DM; t.N = DM; t.r = r; return t;
}
constexpr int TR_NITEMS = (DM / 64) * (NIN / 64) + 2 * (DM / 64) * (DM / 64) + (DM / 64) * (NUP / 64) + (DFF / 64) * (DM / 64) + (PLED / 64) * (DM / 64);
constexpr int TR_SCR_BYTES = 64 * 65 * 4;
struct TrRegs { f32x4 v[16]; f32x4 k0, k1; };
DEVI void tr_load(const TrItem& t, int lane, TrRegs& R) {
    const int nblk = t.N / 64, kb = t.r / nblk, nb = t.r - kb * nblk; const float* src = t.W + (size_t)(64 * kb + (lane >> 4)) * t.N + 64 * nb + (lane & 15) * 4;
#pragma unroll
    for (int i = 0; i < 16; ++i) R.v[i] = __builtin_nontemporal_load((const GAS f32x4*)(src + (size_t)(4 * i) * t.N));
    if (t.ks) { const float* kp = t.ks + 64 * kb + 8 * (lane & 7); R.k0 = *(const GAS f32x4*)kp; R.k1 = *(const GAS f32x4*)(kp + 4); }
    else { R.k0 = (f32x4){1.f, 1.f, 1.f, 1.f}; R.k1 = R.k0; }
}
DEVI void tr_store(const TrItem& t, int lane, const TrRegs& R, LAS float* scr) {
    const int nblk = t.N / 64, kb = t.r / nblk, nb = t.r - kb * nblk, k0 = 64 * kb, n0 = 64 * nb;
#pragma unroll
    for (int i = 0; i < 16; ++i) { LAS float* d = scr + (4 * i + (lane >> 4)) * 65 + (lane & 15) * 4; d[0] = R.v[i][0]; d[1] = R.v[i][1]; d[2] = R.v[i][2]; d[3] = R.v[i][3]; }
    LDS_WAIT(); asm volatile("" ::: "memory");
    const int c = lane & 7;
#pragma unroll
    for (int j = 0; j < 8; ++j) { const int n = (lane >> 3) + 8 * j; const LAS float* s = scr + (8 * c) * 65 + n;
        v4u o; o.x = cvtpk(s[0 * 65] * R.k0[0], s[1 * 65] * R.k0[1]); o.y = cvtpk(s[2 * 65] * R.k0[2], s[3 * 65] * R.k0[3]); o.z = cvtpk(s[4 * 65] * R.k1[0], s[5 * 65] * R.k1[1]); o.w = cvtpk(s[6 * 65] * R.k1[2], s[7 * 65] * R.k1[3]);
        *(GAS v4u*)(t.WT + (size_t)(n0 + n) * t.K + k0 + 8 * c) = o; }
    LDS_WAIT(); asm volatile("" ::: "memory");
}
DEVI void tr_run(const Args& args, int it, int last, int stride, int lane, LAS float* scr) {
    if (it >= last) return;
    TrRegs Ra, Rb; TrItem t = tr_decode(args, it); tr_load(t, lane, Ra);
    for (;;) {
        int nx = it + stride; bool more = nx < last; TrItem tn = t;
        if (more) { tn = tr_decode(args, nx); tr_load(tn, lane, Rb); }
        tr_store(t, lane, Ra, scr);
        if (!more) break;
        t = tn; it = nx; nx = it + stride; more = nx < last;
        if (more) { tn = tr_decode(args, nx); tr_load(tn, lane, Ra); }
        tr_store(t, lane, Rb, scr);
        if (!more) break;
        t = tn; it = nx;
    }
}
DEVI void rms_row_to_bf16(const float* xrow, const float* g, bf16* orow, int lane) {
    const GAS f32x4* xr = (const GAS f32x4*)xrow + lane; const GAS f32x4* gr = (const GAS f32x4*)g + lane;
    f32x4 v[16]; float s = 0.f;
#pragma unroll
    for (int j = 0; j < 16; ++j) { v[j] = __builtin_nontemporal_load(xr + 64 * j); s += (v[j].x * v[j].x + v[j].y * v[j].y) + (v[j].z * v[j].z + v[j].w * v[j].w); }
    f32x4 gv_[16];
#pragma unroll
    for (int j = 0; j < 16; ++j) gv_[j] = gr[64 * j];
    const float rstd = 1.0f / sqrtf(wave_sum(s) * (1.0f / DM) + EPS);
    GAS u32x2* o8 = (GAS u32x2*)orow + lane;
#pragma unroll
    for (int j = 0; j < 16; ++j) { const f32x4 gv = gv_[j]; u32x2 w; w.x = cvtpk(v[j].x * rstd * gv.x, v[j].y * rstd * gv.y); w.y = cvtpk(v[j].z * rstd * gv.z, v[j].w * rstd * gv.w); o8[64 * j] = w; }
}
DEVI void p0_prologue(Frame& F, const Args& args) {
    LAS float* scr = (LAS float*)(F.lds + RING_OFF + F.wave * TR_SCR_BYTES);
    const int gw = blockIdx.x * NWAVES + F.wave, NGW = F.G * NWAVES;
    const int gt = blockIdx.x * NTHR + F.tid, NGT = F.G * NTHR;
#ifndef P0X_DUP
#define P0X_DUP 1
#endif
    for (int xr_ = 0; xr_ < P0X_DUP; ++xr_) {
    for (int idx = gt; idx < 4097 * 64; idx += NGT) { const int pi = idx >> 6, i = idx & 63; const float pos = (pi == 4096) ? (float)PAST : (float)pi;
        const float inv = powf(10000.0f, -(float)i * (1.0f / 64.0f)); const float ang = pos * inv; float sn, cs; sincosf(ang, &sn, &cs); P_ROT[idx] = (f2v){cs, sn}; }
    for (int idx = gt; idx < MPAD * 32; idx += NGT) { const int row = idx >> 5, ch = idx & 31; v4u o = {0u, 0u, 0u, 0u};
        if (row < MREAL) { const float* src = (row < MPROMPT) ? args.in[I_PP] + (size_t)row * PLED : args.in[I_PS] + (size_t)(row - MPROMPT) * PLED;
            const f32x4 a = *(const GAS f32x4*)(src + ch * 8), b = *(const GAS f32x4*)(src + ch * 8 + 4); o.x = cvtpk(a.x, a.y); o.y = cvtpk(a.z, a.w); o.z = cvtpk(b.x, b.y); o.w = cvtpk(b.z, b.w); }
        *(GAS v4u*)(P_PB + (size_t)row * PLED + ch * 8) = o; if (row >= MPROMPT && row < MREAL) *(GAS v4u*)(P_PBS + tiled_off(row - MPROMPT, ch * 8)) = o; }
    for (int idx = gt; idx < 1024 * 256 / 4; idx += NGT) *(GAS f32x4*)(P_OACC + (size_t)idx * 4) = (f32x4){0.f, 0.f, 0.f, 0.f};
    for (int idx = gt; idx < (MPAD - MREAL) * (DM / 8); idx += NGT) { const v4u z = {0u, 0u, 0u, 0u}; const size_t off = (size_t)MREAL * DM + (size_t)idx * 8;
        *(GAS v4u*)(P_A + off) = z; *(GAS v4u*)(P_MIX + off) = z; }
    for (int m = gw; m < MREAL; m += NGW) { const float* xr = (m < MPROMPT) ? args.in[I_XP] + (size_t)m * DM : args.in[I_XS] + (size_t)(m - MPROMPT) * DM; rms_row_to_bf16(xr, args.in[I_GMIX], P_A + (size_t)m * DM, F.lane); }
    }
    tr_run(args, gw, TR_END_P0, NGW, F.lane, scr);
}

DEVI int t5_bucket(int n) {
    if (n < 16) return n;
    const float v = logf((float)n * (1.0f / 16.0f)) / 2.0794415416798357f * 16.0f;
    const int l = 16 + (int)v; return l < 31 ? l : 31;
}
DEVI void attn_prompt_unit(Frame& F, const Args& args, int unit) {
    const int qb = unit & 31, kvh = (unit >> 5) & 3, b = unit >> 7;
    LAS bf16* Kh = (LAS bf16*)(F.lds);
    LAS bf16* Vt = (LAS bf16*)(F.lds + 36864);
    LAS float* biasT = (LAS float*)(F.lds + 36864 + 33792);
    const int tid = F.tid, lane = F.lane, g = F.wave, fr = lane & 15, fq = lane >> 4;
    const float* gk = args.in[I_GK]; const float* gq = args.in[I_GQ];
    const int sitem = unit * 8 + g, su = sitem >> 1, hf = sitem & 1, sh = su & 7, sb = su >> 3;
    const float sgamma = 1.0f - exp2f(-5.0f - (float)sh);
    float sq_sel, sk_sel, sqk; f32x4 sv4;
    {   const bf16* pq = P_PROJ + (size_t)(MPROMPT + sb) * NIN + C_RQ + sh * 128; const bf16* pk = P_PROJ + (size_t)(MPROMPT + sb) * NIN + C_RK + sh * 128;
        const float qa = bf1(pq[lane]), qb_ = bf1(pq[lane + 64]), ka = bf1(pk[lane]), kb_ = bf1(pk[lane + 64]); const f2v cs = P_ROT[(size_t)4096 * 64 + lane];
        const float q_lo = qa * cs.x - qb_ * cs.y, q_hi = qb_ * cs.x + qa * cs.y, k_lo = (ka * cs.x - kb_ * cs.y) * 0.08838834764831845f, k_hi = (kb_ * cs.x + ka * cs.y) * 0.08838834764831845f;
        sqk = wave_sum(q_lo * k_lo + q_hi * k_hi); sq_sel = (hf ? q_hi : q_lo) * sgamma; sk_sel = hf ? k_hi : k_lo;
        const u32x2 vw = *(const GAS u32x2*)(P_PROJ + (size_t)(MPROMPT + sb) * NIN + C_RV + sh * 256 + 4 * lane); sv4 = (f32x4){bflo(vw.x), bfhi(vw.x), bflo(vw.y), bfhi(vw.y)}; }
    const size_t soff = (size_t)su * 32768 + (size_t)(64 * hf) * 256 + 4 * lane;
    f32x4 sbuf[8], so4 = {0.f, 0.f, 0.f, 0.f};
#pragma unroll
    for (int i = 0; i < 8; ++i) sbuf[i] = __builtin_nontemporal_load((const GAS f32x4*)(args.in[I_SR] + soff + (size_t)i * 256));
    __syncthreads();
    for (int task = tid; task < 2048; task += NTHR) {
        const int key = task >> 3, ch = task & 7, tok = (qb - 1) * 128 + key;
        v4u kr = {0u, 0u, 0u, 0u}, vr = {0u, 0u, 0u, 0u};
        if (tok >= 0) { const bf16* rp = P_PROJ + (size_t)(b * SEQ + tok) * NIN + kvh * 64 + ch * 8; kr = *(const GAS v4u*)(rp + C_AK); vr = *(const GAS v4u*)(rp + C_AV); }
        float kf[8], vf[8]; unpack8(kr, kf); unpack8(vr, vf);
        float ss = 0.f;
#pragma unroll
        for (int i = 0; i < 8; ++i) ss += kf[i] * kf[i];
        ss += __shfl_xor(ss, 1); ss += __shfl_xor(ss, 2); ss += __shfl_xor(ss, 4);
        const float rstd = 1.0f / sqrtf(ss * (1.0f / 64.0f) + EPS);
#pragma unroll
        for (int i = 0; i < 8; ++i) kf[i] = kf[i] * rstd * gk[ch * 8 + i];
        *(LAS v4u*)(Kh + key * 72 + ch * 8) = pack8(kf);
        const unsigned vw[4] = {vr.x, vr.y, vr.z, vr.w};
#pragma unroll
        for (int i = 0; i < 8; ++i) Vt[(ch * 8 + i) * 264 + key] = (bf16)((i & 1) ? (vw[i >> 1] >> 16) : (vw[i >> 1] & 0xffffu));
        if (qb == 31 && key >= 128) {
            float* ok = args.out + O_WKP + ((size_t)(b * 128 + (key - 128)) * 4 + kvh) * 64 + ch * 8; float* ov = args.out + O_WVP + ((size_t)(b * 128 + (key - 128)) * 4 + kvh) * 64 + ch * 8;
            *(GAS f32x4*)ok = (f32x4){kf[0], kf[1], kf[2], kf[3]}; *(GAS f32x4*)(ok + 4) = (f32x4){kf[4], kf[5], kf[6], kf[7]};
            *(GAS f32x4*)ov = (f32x4){vf[0], vf[1], vf[2], vf[3]}; *(GAS f32x4*)(ov + 4) = (f32x4){vf[4], vf[5], vf[6], vf[7]};
        }
    }
    for (int i = tid; i < 8 * 129; i += NTHR) { const int gg = i / 129, dist = i - gg * 129; biasT[gg * 132 + dist] = args.in[I_RB][t5_bucket(dist) * 32 + kvh * 8 + gg]; }
    __syncthreads();
    const int head = kvh * 8 + g; const float sink = args.in[I_SINK][head];
    float gqv[2][8];
#pragma unroll
    for (int s = 0; s < 2; ++s)
#pragma unroll
        for (int i = 0; i < 8; ++i) gqv[s][i] = gq[32 * s + 8 * fq + i] * 0.125f;
    const bf16* qbase = P_PROJ + ((size_t)b * SEQ + qb * 128 + fr) * NIN + C_AQ + head * 64 + 8 * fq;
    v4u qn0 = *(const GAS v4u*)qbase, qn1 = *(const GAS v4u*)(qbase + 32);
    for (int j = 0; j < 8; ++j) {
        {
#pragma unroll
            for (int i = 0; i < 8; ++i) { const float qd = __builtin_bit_cast(float, __builtin_amdgcn_readlane(__builtin_bit_cast(int, sq_sel), 8 * j + i)), kd = __builtin_bit_cast(float, __builtin_amdgcn_readlane(__builtin_bit_cast(int, sk_sel), 8 * j + i));
                const f32x4 s0 = sbuf[i]; so4 += s0 * qd; const f32x4 s1 = s0 * sgamma + sv4 * kd;
                __builtin_nontemporal_store(s1, (GAS f32x4*)(args.out + O_RS + soff + (size_t)(8 * j + i) * 256)); }
            if (j < 7) {
#pragma unroll
                for (int i = 0; i < 8; ++i) sbuf[i] = __builtin_nontemporal_load((const GAS f32x4*)(args.in[I_SR] + soff + (size_t)(8 * (j + 1) + i) * 256)); }
        }
        const size_t row = (size_t)b * SEQ + qb * 128 + 16 * j + fr;
        float q0[8], q1[8]; unpack8(qn0, q0); unpack8(qn1, q1);
        { const int jn = j < 7 ? j + 1 : 7; qn0 = *(const GAS v4u*)(qbase + (size_t)(16 * jn) * NIN); qn1 = *(const GAS v4u*)(qbase + (size_t)(16 * jn) * NIN + 32); }
        float ss = 0.f;
#pragma unroll
        for (int i = 0; i < 8; ++i) ss += q0[i] * q0[i] + q1[i] * q1[i];
        ss += __shfl_xor(ss, 16); ss += __shfl_xor(ss, 32);
        const float rstd = 1.0f / sqrtf(ss * (1.0f / 64.0f) + EPS);
#pragma unroll
        for (int i = 0; i < 8; ++i) { q0[i] *= rstd * gqv[0][i]; q1[i] *= rstd * gqv[1][i]; }
        bf16x8 qf[2]; qf[0] = __builtin_bit_cast(bf16x8, pack8(q0)); qf[1] = __builtin_bit_cast(bf16x8, pack8(q1));
        const int start = (16 * j < 96) ? 16 * j : 96;
        f32x4 sacc[10];
#pragma unroll
        for (int t = 0; t < 10; ++t) { sacc[t] = (f32x4){0.f, 0.f, 0.f, 0.f};
#pragma unroll
            for (int s = 0; s < 2; ++s) { const bf16x8 kfr = *(const LAS bf16x8*)(Kh + (start + 16 * t + fr) * 72 + 32 * s + 8 * fq); sacc[t] = MFMA16(kfr, qf[s], sacc[t]); } }
        float mx = -INFINITY;
#pragma unroll
        for (int t = 0; t < 10; ++t)
#pragma unroll
            for (int r = 0; r < 4; ++r) { const int key = start + 16 * t + 4 * fq + r, dist = 128 + 16 * j + fr - key; const bool valid = (dist >= 0) && (dist <= 128) && (qb > 0 || key >= 128);
                const int dc = dist < 0 ? 0 : (dist > 128 ? 128 : dist);
                const float sv = valid ? sacc[t][r] + biasT[g * 132 + dc] : -INFINITY; sacc[t][r] = sv; mx = fmaxf(mx, sv); }
        mx = fmaxf(mx, __shfl_xor(mx, 16)); mx = fmaxf(mx, __shfl_xor(mx, 32)); mx = fmaxf(mx, sink);
        float l = 0.f;
#pragma unroll
        for (int t = 0; t < 10; ++t)
#pragma unroll
            for (int r = 0; r < 4; ++r) { const float e = __expf(sacc[t][r] - mx); sacc[t][r] = e; l += e; }
        l += __shfl_xor(l, 16); l += __shfl_xor(l, 32); l += __expf(sink - mx);
        const float rl = 1.0f / l;
        bf16x8 pf[5];
#pragma unroll
        for (int ks = 0; ks < 5; ++ks) { v4u w; w.x = cvtpk(sacc[2 * ks][0] * rl, sacc[2 * ks][1] * rl); w.y = cvtpk(sacc[2 * ks][2] * rl, sacc[2 * ks][3] * rl);
            w.z = cvtpk(sacc[2 * ks + 1][0] * rl, sacc[2 * ks + 1][1] * rl); w.w = cvtpk(sacc[2 * ks + 1][2] * rl, sacc[2 * ks + 1][3] * rl); pf[ks] = __builtin_bit_cast(bf16x8, w); }
        bf16* op = P_MIX + row * DM + head * 64 + 4 * fq;
#pragma unroll
        for (int dt = 0; dt < 4; ++dt) { f32x4 o = (f32x4){0.f, 0.f, 0.f, 0.f};
#pragma unroll
            for (int ks = 0; ks < 5; ++ks) { const LAS bf16* vp = Vt + (16 * dt + fr) * 264 + start + 32 * ks + 4 * fq; const u32x2 a = *(const LAS u32x2*)vp, c = *(const LAS u32x2*)(vp + 16);
                const v4u vv = {a.x, a.y, c.x, c.y}; o = MFMA16(__builtin_bit_cast(bf16x8, vv), pf[ks], o); }
            u32x2 w; w.x = cvtpk(o[0], o[1]); w.y = cvtpk(o[2], o[3]); *(GAS u32x2*)(op + 16 * dt) = w; }
    }
    if (hf == 0) so4 += sv4 * sqk;
    { float* oa = P_OACC + (size_t)su * 256 + 4 * lane; atomicAdd(oa, so4[0]); atomicAdd(oa + 1, so4[1]); atomicAdd(oa + 2, so4[2]); atomicAdd(oa + 3, so4[3]); }
}
DEVI void sret_finalize(Frame& F, const Args& args) {
    const int gw = blockIdx.x * NWAVES + F.wave, NGW = F.G * NWAVES, lane = F.lane;
    for (int su = gw; su < 1024; su += NGW) { const int sh = su & 7, sb = su >> 3;
        const f32x4 o = *(const GAS f32x4*)(P_OACC + (size_t)su * 256 + 4 * lane);
        const float ssq = wave_sum((o[0] * o[0] + o[1] * o[1]) + (o[2] * o[2] + o[3] * o[3])); const float rn = 1.0f / sqrtf(ssq * (1.0f / 256.0f) + EPS);
        const u32x2 gw2 = *(const GAS u32x2*)(P_PROJ + (size_t)(MPROMPT + sb) * NIN + C_RG + sh * 256 + 4 * lane); const float gg[4] = {bflo(gw2.x), bfhi(gw2.x), bflo(gw2.y), bfhi(gw2.y)}; float r4[4];
#pragma unroll
        for (int r = 0; r < 4; ++r) r4[r] = gg[r] / (1.0f + __expf(-gg[r])) * o[r] * rn;
        u32x2 ow; ow.x = cvtpk(r4[0], r4[1]); ow.y = cvtpk(r4[2], r4[3]); *(GAS u32x2*)(P_MIXS + tiled_off(sb, 2048 + sh * 256 + 4 * lane)) = ow; }
}
DEVI void attn_sample_unit(Frame& F, const Args& args, int unit) {
    const int kvh = unit & 3, b = unit >> 2;
    LAS float* Kc = (LAS float*)(F.lds);
    LAS float* Vc = (LAS float*)(F.lds + 33792);
    LAS float* qs = (LAS float*)(F.lds + 33792 + 33280);
    LAS float* pl = qs + 512;
    LAS float* biasT = pl + 8 * 132;
    const int tid = F.tid, lane = F.lane, g = F.wave;
    const size_t prow = (size_t)(MPROMPT + b) * NIN;
    f32x4 ck[4], cv[4];
#pragma unroll
    for (int it = 0; it < 4; ++it) { const int idx = tid + it * NTHR, j = idx >> 4, c4 = idx & 15; const size_t src = ((size_t)(b * 128 + j) * 4 + kvh) * 64 + c4 * 4;
        ck[it] = *(const GAS f32x4*)(args.in[I_CK] + src); cv[it] = *(const GAS f32x4*)(args.in[I_CV] + src); }
    const float qv_raw = bf1(P_PROJ[prow + C_AQ + (kvh * 8 + g) * 64 + lane]), gq_l = args.in[I_GQ][lane];
    const float kv_raw = bf1(P_PROJ[prow + C_AK + kvh * 64 + lane]), gk_l = args.in[I_GK][lane], vv_raw = bf1(P_PROJ[prow + C_AV + kvh * 64 + lane]);
    float rbv[3];
#pragma unroll
    for (int it = 0; it < 3; ++it) { const int i = tid + it * NTHR; const int ii = i < 8 * 129 ? i : 0; const int gg = ii / 129, dist = ii - gg * 129; rbv[it] = args.in[I_RB][t5_bucket(dist) * 32 + kvh * 8 + gg]; }
    __syncthreads();
#pragma unroll
    for (int it = 0; it < 4; ++it) { const int idx = tid + it * NTHR, j = idx >> 4, c4 = idx & 15; const f32x4 kv = ck[it], vv = cv[it];
        Kc[j * 65 + c4 * 4 + 0] = kv.x; Kc[j * 65 + c4 * 4 + 1] = kv.y; Kc[j * 65 + c4 * 4 + 2] = kv.z; Kc[j * 65 + c4 * 4 + 3] = kv.w;
        *(LAS f32x4*)(Vc + j * 64 + c4 * 4) = vv;
        if (j >= 1) { const size_t dst = ((size_t)(b * 128 + (j - 1)) * 4 + kvh) * 64 + c4 * 4; *(GAS f32x4*)(args.out + O_WKS + dst) = kv; *(GAS f32x4*)(args.out + O_WVS + dst) = vv; } }
    {
        const float ss = wave_sum(qv_raw * qv_raw); qs[g * 64 + lane] = qv_raw * (1.0f / sqrtf(ss * (1.0f / 64.0f) + EPS)) * gq_l * 0.125f;
    }
    if (g == 0) { const float ss = wave_sum(kv_raw * kv_raw); const float kn = kv_raw * (1.0f / sqrtf(ss * (1.0f / 64.0f) + EPS)) * gk_l;
        Kc[128 * 65 + lane] = kn; args.out[O_WKS + ((size_t)(b * 128 + 127) * 4 + kvh) * 64 + lane] = kn; }
    if (g == 1) { Vc[128 * 64 + lane] = vv_raw; args.out[O_WVS + ((size_t)(b * 128 + 127) * 4 + kvh) * 64 + lane] = vv_raw; }
#pragma unroll
    for (int it = 0; it < 3; ++it) { const int i = tid + it * NTHR; if (i < 8 * 129) { const int gg = i / 129, dist = i - gg * 129; biasT[gg * 132 + dist] = rbv[it]; } }
    __syncthreads();
    {
        const float sink = args.in[I_SINK][kvh * 8 + g];
        float s0 = 0.f, s1 = 0.f, s2 = 0.f;
        for (int d = 0; d < 64; ++d) { const float q = qs[g * 64 + d]; s0 += q * Kc[lane * 65 + d]; s1 += q * Kc[(lane + 64) * 65 + d]; s2 += q * Kc[128 * 65 + d]; }
        s0 += biasT[g * 132 + (128 - lane)]; s1 += biasT[g * 132 + (64 - lane)]; s2 += biasT[g * 132 + 0];
        float mx = wave_max(fmaxf(s0, s1)); mx = fmaxf(mx, fmaxf(s2, sink));
        const float e0 = __expf(s0 - mx), e1 = __expf(s1 - mx), e2 = __expf(s2 - mx);
        const float l = wave_sum(e0 + e1) + e2 + __expf(sink - mx); const float rl = 1.0f / l;
        pl[g * 132 + lane] = e0 * rl; pl[g * 132 + 64 + lane] = e1 * rl; if (lane == 0) pl[g * 132 + 128] = e2 * rl;
    }
    __syncthreads();
    {
        float o = 0.f;
        for (int j = 0; j < 129; ++j) o += pl[g * 132 + j] * Vc[j * 64 + lane];
        P_MIXS[tiled_off(b, (kvh * 8 + g) * 64 + lane)] = (bf16)(cvtpk(o, 0.f) & 0xffffu);
    }
}
struct RetKRegs { v4u r0[2], r1[2]; f32x4 cs[2][4]; };
DEVI void ret_k_issue(int tid, const Args& args, RetKRegs& R, int b, int h, int c) {
#pragma unroll
    for (int it = 0; it < 2; ++it) { const int task = tid + it * NTHR, m = task & 127, ch = task >> 7;
        const int t = c * 128 + m; const bf16* rp = P_PROJ + (size_t)(b * SEQ + t) * NIN + C_RK + h * 128 + ch * 8;
        R.r0[it] = *(const GAS v4u*)rp; R.r1[it] = *(const GAS v4u*)(rp + 64);
        const GAS f32x4* rt = (const GAS f32x4*)((const GAS f2v*)P_ROT + (size_t)t * 64 + ch * 8);
#pragma unroll
        for (int j = 0; j < 4; ++j) R.cs[it][j] = rt[j]; }
}
template <bool TRANSPOSED> DEVI void ret_k_write(int tid, const RetKRegs& R, LAS bf16* Kd, float lg2) {
#pragma unroll
    for (int it = 0; it < 2; ++it) { const int task = tid + it * NTHR, m = task & 127, ch = task >> 7;
        float a[8], bb[8]; unpack8(R.r0[it], a); unpack8(R.r1[it], bb);
        float sc = 0.08838834764831845f; if (TRANSPOSED) sc *= exp2f((float)(127 - m) * lg2);
        float lo[8], hi[8];
#pragma unroll
        for (int i = 0; i < 8; ++i) { const float cx = R.cs[it][i >> 1][(i & 1) * 2], cy = R.cs[it][i >> 1][(i & 1) * 2 + 1]; lo[i] = (a[i] * cx - bb[i] * cy) * sc; hi[i] = (bb[i] * cx + a[i] * cy) * sc; }
        if (TRANSPOSED) {
#pragma unroll
            for (int i = 0; i < 8; i += 2) { const unsigned wl = cvtpk(lo[i], lo[i + 1]), wh = cvtpk(hi[i], hi[i + 1]);
                Kd[(ch * 8 + i) * 136 + m] = (bf16)(wl & 0xffffu); Kd[(ch * 8 + i + 1) * 136 + m] = (bf16)(wl >> 16);
                Kd[(64 + ch * 8 + i) * 136 + m] = (bf16)(wh & 0xffffu); Kd[(64 + ch * 8 + i + 1) * 136 + m] = (bf16)(wh >> 16); }
        } else { *(LAS v4u*)(Kd + m * 136 + ch * 8) = pack8(lo); *(LAS v4u*)(Kd + m * 136 + 64 + ch * 8) = pack8(hi); }
    }
}
struct RetVRegs { v4u r[8]; };
DEVI void ret_v_issue(int tid, const Args& args, RetVRegs& R, int b, int h, int c) {
#pragma unroll
    for (int it = 0; it < 8; ++it) { const int task = tid + it * NTHR, m = task & 127, ch = task >> 7;
        R.r[it] = *(const GAS v4u*)(P_PROJ + (size_t)(b * SEQ + c * 128 + m) * NIN + C_RV + h * 256 + ch * 8); }
}
DEVI void ret_v_write(int tid, const RetVRegs& R, LAS bf16* Vt) {
#pragma unroll
    for (int it = 0; it < 8; ++it) { const int task = tid + it * NTHR, m = task & 127, ch = task >> 7;
        const unsigned w[4] = {R.r[it].x, R.r[it].y, R.r[it].z, R.r[it].w};
#pragma unroll
        for (int i = 0; i < 8; ++i) Vt[(ch * 8 + i) * 136 + m] = (bf16)((i & 1) ? (w[i >> 1] >> 16) : (w[i >> 1] & 0xffffu)); }
}
DEVI float ret_log2_gamma(int h) { return log2f(1.0f - exp2f(-5.0f - (float)h)); }
DEVI void ret_kv_unit(Frame& F, const Args& args, int unit) {
    const int c = unit & 31, h = (unit >> 5) & 7, b = unit >> 8;
    LAS bf16* Kt = (LAS bf16*)(F.lds); LAS bf16* Vt = (LAS bf16*)(F.lds + 34816);
    const int lane = F.lane, w = F.wave, fr = lane & 15, fq = lane >> 4;
    int tidl = F.tid; asm volatile("" : "+v"(tidl));
    RetKRegs RK; RetVRegs RV; ret_k_issue(tidl, args, RK, b, h, c); ret_v_issue(tidl, args, RV, b, h, c);
    __syncthreads();
    ret_k_write<true>(tidl, RK, Kt, ret_log2_gamma(h)); ret_v_write(tidl, RV, Vt);
    __syncthreads();
    f32x4 acc[8][2];
#pragma unroll
    for (int dt = 0; dt < 8; ++dt) { acc[dt][0] = (f32x4){0.f, 0.f, 0.f, 0.f}; acc[dt][1] = (f32x4){0.f, 0.f, 0.f, 0.f}; }
#pragma unroll
    for (int ks = 0; ks < 4; ++ks) {
        bf16x8 vf[2];
#pragma unroll
        for (int et = 0; et < 2; ++et) vf[et] = *(const LAS bf16x8*)(Vt + (32 * w + 16 * et + fr) * 136 + 32 * ks + 8 * fq);
#pragma unroll
        for (int dt = 0; dt < 8; ++dt) { const bf16x8 kf = *(const LAS bf16x8*)(Kt + (16 * dt + fr) * 136 + 32 * ks + 8 * fq);
            acc[dt][0] = MFMA16(kf, vf[0], acc[dt][0]); acc[dt][1] = MFMA16(kf, vf[1], acc[dt][1]); }
    }
    bf16* dst = P_KVT + (size_t)unit * 32768;
#pragma unroll
    for (int dt = 0; dt < 8; ++dt)
#pragma unroll
        for (int et = 0; et < 2; ++et) { u32x2 kw; kw.x = cvtpk(acc[dt][et][0], acc[dt][et][1]); kw.y = cvtpk(acc[dt][et][2], acc[dt][et][3]); *(GAS u32x2*)(dst + (size_t)(32 * w + 16 * et + fr) * 128 + 16 * dt + 4 * fq) = kw; }
}
DEVI void ret_sample_unit(Frame& F, const Args& args, int unit) {
    const int h = unit & 7, b = unit >> 3;
    LAS float* qv = (LAS float*)(F.lds); LAS float* kv = qv + 128; LAS float* vv = kv + 128; LAS float* red = vv + 256; LAS float* red2 = red + 8 * 256;
    const int tid = F.tid, lane = F.lane, w = F.wave;
    const size_t prow = (size_t)(MPROMPT + b) * NIN;
    const float gamma = 1.0f - exp2f(-5.0f - (float)h);
    const size_t sbase = (size_t)unit * 32768;
    f32x4 s0v[16];
#pragma unroll
    for (int i = 0; i < 16; ++i) s0v[i] = __builtin_nontemporal_load((const GAS f32x4*)(args.in[I_SR] + sbase + (size_t)(w + 8 * i) * 256 + 4 * lane));
    __syncthreads();
    if (tid < 128) { const int d = tid & 63, isk = tid >> 6; const bf16* rp = P_PROJ + prow + (isk ? C_RK : C_RQ) + h * 128;
        const float a = bf1(rp[d]), bb = bf1(rp[d + 64]); const f2v cs = P_ROT[(size_t)4096 * 64 + d]; const float sc = isk ? 0.08838834764831845f : 1.0f;
        LAS float* dstv = isk ? kv : qv; dstv[d] = (a * cs.x - bb * cs.y) * sc; dstv[d + 64] = (bb * cs.x + a * cs.y) * sc; }
    else if (tid < 384) { vv[tid - 128] = bf1(P_PROJ[prow + C_RV + h * 256 + (tid - 128)]); }
    __syncthreads();
    const float qk = wave_sum(qv[lane] * kv[lane] + qv[lane + 64] * kv[lane + 64]);
    const f32x4 v4 = *(const LAS f32x4*)(vv + 4 * lane);
    f32x4 o4 = {0.f, 0.f, 0.f, 0.f};
#pragma unroll
    for (int i = 0; i < 16; ++i) { const int d = w + 8 * i; const size_t off = sbase + (size_t)d * 256 + 4 * lane;
        const f32x4 s0 = s0v[i]; const float qd = qv[d] * gamma, kd = kv[d];
        o4 += s0 * qd; const f32x4 s1 = s0 * gamma + v4 * kd; __builtin_nontemporal_store(s1, (GAS f32x4*)(args.out + O_RS + off)); }
    *(LAS f32x4*)(red + w * 256 + 4 * lane) = o4;
    __syncthreads();
    float o = 0.f;
    if (tid < 256) {
#pragma unroll
        for (int i = 0; i < 8; ++i) o += red[i * 256 + tid];
        o += qk * vv[tid]; }
    const float ssq = wave_sum(o * o);
    if (lane == 0) red2[w] = ssq;
    __syncthreads();
    if (tid < 256) { const float tot = red2[0] + red2[1] + red2[2] + red2[3]; const float rn = 1.0f / sqrtf(tot * (1.0f / 256.0f) + EPS);
        const float rg = bf1(P_PROJ[prow + C_RG + h * 256 + tid]); const float sg = rg / (1.0f + __expf(-rg));
        P_MIX[(size_t)(MPROMPT + b) * DM + 2048 + h * 256 + tid] = (bf16)(cvtpk(sg * o * rn, 0.f) & 0xffffu); }
}
DEVI void ret_scan(Frame& F, const Args& args) {
    LAS float* tl = (LAS float*)(F.lds);
    for (int tile = blockIdx.x; tile < 16 * 16; tile += F.G) {
        const int g4 = tile * NTHR + F.tid, bh = g4 >> 13, within = g4 & 8191, h = bh & 7;
        const float g128 = exp2f(128.0f * ret_log2_gamma(h));
        f32x4 S = {0.f, 0.f, 0.f, 0.f};
        const GAS u32x2* src = (const GAS u32x2*)P_KVT + (size_t)bh * NCHUNK * 8192 + within; GAS u32x2* dst = (GAS u32x2*)P_ST + (size_t)bh * NCHUNK * 8192 + within;
        u32x2 kws[NCHUNK];
#pragma unroll
        for (int c = 0; c < NCHUNK; ++c) kws[c] = __builtin_nontemporal_load(src + (size_t)c * 8192);
#pragma unroll
        for (int c = 0; c < NCHUNK; ++c) { const u32x2 kw = kws[c]; const f32x4 kv = {bflo(kw.x), bfhi(kw.x), bflo(kw.y), bfhi(kw.y)};
            u32x2 w; w.x = cvtpk(S[0], S[1]); w.y = cvtpk(S[2], S[3]); dst[(size_t)c * 8192] = w; S = S * g128 + kv; }
        const int el = F.tid >> 5, d0 = (F.tid & 31) * 4;
        __syncthreads();
#pragma unroll
        for (int i = 0; i < 4; ++i) tl[el * 129 + d0 + i] = S[i];
        __syncthreads();
        { const int d = F.tid >> 2, e4 = F.tid & 3, e0 = (within >> 5) - el;
          const f32x4 o = {tl[(4 * e4 + 0) * 129 + d], tl[(4 * e4 + 1) * 129 + d], tl[(4 * e4 + 2) * 129 + d], tl[(4 * e4 + 3) * 129 + d]};
          *(GAS f32x4*)(args.out + O_RP + ((size_t)bh * 128 + d) * 256 + e0 + 4 * e4) = o; }
    }
}
DEVI void ret_stage_half(Frame& F, const Args& args, LAS bf16* Vh, LAS bf16* Sh, int b, int h, int c, int unit, int hf) {
    const bf16* stp = P_ST + (size_t)unit * 32768 + (size_t)(128 * hf) * 128;
#pragma unroll 1
    for (int task = F.tid; task < 2048; task += NTHR) {
        const int m = task & 127, ch = task >> 7, e = task >> 4, cs = task & 15;
        const v4u rv = *(const GAS v4u*)(P_PROJ + (size_t)(b * SEQ + c * 128 + m) * NIN + C_RV + h * 256 + 128 * hf + ch * 8);
        const v4u rs = *(const GAS v4u*)(stp + (size_t)e * 128 + cs * 8);
        const unsigned w[4] = {rv.x, rv.y, rv.z, rv.w};
#pragma unroll
        for (int i = 0; i < 8; ++i) Vh[(ch * 8 + i) * 136 + m] = (bf16)((i & 1) ? (w[i >> 1] >> 16) : (w[i >> 1] & 0xffffu));
        *(LAS v4u*)(Sh + e * 136 + cs * 8) = rs;
    }
}
DEVI void ret_out_unit(Frame& F, const Args& args, int unit) {
    const int c = unit & 31, h = (unit >> 5) & 7, b = unit >> 8;
    LAS bf16* Km = (LAS bf16*)(F.lds); LAS bf16* Vh = (LAS bf16*)(F.lds + 34816); LAS bf16* Sh = (LAS bf16*)(F.lds + 2 * 34816);
    const int lane = F.lane, w = F.wave, fr = lane & 15, fq = lane >> 4;
    const float lg2 = ret_log2_gamma(h);
    __syncthreads();
    { RetKRegs RK; ret_k_issue(F.tid, args, RK, b, h, c); ret_k_write<false>(F.tid, RK, Km, lg2); }
    ret_stage_half(F, args, Vh, Sh, b, h, c, unit, 0);
    __syncthreads();
    int l = 16 * w + fr; asm volatile("" : "+v"(l));
    const int t = c * 128 + l; const size_t row = (size_t)b * SEQ + t;
    bf16x8 qf[4], qdf[4];
    {
        float qa[4][8]; const bf16* qp = P_PROJ + row * NIN + C_RQ + h * 128 + 8 * fq;
#pragma unroll
        for (int s = 0; s < 4; ++s) { const v4u r = *(const GAS v4u*)(qp + 32 * s); unpack8(r, qa[s]); }
        const float dec = exp2f((float)(l + 1) * lg2);
#pragma unroll
        for (int s = 0; s < 2; ++s) { const GAS f2v* rt = (const GAS f2v*)P_ROT + (size_t)t * 64 + 32 * s + 8 * fq;
            float lo[8], hi[8], lod[8], hid[8];
#pragma unroll
            for (int i = 0; i < 8; ++i) { const f2v cs = rt[i]; lo[i] = qa[s][i] * cs.x - qa[s + 2][i] * cs.y; hi[i] = qa[s + 2][i] * cs.x + qa[s][i] * cs.y; lod[i] = lo[i] * dec; hid[i] = hi[i] * dec; }
            qf[s] = __builtin_bit_cast(bf16x8, pack8(lo)); qf[s + 2] = __builtin_bit_cast(bf16x8, pack8(hi)); qdf[s] = __builtin_bit_cast(bf16x8, pack8(lod)); qdf[s + 2] = __builtin_bit_cast(bf16x8, pack8(hid)); }
    }
    f32x4 sacc[8];
#pragma unroll
    for (int mt = 0; mt < 8; ++mt) { sacc[mt] = (f32x4){0.f, 0.f, 0.f, 0.f};
        if (mt <= w) {
#pragma unroll
            for (int s = 0; s < 4; ++s) { const bf16x8 kf = *(const LAS bf16x8*)(Km + (16 * mt + fr) * 136 + 32 * s + 8 * fq); sacc[mt] = MFMA16(kf, qf[s], sacc[mt]); }
#pragma unroll
            for (int r = 0; r < 4; ++r) { const int diff = l - (16 * mt + 4 * fq + r); sacc[mt][r] = (diff >= 0) ? sacc[mt][r] * exp2f((float)diff * lg2) : 0.f; }
        } }
    bf16x8 pf[4];
#pragma unroll
    for (int ks = 0; ks < 4; ++ks) { v4u pw; pw.x = cvtpk(sacc[2 * ks][0], sacc[2 * ks][1]); pw.y = cvtpk(sacc[2 * ks][2], sacc[2 * ks][3]); pw.z = cvtpk(sacc[2 * ks + 1][0], sacc[2 * ks + 1][1]); pw.w = cvtpk(sacc[2 * ks + 1][2], sacc[2 * ks + 1][3]); pf[ks] = __builtin_bit_cast(bf16x8, pw); }
    f32x4 oacc[16];
#pragma unroll
    for (int hf = 0; hf < 2; ++hf) {
        if (hf == 1) { __syncthreads(); ret_stage_half(F, args, Vh, Sh, b, h, c, unit, 1); __syncthreads(); }
#pragma unroll
        for (int et = 0; et < 8; ++et) { f32x4 o = (f32x4){0.f, 0.f, 0.f, 0.f};
#pragma unroll
            for (int ks = 0; ks < 4; ++ks) if (2 * ks <= w) { const LAS bf16* vp = Vh + (16 * et + fr) * 136 + 32 * ks + 4 * fq; const u32x2 a = *(const LAS u32x2*)vp, cc = *(const LAS u32x2*)(vp + 16);
                const v4u vv = {a.x, a.y, cc.x, cc.y}; o = MFMA16(__builtin_bit_cast(bf16x8, vv), pf[ks], o); }
#pragma unroll
            for (int s = 0; s < 4; ++s) { const bf16x8 sf = *(const LAS bf16x8*)(Sh + (16 * et + fr) * 136 + 32 * s + 8 * fq); o = MFMA16(sf, qdf[s], o); }
            oacc[8 * hf + et] = o; }
    }
    const bf16* gp = P_PROJ + row * NIN + C_RG + h * 256 + 4 * fq; bf16* op = P_MIX + row * DM + 2048 + h * 256 + 4 * fq;
    u32x2 gws[16];
#pragma unroll
    for (int et = 0; et < 16; ++et) gws[et] = *(const GAS u32x2*)(gp + 16 * et);
    float ss = 0.f;
#pragma unroll
    for (int et = 0; et < 16; ++et) ss += (oacc[et][0] * oacc[et][0] + oacc[et][1] * oacc[et][1]) + (oacc[et][2] * oacc[et][2] + oacc[et][3] * oacc[et][3]);
    ss += __shfl_xor(ss, 16); ss += __shfl_xor(ss, 32);
    const float rn = 1.0f / sqrtf(ss * (1.0f / 256.0f) + EPS);
#pragma unroll
    for (int et = 0; et < 16; ++et) { const u32x2 gw = gws[et]; const float gg[4] = {bflo(gw.x), bfhi(gw.x), bflo(gw.y), bfhi(gw.y)}; float r4[4];
#pragma unroll
        for (int r = 0; r < 4; ++r) r4[r] = gg[r] / (1.0f + __expf(-gg[r])) * oacc[et][r] * rn;
        u32x2 ow; ow.x = cvtpk(r4[0], r4[1]); ow.y = cvtpk(r4[2], r4[3]); *(GAS u32x2*)(op + 16 * et) = ow; }
}
DEVI void conv_gate_pass(Frame& F, const Args& args) {
    const int gt = blockIdx.x * NTHR + F.tid, NGT = F.G * NTHR;
    const float* cw = args.in[I_CW]; const float* cb = args.in[I_CB];
    constexpr int NCG = DFF / 8;
    constexpr int P7_SEG = 88, P7_NSEG = (MPROMPT + P7_SEG - 1) / P7_SEG;
    static_assert(P7_SEG % 8 == 0 && (MPROMPT - (P7_NSEG - 1) * P7_SEG) % 8 == 0 && SEQ % P7_SEG != 1 && SEQ % P7_SEG != 0, "segment / sequence geometry");
    for (int task = gt; task < P7_NSEG * NCG; task += NGT) {
        const int seg = task / NCG, cg = task - seg * NCG, r0 = seg * P7_SEG, j0 = cg * 8; const int nb = ((MPROMPT - r0 < P7_SEG) ? (MPROMPT - r0) : P7_SEG) / 4;
        float w0[16], w1[16], w2[16], bs[16];
#pragma unroll
        for (int i = 0; i < 8; ++i) { w0[i] = cw[j0 + i]; w1[i] = cw[NUP + j0 + i]; w2[i] = cw[2 * NUP + j0 + i]; bs[i] = cb[j0 + i];
            w0[8 + i] = cw[DFF + j0 + i]; w1[8 + i] = cw[NUP + DFF + j0 + i]; w2[8 + i] = cw[2 * NUP + DFF + j0 + i]; bs[8 + i] = cb[DFF + j0 + i]; }
        float p2[16], p1[16];
        const bool first = (r0 & (SEQ - 1)) == 0;
        if (first) {
#pragma unroll
            for (int i = 0; i < 16; ++i) { p2[i] = 0.f; p1[i] = 0.f; }
        } else { const bf16* ua = P_U + (size_t)(r0 - 2) * NUP + j0; float t8[8];
            unpack8(*(const GAS v4u*)ua, t8);
#pragma unroll
            for (int i = 0; i < 8; ++i) p2[i] = t8[i];
            unpack8(*(const GAS v4u*)(ua + DFF), t8);
#pragma unroll
            for (int i = 0; i < 8; ++i) p2[8 + i] = t8[i];
            unpack8(*(const GAS v4u*)(ua + NUP), t8);
#pragma unroll
            for (int i = 0; i < 8; ++i) p1[i] = t8[i];
            unpack8(*(const GAS v4u*)(ua + NUP + DFF), t8);
#pragma unroll
            for (int i = 0; i < 8; ++i) p1[8 + i] = t8[i]; }
        v4u ba[8], bb[8];
#define P7_LOAD(buf, b) do { _Pragma("unroll") for (int q = 0; q < 4; ++q) { const bf16* up_ = P_U + (size_t)(r0 + 4 * (b) + q) * NUP + j0; buf[2 * q] = __builtin_nontemporal_load((const GAS v4u*)up_); buf[2 * q + 1] = __builtin_nontemporal_load((const GAS v4u*)(up_ + DFF)); } } while (0)
#define P7_COMP(buf, b) do { _Pragma("unroll") for (int q = 0; q < 4; ++q) { const int row = r0 + 4 * (b) + q; if ((row & (SEQ - 1)) == 0) { _Pragma("unroll") for (int i = 0; i < 16; ++i) { p2[i] = 0.f; p1[i] = 0.f; } } float cur[16]; { float t8[8]; unpack8(buf[2 * q], t8); \
            _Pragma("unroll") for (int i = 0; i < 8; ++i) cur[i] = t8[i]; unpack8(buf[2 * q + 1], t8); _Pragma("unroll") for (int i = 0; i < 8; ++i) cur[8 + i] = t8[i]; } \
            float a8[8]; \
            _Pragma("unroll") for (int i = 0; i < 8; i += 2) { const float cg0 = bs[i] + w0[i] * p2[i] + w1[i] * p1[i] + w2[i] * cur[i], cg1 = bs[i + 1] + w0[i + 1] * p2[i + 1] + w1[i + 1] * p1[i + 1] + w2[i + 1] * cur[i + 1]; \
                const float cv0 = bs[8 + i] + w0[8 + i] * p2[8 + i] + w1[8 + i] * p1[8 + i] + w2[8 + i] * cur[8 + i], cv1 = bs[9 + i] + w0[9 + i] * p2[9 + i] + w1[9 + i] * p1[9 + i] + w2[9 + i] * cur[9 + i]; \
                const pg8::f32x2 ge = pg8::gelu_pk((pg8::f32x2){cg0, cg1}); a8[i] = ge.x * cv0; a8[i + 1] = ge.y * cv1; } \
            *(GAS v4u*)(P_ACT + (size_t)row * DFF + j0) = pack8(a8); \
            if ((row & (SEQ - 1)) >= SEQ - 2) { float* oc = args.out + O_CP + ((size_t)(row >> 12) * 2 + ((row & (SEQ - 1)) - (SEQ - 2))) * NUP + j0; \
                _Pragma("unroll") for (int i = 0; i < 8; ++i) { oc[i] = cur[i]; oc[DFF + i] = cur[8 + i]; } } \
            _Pragma("unroll") for (int i = 0; i < 16; ++i) { p2[i] = p1[i]; p1[i] = cur[i]; } } } while (0)
        P7_LOAD(ba, 0);
#pragma unroll 1
        for (int b = 0; b < nb; b += 2) {
            P7_LOAD(bb, b + 1);
            P7_COMP(ba, b);
            if (b + 2 < nb) P7_LOAD(ba, b + 2);
            P7_COMP(bb, b + 1);
        }
#undef P7_LOAD
#undef P7_COMP
    }
    for (int task = gt; task < 2 * MSAMPLE * NCG; task += NGT) {
        const int rb = task / NCG, cg = task - rb * NCG, j0 = cg * 8;
        if (rb >= MSAMPLE) { const v4u z = {0u, 0u, 0u, 0u}; *(GAS v4u*)(P_ACT + (size_t)(MREAL + rb - MSAMPLE) * DFF + j0) = z; continue; }
        const int row = MPROMPT + rb; const bf16* up = P_U + (size_t)row * NUP + j0;
        const v4u ug = *(const GAS v4u*)up, uv = *(const GAS v4u*)(up + DFF);
        const float* sc0 = args.in[I_SC] + (size_t)rb * 2 * NUP + j0; const float* sc1 = sc0 + NUP;
        float* oc0 = args.out + O_CS + (size_t)rb * 2 * NUP + j0; float* oc1 = oc0 + NUP;
        f32x4 p2g[2], p2v[2], p1g[2], p1v[2], wq[8][2];
#pragma unroll
        for (int q = 0; q < 2; ++q) { p2g[q] = *(const GAS f32x4*)(sc0 + 4 * q); p2v[q] = *(const GAS f32x4*)(sc0 + DFF + 4 * q); p1g[q] = *(const GAS f32x4*)(sc1 + 4 * q); p1v[q] = *(const GAS f32x4*)(sc1 + DFF + 4 * q);
            wq[0][q] = *(const GAS f32x4*)(cb + j0 + 4 * q); wq[1][q] = *(const GAS f32x4*)(cw + j0 + 4 * q); wq[2][q] = *(const GAS f32x4*)(cw + NUP + j0 + 4 * q); wq[3][q] = *(const GAS f32x4*)(cw + 2 * NUP + j0 + 4 * q);
            wq[4][q] = *(const GAS f32x4*)(cb + DFF + j0 + 4 * q); wq[5][q] = *(const GAS f32x4*)(cw + DFF + j0 + 4 * q); wq[6][q] = *(const GAS f32x4*)(cw + NUP + DFF + j0 + 4 * q); wq[7][q] = *(const GAS f32x4*)(cw + 2 * NUP + DFF + j0 + 4 * q); }
        float cur[16]; { float t8[8]; unpack8(ug, t8);
#pragma unroll
            for (int i = 0; i < 8; ++i) cur[i] = t8[i];
            unpack8(uv, t8);
#pragma unroll
            for (int i = 0; i < 8; ++i) cur[8 + i] = t8[i]; }
        float a8[8];
#pragma unroll
        for (int i = 0; i < 8; i += 2) { const int q = i >> 2, e = i & 3;
            const float cg0 = wq[0][q][e] + wq[1][q][e] * p2g[q][e] + wq[2][q][e] * p1g[q][e] + wq[3][q][e] * cur[i];
            const float cg1 = wq[0][q][e + 1] + wq[1][q][e + 1] * p2g[q][e + 1] + wq[2][q][e + 1] * p1g[q][e + 1] + wq[3][q][e + 1] * cur[i + 1];
            const float cv0 = wq[4][q][e] + wq[5][q][e] * p2v[q][e] + wq[6][q][e] * p1v[q][e] + wq[7][q][e] * cur[8 + i];
            const float cv1 = wq[4][q][e + 1] + wq[5][q][e + 1] * p2v[q][e + 1] + wq[6][q][e + 1] * p1v[q][e + 1] + wq[7][q][e + 1] * cur[8 + i + 1];
            const pg8::f32x2 ge = pg8::gelu_pk((pg8::f32x2){cg0, cg1}); a8[i] = ge.x * cv0; a8[i + 1] = ge.y * cv1; }
#pragma unroll
        for (int q = 0; q < 2; ++q) { *(GAS f32x4*)(oc0 + 4 * q) = p1g[q]; *(GAS f32x4*)(oc0 + DFF + 4 * q) = p1v[q];
            *(GAS f32x4*)(oc1 + 4 * q) = (f32x4){cur[4 * q], cur[4 * q + 1], cur[4 * q + 2], cur[4 * q + 3]}; *(GAS f32x4*)(oc1 + DFF + 4 * q) = (f32x4){cur[8 + 4 * q], cur[8 + 4 * q + 1], cur[8 + 4 * q + 2], cur[8 + 4 * q + 3]}; }
        *(GAS v4u*)(P_ACTS + tiled_off(rb, j0)) = pack8(a8);
    }
}

template <bool TILED> DEVI f32x4 sliver_gemm_t(LAS unsigned char* lds, const bf16* A, const bf16* Bt, int K, int n0, int lane, int wave) {
    const int fr = lane & 15, fq = lane >> 4, ks = K >> 3, nst = ks >> 5;
    const bf16* ap = TILED ? A + ((size_t)(wave * (ks >> 5)) * 128 + fr) * 32 + 8 * fq : A + (size_t)fr * K + wave * ks + 8 * fq; const bf16* bp = Bt + (size_t)(n0 + fr) * K + wave * ks + 8 * fq;
    const size_t rt_stride = TILED ? (size_t)16 * 32 : (size_t)16 * K; const int ast = TILED ? 128 : 1;
    f32x4 acc[8];
#pragma unroll
    for (int rt = 0; rt < 8; ++rt) acc[rt] = (f32x4){0.f, 0.f, 0.f, 0.f};
    const int rot = (int)(blockIdx.x >> 3) % nst;
#define SLV_OFF(st) (32 * (((st) + rot) >= nst ? ((st) + rot) - nst : ((st) + rot)))
    v4u a0[8], a1[8], b0, b1;
    { const int o0 = SLV_OFF(0); b0 = *(const GAS v4u*)(bp + o0);
#pragma unroll
      for (int rt = 0; rt < 8; ++rt) a0[rt] = *(const GAS v4u*)(ap + rt * rt_stride + (size_t)o0 * ast); }
    for (int st = 0; st < nst; st += 2) {
        if (st + 1 < nst) { const int o1 = SLV_OFF(st + 1); b1 = *(const GAS v4u*)(bp + o1);
#pragma unroll
            for (int rt = 0; rt < 8; ++rt) a1[rt] = *(const GAS v4u*)(ap + rt * rt_stride + (size_t)o1 * ast); }
#pragma unroll
        for (int rt = 0; rt < 8; ++rt) acc[rt] = MFMA16(__builtin_bit_cast(bf16x8, b0), __builtin_bit_cast(bf16x8, a0[rt]), acc[rt]);
        if (st + 1 < nst) {
            if (st + 2 < nst) { const int o2 = SLV_OFF(st + 2); b0 = *(const GAS v4u*)(bp + o2);
#pragma unroll
                for (int rt = 0; rt < 8; ++rt) a0[rt] = *(const GAS v4u*)(ap + rt * rt_stride + (size_t)o2 * ast); }
#pragma unroll
            for (int rt = 0; rt < 8; ++rt) acc[rt] = MFMA16(__builtin_bit_cast(bf16x8, b1), __builtin_bit_cast(bf16x8, a1[rt]), acc[rt]);
        }
    }
#undef SLV_OFF
    LAS f32x4* red = (LAS f32x4*)lds;
    __syncthreads();
#pragma unroll
    for (int rt = 0; rt < 8; ++rt) red[(wave * 8 + rt) * 64 + lane] = acc[rt];
    __syncthreads();
    f32x4 r = red[wave * 64 + lane];
#pragma unroll
    for (int sw = 1; sw < 8; ++sw) r += red[(sw * 8 + wave) * 64 + lane];
    return r;
}
DEVI f32x4 sliver_gemm(LAS unsigned char* lds, const bf16* A, const bf16* Bt, int K, int n0, int lane, int wave) { return sliver_gemm_t<false>(lds, A, Bt, K, n0, lane, wave); }
DEVI f32x4 sliver_gemm_64x32(LAS unsigned char* lds, const bf16* A, const bf16* Bt, int K, int rh, int n0, int lane, int wave) {
    const int fr = lane & 15, fq = lane >> 4, ks = K >> 3, nst = ks >> 5;
    const bf16* ap = A + ((size_t)(wave * nst) * 128 + 64 * rh + fr) * 32 + 8 * fq; const bf16* bp = Bt + (size_t)(n0 + fr) * K + wave * ks + 8 * fq; const size_t bct = (size_t)16 * K;
    f32x4 acc[8];
#pragma unroll
    for (int i = 0; i < 8; ++i) acc[i] = (f32x4){0.f, 0.f, 0.f, 0.f};
    const int rot = (int)(blockIdx.x >> 3) % nst;
#define SLV_OFF(st) (32 * (((st) + rot) >= nst ? ((st) + rot) - nst : ((st) + rot)))
#define SLV_LD(a, b, o) do { b[0] = *(const GAS v4u*)(bp + (o)); b[1] = *(const GAS v4u*)(bp + bct + (o)); _Pragma("unroll") for (int rt = 0; rt < 4; ++rt) a[rt] = *(const GAS v4u*)(ap + rt * 512 + (size_t)(o) * 128); } while (0)
#define SLV_MM(a, b) do { _Pragma("unroll") for (int rt = 0; rt < 4; ++rt) _Pragma("unroll") for (int ct = 0; ct < 2; ++ct) acc[rt * 2 + ct] = MFMA16(__builtin_bit_cast(bf16x8, b[ct]), __builtin_bit_cast(bf16x8, a[rt]), acc[rt * 2 + ct]); } while (0)
    v4u a0[4], a1[4], a2[4], b0[2], b1[2], b2[2];
    SLV_LD(a0, b0, SLV_OFF(0)); if (1 < nst) SLV_LD(a1, b1, SLV_OFF(1));
    for (int st = 0; st < nst; st += 3) {
        if (st + 2 < nst) SLV_LD(a2, b2, SLV_OFF(st + 2));
        SLV_MM(a0, b0);
        if (st + 1 < nst) { if (st + 3 < nst) SLV_LD(a0, b0, SLV_OFF(st + 3)); SLV_MM(a1, b1); }
        if (st + 2 < nst) { if (st + 4 < nst) SLV_LD(a1, b1, SLV_OFF(st + 4)); SLV_MM(a2, b2); }
    }
#undef SLV_OFF
#undef SLV_LD
#undef SLV_MM
    LAS f32x4* red = (LAS f32x4*)lds;
    __syncthreads();
#pragma unroll
    for (int i = 0; i < 8; ++i) red[(wave * 8 + i) * 64 + lane] = acc[i];
    __syncthreads();
    f32x4 r = red[wave * 64 + lane];
#pragma unroll
    for (int sw = 1; sw < 8; ++sw) r += red[(sw * 8 + wave) * 64 + lane];
    return r;
}
template <bool BASE_BF16, bool OUT_F32> DEVI void sliver_resid(const f32x4 acc, int row, int c, const float* base  , float* outf  , bf16* outb, float* ss, bf16* outt  ) {
    const size_t off = (size_t)row * DM + c; f32x4 b4;
    if (BASE_BF16) { const u32x2 bw = *(const GAS u32x2*)(outb + off); b4 = (f32x4){bflo(bw.x), bfhi(bw.x), bflo(bw.y), bfhi(bw.y)}; } else b4 = *(const GAS f32x4*)(base + off);
    const f32x4 o = b4 + acc;
    if (OUT_F32) *(GAS f32x4*)(outf + off) = o;
    u32x2 w; w.x = cvtpk(o[0], o[1]); w.y = cvtpk(o[2], o[3]); *(GAS u32x2*)(outb + off) = w; if (outt) *(GAS u32x2*)(outt + tiled_off(row, c)) = w;
    float s = (o[0] * o[0] + o[1] * o[1]) + (o[2] * o[2] + o[3] * o[3]); s += __shfl_xor(s, 16); s += __shfl_xor(s, 32);
    if ((threadIdx.x & 48) == 0) atomicAdd(ss + row, s);
}
#ifndef SLV_DUP
#define SLV_DUP 1
#endif
#ifndef SLV_TILED
#define SLV_TILED false
#endif
#define SLV_ROW(sv) (64 * ((sv) & 1) + 16 * (F.wave >> 1) + (F.lane & 15))
#define SLV_COL(sv) (32 * ((sv) >> 1) + 16 * (F.wave & 1) + 4 * (F.lane >> 4))
__global__ void __launch_bounds__(NTHR, 2) mk_fwd(Args args) {
    extern __shared__ __attribute__((aligned(16))) unsigned char lds[];
    Frame F;
    F.lds = (LAS unsigned char*)lds;
    F.MISC = (volatile LAS unsigned*)(F.lds + MISC_OFF);
    F.tid = threadIdx.x; F.lane = F.tid & 63; F.wave = __builtin_amdgcn_readfirstlane(F.tid >> 6); F.G = gridDim.x;
    unsigned char* ws = args.ws;
    F.ctl = (gu32*)(ws + WS_CTL);
    for (int u = F.tid; u < (LDS_BYTES - LDSCTL_OFF) / 4; u += NTHR) ((LAS unsigned*)(F.lds + LDSCTL_OFF))[u] = 0u;
    __syncthreads();
    XcdBarrier bar; bar.bar = (unsigned*)(F.ctl + CW_BAR); bar.x = 0; bar.st = nullptr;
    if (N_LAUNCHES == 1) bar = xcd_barrier_post((unsigned*)(F.ctl + CW_BAR), F.MISC + 8);
#define GRID_BAR() do { if (N_LAUNCHES == 1) xcd_barrier(bar); } while (0)
    F.vc = (int)blockIdx.x;
    if (N_LAUNCHES == 1 && F.G == 256) {
        if (F.tid == 0) { const unsigned x = xb_xcc_id(); const unsigned r = __hip_atomic_fetch_add(F.ctl + CW_XRANK + 64 * x, 1u, RLX_AGENT); F.MISC[20] = (x < 8u && r < 32u) ? x + 8u * r : 0xffffffffu; }
        __syncthreads();
        const unsigned v = (unsigned)__builtin_amdgcn_readfirstlane((int)F.MISC[20]); if (v != 0xffffffffu) F.vc = (int)v;
    }

    const int lo = args.ph_lo, hi = args.ph_hi;
#ifndef DUP_MASK
#define DUP_MASK 0
#endif
#define REP(k) for (int rep_ = 0; rep_ < (((DUP_MASK >> (k)) & 1) ? 2 : 1); ++rep_)
#ifndef PHASE_MASK
#define PHASE_MASK 0x7ff
#endif
#define IN(k) (((PHASE_MASK >> (k)) & 1) && lo <= (k) && (k) < hi)
#define BOTH(k) (IN(k) && IN((k) + 1))
    typedef pg8::StaticOrder SO;
    if (IN(0)) { REP(0) p0_prologue(F, args); if (BOTH(0)) GRID_BAR(); }
    if (IN(1)) { pg8::Gemm g = pg8::gemm_rowmajor(P_A, P_Win_t, MPAD, NIN, DM); SO S; S.init(MPAD, NIN, F.G, F.vc);
        pg8::EpiBf16S<false> E{P_PROJ, NIN, nullptr};
        pg8::gemm_phase<pg8::EpiBf16S<false>, SO, true, true>(F.lds + RING_OFF, g, S, E);
        { const int nbusy = S.nwg % F.G;
          if (nbusy != 0 && F.vc >= nbusy) tr_run(args, TR_END_P0 + (F.vc - nbusy) * NWAVES + F.wave, TR_END_G1, (F.G - nbusy) * NWAVES, F.lane, (LAS float*)(F.lds + RING_OFF + F.wave * TR_SCR_BYTES));
          else if (nbusy == 0) tr_run(args, TR_END_P0 + F.vc * NWAVES + F.wave, TR_END_G1, F.G * NWAVES, F.lane, (LAS float*)(F.lds + RING_OFF + F.wave * TR_SCR_BYTES)); }
        if (BOTH(1)) GRID_BAR(); }
    if (IN(2)) {
        if (blockIdx.x & 1) {
            for (int u = blockIdx.x; u < 512; u += F.G) attn_sample_unit(F, args, u);
            for (int u = blockIdx.x; u < 512; u += F.G) ret_kv_unit(F, args, u);
            for (int u = blockIdx.x; u < 256; u += F.G) attn_prompt_unit(F, args, u);
        } else {
            for (int u = blockIdx.x; u < 256; u += F.G) attn_prompt_unit(F, args, u);
            for (int u = blockIdx.x; u < 512; u += F.G) ret_kv_unit(F, args, u);
            for (int u = blockIdx.x; u < 512; u += F.G) attn_sample_unit(F, args, u);
        }
        __syncthreads();
        if (BOTH(2)) GRID_BAR(); }
    if (IN(3)) { sret_finalize(F, args); REP(3) ret_scan(F, args); if (BOTH(3)) GRID_BAR(); }
#ifndef P4_DUP
#define P4_DUP 1
#endif
    if (IN(4)) { for (int u = blockIdx.x; u < 512 * P4_DUP; u += F.G) ret_out_unit(F, args, u & 511); __syncthreads(); if (BOTH(4)) GRID_BAR(); }
    if (IN(5)) { pg8::Gemm g = pg8::gemm_rowmajor(P_MIX, P_Wout_t, MPROMPT, DM, DM); SO S; S.init(MPROMPT, DM, F.G, F.vc);
        pg8::EpiResid<false, false> E{args.in[I_XP], args.in[I_XS], nullptr, P_A, P_SS1};
        pg8::gemm_phase<pg8::EpiResid<false, false>, SO, true, true>(F.lds + RING_OFF, g, S, E);
        for (int sv = blockIdx.x; sv < DM / 16; sv += F.G) { const f32x4 acc = sliver_gemm_64x32(F.lds, P_MIXS, P_Wout_t, DM, sv & 1, 32 * (sv >> 1), F.lane, F.wave);
            sliver_resid<false, false>(acc, SLV_ROW(sv), SLV_COL(sv), args.in[I_XS], nullptr, P_A + (size_t)MPROMPT * DM, P_SS1 + MPROMPT, nullptr); }
        if (BOTH(5)) GRID_BAR(); }
    if (IN(6)) { pg8::Gemm g = pg8::gemm_rowmajor(P_A, P_Wup_t, MPAD, NUP, DM); SO S; S.init(MPAD, NUP, F.G, F.vc);
        pg8::EpiBf16S<true> E{P_U, NUP, P_SS1};
        pg8::gemm_phase<pg8::EpiBf16S<true>, SO, true, true>(F.lds + RING_OFF, g, S, E);
        { const int nbusy = S.nwg % F.G;
          if (nbusy != 0 && F.vc >= nbusy) tr_run(args, TR_END_G1 + (F.vc - nbusy) * NWAVES + F.wave, TR_END_G3, (F.G - nbusy) * NWAVES, F.lane, (LAS float*)(F.lds + RING_OFF + F.wave * TR_SCR_BYTES));
          else if (nbusy == 0) tr_run(args, TR_END_G1 + F.vc * NWAVES + F.wave, TR_END_G3, F.G * NWAVES, F.lane, (LAS float*)(F.lds + RING_OFF + F.wave * TR_SCR_BYTES)); }
        if (BOTH(6)) GRID_BAR(); }
    if (IN(7)) { REP(7) conv_gate_pass(F, args); if (BOTH(7)) GRID_BAR(); }
    if (IN(8)) { pg8::Gemm g = pg8::gemm_rowmajor(P_ACT, P_Wdown_t, MPROMPT, DM, DFF); SO S; S.init(MPROMPT, DM, F.G, F.vc);
        pg8::EpiResid<true, false> E{nullptr, nullptr, nullptr, P_A, P_SS2};
        pg8::gemm_phase<pg8::EpiResid<true, false>, SO, true, true>(F.lds + RING_OFF, g, S, E);
        for (int sv = blockIdx.x; sv < DM / 16; sv += F.G) { const f32x4 acc = sliver_gemm_64x32(F.lds, P_ACTS, P_Wdown_t, DFF, sv & 1, 32 * (sv >> 1), F.lane, F.wave);
            sliver_resid<true, false>(acc, SLV_ROW(sv), SLV_COL(sv), nullptr, nullptr, P_A + (size_t)MPROMPT * DM, P_SS2 + MPROMPT, P_X2BS); }
        __syncthreads(); }
    if (IN(9)) { int kple = PLED; asm volatile("" : "+s"(kple));
        pg8::Gemm g = pg8::gemm_rowmajor(P_PB, P_Wproj_t, MPROMPT, DM, kple); SO S; S.init(MPROMPT, DM, F.G, F.vc);
        pg8::EpiBf16S<false> E{P_PLEB, DM, nullptr};
        pg8::gemm_phase<pg8::EpiBf16S<false>, SO, true, true>(F.lds + RING_OFF, g, S, E);
        for (int sv = blockIdx.x; sv < DM / 16; sv += F.G) { const f32x4 acc = sliver_gemm_64x32(F.lds, P_PBS, P_Wproj_t, kple, sv & 1, 32 * (sv >> 1), F.lane, F.wave);
            u32x2 w; w.x = cvtpk(acc[0], acc[1]); w.y = cvtpk(acc[2], acc[3]);
            *(GAS u32x2*)(P_PLEB + (size_t)(MPROMPT + SLV_ROW(sv)) * DM + SLV_COL(sv)) = w; }
        if (BOTH(9)) GRID_BAR(); }
    if (IN(10)) { pg8::Gemm g = pg8::gemm_rowmajor(P_A, P_Wgate_t, MPROMPT, DM, DM); SO S; S.init(MPROMPT, DM, F.G, F.vc);
        pg8::EpiPle E{args.out, P_A, P_PLEB, P_SS2};
        pg8::gemm_phase<pg8::EpiPle, SO, true, true>(F.lds + RING_OFF, g, S, E);
        for (int sv = blockIdx.x; sv < (DM / 16); sv += F.G) { const f32x4 acc = sliver_gemm_64x32(F.lds, P_X2BS, P_Wgate_t, DM, sv & 1, 32 * (sv >> 1), F.lane, F.wave);
            const int row = MPROMPT + SLV_ROW(sv), c = SLV_COL(sv); const size_t off = (size_t)row * DM + c;
            const float sc = 1.0f / sqrtf(P_SS2[row] * (1.0f / DM) + EPS);
            const u32x2 xw = *(const GAS u32x2*)(P_A + off); const f32x4 x2 = {bflo(xw.x), bfhi(xw.x), bflo(xw.y), bfhi(xw.y)}; const u32x2 pw = *(const GAS u32x2*)(P_PLEB + off); const float pl[4] = {bflo(pw.x), bfhi(pw.x), bflo(pw.y), bfhi(pw.y)}; f32x4 o;
#pragma unroll
            for (int k = 0; k < 4; ++k) { const float gte = __builtin_amdgcn_rcpf(1.0f + __builtin_amdgcn_exp2f(-1.4426950408889634f * sc * acc[k])); o[k] = x2[k] + gte * pl[k]; }
            *(GAS f32x4*)(args.out + off) = o; }
        }
#undef IN
#undef BOTH
}

extern "C" void kernel_launch(void* const* d_in, const int* in_sizes, int n_in, void* d_out, int out_size, void* d_ws, size_t ws_size, hipStream_t stream) {
    static int grid = 0;
    if (grid == 0) {
        if (n_in != N_INPUTS || (size_t)out_size != O_END || ws_size < WS_END) { fprintf(stderr, "kernel_launch: unexpected shapes: n_in %d out %d ws %zu; nothing launched\n", n_in, out_size, ws_size); grid = -1; return; }
        int dev = 0, cus = 0, per_cu = 0;
        if (hipGetDevice(&dev) != hipSuccess || hipDeviceGetAttribute(&cus, hipDeviceAttributeMultiprocessorCount, dev) != hipSuccess) { grid = -1; return; }
        if (hipFuncSetAttribute((const void*)mk_fwd, hipFuncAttributeMaxDynamicSharedMemorySize, LDS_BYTES) != hipSuccess) { fprintf(stderr, "kernel_launch: hipFuncSetAttribute failed\n"); grid = -1; return; }
        if (hipOccupancyMaxActiveBlocksPerMultiprocessor(&per_cu, (const void*)mk_fwd, NTHR, LDS_BYTES) != hipSuccess || per_cu < 1) { fprintf(stderr, "kernel_launch: occupancy query says %d blocks per CU\n", per_cu); }
        (void)hipGetLastError();
        grid = cus;
    }
    if (grid < 0) return;
    if (hipMemsetAsync((char*)d_ws + WS_CTL, 0, CTL_ZERO_BYTES, stream) != hipSuccess) return;
    Args a{};
    for (int i = 0; i < N_INPUTS; ++i) a.in[i] = (const float*)d_in[i];
    a.out = (float*)d_out; a.ws = (unsigned char*)d_ws;
    if (N_LAUNCHES == 1) { a.ph_lo = 0; a.ph_hi = N_PHASES; hipLaunchKernelGGL(mk_fwd, dim3(grid), dim3(NTHR), LDS_BYTES, stream, a); }
    else { for (int p = 0; p < N_PHASES; ++p) { a.ph_lo = p; a.ph_hi = p + 1; hipLaunchKernelGGL(mk_fwd, dim3(grid), dim3(NTHR), LDS_BYTES, stream, a); } }
}
```
